# Optimizing an MI355X kernel written in HIP

```python
import jax, jax.numpy as jnp
from jax import lax
import numpy as np

D_MODEL = 2048
BATCH = 2
SEQ = 8192
DEPTH = 2

CTX_LEN = 256
GRID_W = 64
N_MIXERS = 2
HEAD_DIM = 128
N_HEADS = D_MODEL // HEAD_DIM
N_KV_HEADS = N_HEADS // 4
GQA_GROUP = N_HEADS // N_KV_HEADS
WINDOW = 128
BLOCK = 128
ROPE_BASE = 10000.0
POOL_WINDOWS = (2, 4, 8, 16)
POOL_GROUP = D_MODEL // len(POOL_WINDOWS)
N_EXPERTS = 64
N_EXPERT_GROUPS = 8
TOPK_GROUPS = 4
TOP_K = 8
EXPERT_FF = D_MODEL // 4
SHARED_FF = EXPERT_FF
ROUTED_SCALE = 2.5
EPS = 1e-6
NEG = -1e30
N_ATTN_LAYERS = (DEPTH + 1) // 2
N_POOL_LAYERS = DEPTH // 2

kernel_name = 'hybrid_swa_sink_pool_moe_dit'


def rmsnorm(x, g):
    x32 = x.astype(jnp.float32)
    y = x32 * lax.rsqrt(jnp.mean(x32 * x32, axis=-1, keepdims=True) + EPS) * g.astype(jnp.float32)
    return y.astype(x.dtype)


def head_rms(x, g):
    x32 = x.astype(jnp.float32)
    y = x32 * lax.rsqrt(jnp.mean(x32 * x32, axis=-1, keepdims=True) + EPS) * g.astype(jnp.float32)
    return y.astype(x.dtype)


def modulate(h, shift, scale):
    return h * (1 + scale) + shift


def adaln(cond, w, b):
    return jnp.split(jax.nn.silu(cond) @ w + b, 6, axis=-1)


def axial_rope(S, dtype):
    rows = S // GRID_W
    row = jnp.repeat(jnp.arange(rows), GRID_W).astype(jnp.float32)
    col = jnp.tile(jnp.arange(GRID_W), rows).astype(jnp.float32)
    nf = HEAD_DIM // 4
    inv = ROPE_BASE ** (-jnp.arange(nf, dtype=jnp.float32) / nf)
    ang = jnp.stack([row[:, None] * inv, col[:, None] * inv], axis=1)
    return jnp.cos(ang).astype(dtype), jnp.sin(ang).astype(dtype)


def apply_axial_rope(x, cos, sin):
    xs = x.reshape(*x.shape[:-1], 2, 2, HEAD_DIM // 4)
    x1, x2 = xs[..., 0, :], xs[..., 1, :]
    c, s = cos[:, None], sin[:, None]
    out = jnp.stack([x1 * c - x2 * s, x2 * c + x1 * s], axis=-2)
    return out.reshape(x.shape)


def band_blocks(t, nb):
    B = t.shape[0]
    tp = jnp.pad(t, ((0, 0), (BLOCK, BLOCK), (0, 0), (0, 0))).reshape(B, nb + 2, BLOCK, N_KV_HEADS, HEAD_DIM)
    return jnp.concatenate([tp[:, :-2], tp[:, 1:-1], tp[:, 2:]], axis=2)


def windowed_sink_attention(h, hc, w_qkv, g_q, g_k, sink, w_o, cos, sin, with_ctx_queries):
    B, S, _ = h.shape
    C = hc.shape[1]
    qd = N_HEADS * HEAD_DIM
    kd = N_KV_HEADS * HEAD_DIM
    scale = HEAD_DIM ** -0.5
    qkv = h @ w_qkv
    q = qkv[..., :qd].reshape(B, S, N_HEADS, HEAD_DIM)
    k = qkv[..., qd:qd + kd].reshape(B, S, N_KV_HEADS, HEAD_DIM)
    v = qkv[..., qd + kd:].reshape(B, S, N_KV_HEADS, HEAD_DIM)
    q = apply_axial_rope(head_rms(q, g_q), cos, sin)
    k = apply_axial_rope(head_rms(k, g_k), cos, sin)
    kv_c = hc @ w_qkv[:, qd:]
    k_c = head_rms(kv_c[..., :kd].reshape(B, C, N_KV_HEADS, HEAD_DIM), g_k)
    v_c = kv_c[..., kd:].reshape(B, C, N_KV_HEADS, HEAD_DIM)
    nb = S // BLOCK
    qb = q.reshape(B, nb, BLOCK, N_KV_HEADS, GQA_GROUP, HEAD_DIM)
    kw = band_blocks(k, nb)
    vw = band_blocks(v, nb)
    s_loc = jnp.einsum('bnqkgd,bnjkd->bnkgqj', qb, kw).astype(jnp.float32) * scale
    qpos = jnp.arange(nb)[:, None, None] * BLOCK + jnp.arange(BLOCK)[None, :, None]
    kpos = (jnp.arange(nb)[:, None, None] - 1) * BLOCK + jnp.arange(3 * BLOCK)[None, None, :]
    valid = (jnp.abs(qpos - kpos) <= WINDOW) & (kpos >= 0) & (kpos < S)
    s_loc = jnp.where(valid[None, :, None, None], s_loc, NEG)
    s_ctx = jnp.einsum('bnqkgd,bckd->bnkgqc', qb, k_c).astype(jnp.float32) * scale
    sink_h = sink.astype(jnp.float32).reshape(N_KV_HEADS, GQA_GROUP)
    sink_l = jnp.broadcast_to(sink_h[None, None, :, :, None, None], s_loc.shape[:-1] + (1,))
    p = jax.nn.softmax(jnp.concatenate([s_loc, s_ctx, sink_l], axis=-1), axis=-1).astype(h.dtype)
    o = (jnp.einsum('bnkgqj,bnjkd->bnqkgd', p[..., :3 * BLOCK], vw)
         + jnp.einsum('bnkgqc,bckd->bnqkgd', p[..., 3 * BLOCK:3 * BLOCK + C], v_c))
    y = o.reshape(B, S, qd) @ w_o
    if with_ctx_queries:
        q_c = head_rms((hc @ w_qkv[:, :qd]).reshape(B, C, N_KV_HEADS, GQA_GROUP, HEAD_DIM), g_q)
        s_cc = jnp.einsum('bckgd,bjkd->bkgcj', q_c, k_c).astype(jnp.float32) * scale
        sink_c = jnp.broadcast_to(sink_h[None, :, :, None, None], s_cc.shape[:-1] + (1,))
        p_c = jax.nn.softmax(jnp.concatenate([s_cc, sink_c], axis=-1), axis=-1).astype(hc.dtype)
        o_c = jnp.einsum('bkgcj,bjkd->bckgd', p_c[..., :C], v_c)
        yc = o_c.reshape(B, C, qd) @ w_o
    else:
        yc = None
    return y, yc


def multiscale_pool(h, w_pool, pool_scale):
    B, S, D = h.shape
    h32 = h.astype(jnp.float32)
    csum = jnp.concatenate([jnp.zeros((B, 1, D), jnp.float32), jnp.cumsum(h32, axis=1)], axis=1)
    t = jnp.arange(S)
    outs = []
    for g, w in enumerate(POOL_WINDOWS):
        lo = jnp.clip(t - w // 2, 0, S)
        hi = jnp.clip(t + (w - w // 2), 0, S)
        cs = csum[..., g * POOL_GROUP:(g + 1) * POOL_GROUP]
        mean = (cs[:, hi] - cs[:, lo]) / (hi - lo).astype(jnp.float32)[:, None]
        outs.append(mean - h32[..., g * POOL_GROUP:(g + 1) * POOL_GROUP])
    d = jnp.stack(outs, axis=2).astype(h.dtype)
    y = jnp.einsum('bsgc,gcd->bsgd', d, w_pool).reshape(B, S, D)
    return y * pool_scale


def moe(h, w_router, b_router, w_gate, w_up, w_down, ws_gate, ws_up, ws_down):
    shape = h.shape
    t = h.reshape(-1, shape[-1])
    n = t.shape[0]
    s = jax.nn.sigmoid(t.astype(jnp.float32) @ w_router.astype(jnp.float32))
    sb = s + b_router.astype(jnp.float32)
    per = N_EXPERTS // N_EXPERT_GROUPS
    gscore = lax.top_k(sb.reshape(n, N_EXPERT_GROUPS, per), 2)[0].sum(-1)
    _, gidx = lax.top_k(gscore, TOPK_GROUPS)
    gmask = jnp.sum(jax.nn.one_hot(gidx, N_EXPERT_GROUPS, dtype=jnp.float32), axis=1) > 0
    emask = jnp.repeat(gmask, per, axis=1)
    _, eidx = lax.top_k(jnp.where(emask, sb, NEG), TOP_K)
    sel = jnp.take_along_axis(s, eidx, axis=1)
    sel = sel / jnp.sum(sel, axis=-1, keepdims=True) * ROUTED_SCALE
    gates = jnp.einsum('nk,nke->en', sel, jax.nn.one_hot(eidx, N_EXPERTS, dtype=jnp.float32)).astype(t.dtype)

    def expert_step(acc, p):
        wg, wu, wd, g = p
        hid = jax.nn.silu(t @ wg) * (t @ wu)
        return acc + (hid @ wd) * g[:, None], None

    routed, _ = lax.scan(expert_step, jnp.zeros_like(t), (w_gate, w_up, w_down, gates))
    shared = (jax.nn.silu(t @ ws_gate) * (t @ ws_up)) @ ws_down
    return (routed + shared).reshape(shape)


def setup_inputs(seed: int = 0) -> dict:
    key = jax.random.key(seed)
    ks = jax.random.split(key, 24)
    f32 = jnp.float32

    def nrm(k, shape, scale):
        return jax.random.normal(k, shape, f32) * scale

    D = D_MODEL
    qkv_w = (N_HEADS + 2 * N_KV_HEADS) * HEAD_DIM
    return {
        'x': nrm(ks[0], (BATCH, SEQ, D), 1.0),
        'c': nrm(ks[1], (BATCH, D), 1.0),
        'ctx': nrm(ks[2], (BATCH, CTX_LEN, D), 1.0),
        'c_ctx': nrm(ks[3], (D,), 1.0),
        'w_ada': nrm(ks[4], (DEPTH, D, 6 * D), 0.5 * D ** -0.5),
        'b_ada': nrm(ks[5], (DEPTH, 6 * D), 0.02),
        'g_norm1': 1.0 + nrm(ks[6], (DEPTH, D), 0.02),
        'g_norm2': 1.0 + nrm(ks[7], (DEPTH, D), 0.02),
        'w_qkv': nrm(ks[8], (N_ATTN_LAYERS, D, qkv_w), D ** -0.5),
        'g_q': 1.0 + nrm(ks[9], (N_ATTN_LAYERS, HEAD_DIM), 0.02),
        'g_k': 1.0 + nrm(ks[10], (N_ATTN_LAYERS, HEAD_DIM), 0.02),
        'sink': nrm(ks[11], (N_ATTN_LAYERS, N_HEADS), 0.5),
        'w_o': nrm(ks[12], (N_ATTN_LAYERS, N_HEADS * HEAD_DIM, D), (N_HEADS * HEAD_DIM) ** -0.5),
        'w_pool': nrm(ks[13], (N_POOL_LAYERS, len(POOL_WINDOWS), POOL_GROUP, POOL_GROUP), POOL_GROUP ** -0.5),
        'pool_scale': 1.0 + nrm(ks[14], (N_POOL_LAYERS, D), 0.02),
        'w_router': nrm(ks[15], (DEPTH, D, N_EXPERTS), D ** -0.5),
        'b_router': nrm(ks[16], (DEPTH, N_EXPERTS), 0.01),
        'w_gate': nrm(ks[17], (DEPTH, N_EXPERTS, D, EXPERT_FF), D ** -0.5),
        'w_up': nrm(ks[18], (DEPTH, N_EXPERTS, D, EXPERT_FF), D ** -0.5),
        'w_down': nrm(ks[19], (DEPTH, N_EXPERTS, EXPERT_FF, D), EXPERT_FF ** -0.5),
        'ws_gate': nrm(ks[20], (DEPTH, D, SHARED_FF), D ** -0.5),
        'ws_up': nrm(ks[21], (DEPTH, D, SHARED_FF), D ** -0.5),
        'ws_down': nrm(ks[22], (DEPTH, SHARED_FF, D), SHARED_FF ** -0.5),
    }


def reference(x, c, ctx, c_ctx, w_ada, b_ada, g_norm1, g_norm2, w_qkv, g_q, g_k, sink, w_o,
              w_pool, pool_scale, w_router, b_router, w_gate, w_up, w_down, ws_gate, ws_up, ws_down):
    S = x.shape[1]
    cos, sin = axial_rope(S, x.dtype)
    last_ctx_reader = max(i for i in range(DEPTH) if i % N_MIXERS == 0)
    for i in range(DEPTH):
        sh1, sc1, ga1, sh2, sc2, ga2 = [m[:, None, :] for m in adaln(c, w_ada[i], b_ada[i])]
        keep_ctx = i < last_ctx_reader
        is_attn = i % N_MIXERS == 0
        h = modulate(rmsnorm(x, g_norm1[i]), sh1, sc1)
        if is_attn or keep_ctx:
            csh1, csc1, cga1, csh2, csc2, cga2 = adaln(c_ctx, w_ada[i], b_ada[i])
            hc = modulate(rmsnorm(ctx, g_norm1[i]), csh1, csc1)
        if is_attn:
            a = i // N_MIXERS
            y, yc = windowed_sink_attention(h, hc, w_qkv[a], g_q[a], g_k[a], sink[a], w_o[a], cos, sin, keep_ctx)
        else:
            p = i // N_MIXERS
            y = multiscale_pool(h, w_pool[p], pool_scale[p])
            yc = multiscale_pool(hc, w_pool[p], pool_scale[p]) if keep_ctx else None
        x = x + ga1 * y
        x = x + ga2 * moe(modulate(rmsnorm(x, g_norm2[i]), sh2, sc2), w_router[i], b_router[i],
                          w_gate[i], w_up[i], w_down[i], ws_gate[i], ws_up[i], ws_down[i])
        if keep_ctx:
            ctx = ctx + cga1 * yc
            ctx = ctx + cga2 * moe(modulate(rmsnorm(ctx, g_norm2[i]), csh2, csc2), w_router[i], b_router[i],
                                   w_gate[i], w_up[i], w_down[i], ws_gate[i], ws_up[i], ws_down[i])
    return x
```

```cpp
#include <hip/hip_runtime.h>
#include <cstdio>
#include <cstdint>

#ifndef MK_N_LAUNCHES
#define MK_N_LAUNCHES 1
#endif

#define GAS __attribute__((address_space(1)))
#define LAS __attribute__((address_space(3)))
typedef unsigned short bf16;
typedef unsigned v4u __attribute__((ext_vector_type(4)));
typedef unsigned v2u __attribute__((ext_vector_type(2)));
typedef float f32x4 __attribute__((ext_vector_type(4)));
typedef float f32x2 __attribute__((ext_vector_type(2)));
typedef float f32x16 __attribute__((ext_vector_type(16)));
typedef short bf16x8 __attribute__((ext_vector_type(8)));
typedef short s16x4 __attribute__((ext_vector_type(4)));
typedef GAS unsigned gu32;
#define RLX_AGENT __ATOMIC_RELAXED, __HIP_MEMORY_SCOPE_AGENT
#define LDS_WAIT() asm volatile("s_waitcnt lgkmcnt(0)" ::: "memory")
#define VM_WAIT() asm volatile("s_waitcnt vmcnt(0)" ::: "memory")

constexpr int D = 2048, NB = 2, S = 8192, M = NB * S, CTX = 256, MC = NB * CTX, MT = M + MC;
constexpr int NH = 16, NKV = 4, HD = 128, NE = 64, FF = 512, TOPK = 8, NE1 = NE + 1;
constexpr int ECAP = 16384;
constexpr float EPS = 1e-6f;
constexpr int YROWS = M * 9 + 256;
constexpr int HID_TILES = 640;

constexpr size_t MiB = 1u << 20;
constexpr size_t WS_CTL = 0, CTL_ZERO_BYTES = 256 * 1024;
constexpr size_t WS_MOD = 1 * MiB;
constexpr size_t WS_ROPE = 2 * MiB;
constexpr size_t WS_WR = 3 * MiB;
constexpr size_t WS_SSQ = 5 * MiB;
constexpr size_t WS_TOK = 8 * MiB;
constexpr size_t WS_DST = 18 * MiB;
constexpr size_t WS_GW = 28 * MiB;
constexpr size_t LIST_L = 5 * MiB;
constexpr size_t WS_WQKV = 40 * MiB;
constexpr size_t WS_WO = 52 * MiB;
constexpr size_t WS_WPOOL = 60 * MiB;
constexpr size_t WS_W1 = 64 * MiB;
constexpr size_t WS_W2 = 584 * MiB;
constexpr size_t WS_ACTA = 844 * MiB;
constexpr size_t WS_ACTB = 910 * MiB;
constexpr size_t WS_ACTC = 974 * MiB;
constexpr size_t WS_KB = 1038 * MiB;
constexpr size_t WS_VT = 1055 * MiB;
constexpr size_t WS_X1 = 1072 * MiB;
constexpr size_t WS_HID = 1200 * MiB;
constexpr size_t WS_Y = 1360 * MiB;
constexpr size_t WS_END = 1940 * MiB;
static_assert(WS_Y + (size_t)YROWS * D * 2 <= WS_END, "ws map");
static_assert(WS_W1 + (size_t)2 * NE1 * 1024 * 2048 * 2 <= WS_W2 && WS_W2 + (size_t)2 * NE1 * 2048 * 512 * 2 <= WS_ACTA, "ws map");
constexpr int CW_BAR = 4096;
constexpr int CW_CNT = 16384;

constexpr int RING_BYTES = 131072;
constexpr int GTL_OFF = RING_BYTES;
constexpr int TOFF_OFF = GTL_OFF + 1024;
constexpr int MISC_OFF = TOFF_OFF + 512;
constexpr int LDS_BYTES = 155648;

__device__ __forceinline__ unsigned cvt_pk_bf16(float lo, float hi) { unsigned r; asm volatile("v_cvt_pk_bf16_f32 %0, %1, %2" : "=v"(r) : "v"(lo), "v"(hi)); return r; }
__device__ __forceinline__ float bf2f(unsigned short u) { return __uint_as_float((unsigned)u << 16); }
__device__ __forceinline__ float bflo(unsigned u) { return __uint_as_float(u << 16); }
__device__ __forceinline__ float bfhi(unsigned u) { return __uint_as_float(u & 0xffff0000u); }
__device__ __forceinline__ float wave_sum(float v) {
#pragma unroll
    for (int o = 1; o < 64; o <<= 1) v += __shfl_xor(v, o);
    return v;
}
__device__ __forceinline__ float fast_sigmoid(float x) { return __builtin_amdgcn_rcpf(1.0f + __builtin_amdgcn_exp2f(-1.4426950408889634f * x)); }

namespace pg8 {
constexpr int BM = 256, BK = 64, HALF = 128, HTB = HALF * BK * 2, STAGE_BYTES = 8 * HTB;
__host__ __device__ __forceinline__ int lds_byte(int r, int c) { const int st = (r >> 4) * 2 + (c >> 5), rr = r & 15, cc = c & 31, ob = rr * 64 + cc * 2; return st * 1024 + (ob ^ (((ob >> 9) & 1) << 5)); }
__host__ __device__ __forceinline__ void stage_rc(int b, int& R, int& C) { const int st = b / 1024, sb = b % 1024, swz = sb ^ (((sb >> 9) & 1) << 5); R = (st >> 1) * 16 + swz / 64; C = (st & 1) * 32 + (swz % 64) / 2; }
__host__ __device__ __forceinline__ int perm32(int rho) { const int n = rho >> 4, i = rho & 15; return 8 * (i >> 2) + 4 * n + (i & 3); }

struct GUnit { const char* A; const char* B; const unsigned* gtab; int i0, i1, i2, i3; };

template <class Epi, class Sched, bool GATHER>
__device__ __forceinline__ void gemm_phase(LAS unsigned char* lds, LAS unsigned* gtl, const int K, const int lda, const int ldb, const Sched& S, const Epi& E) {
    const int tid = threadIdx.x, wid = __builtin_amdgcn_readfirstlane(tid >> 6), lane = tid & 63, wr = wid >> 2, wc = wid & 3, fr = lane & 15, fq = lane >> 4;
    const int nt = K / BK;
    unsigned roA[2][2], voffB[2];
    int RA[2], CA[2];
#pragma unroll
    for (int i = 0; i < 2; ++i) { int R, C; stage_rc(tid * 16 + i * 8192, R, C); const int Rb = Epi::PERM ? ((R & ~31) + perm32(R & 31)) : R;
        RA[i] = R; CA[i] = C * 2; voffB[i] = (unsigned)(Rb * ldb + C) * 2u;
#pragma unroll
        for (int h = 0; h < 2; ++h) roA[h][i] = (unsigned)((h * HALF + R) * lda + C) * 2u; }
    const size_t kstep = (size_t)(BK * 2);
    const size_t hstepB = (size_t)HALF * ldb * 2;
    const unsigned lda2 = (unsigned)lda * 2u;
    const unsigned ldsw = (unsigned)wid * 1024u;
    const int aoff = lds_byte(wr * 64 + fr, fq * 8), boff = lds_byte(wc * 32 + fr, fq * 8);
#define PG8_SA(b, h) (((b) * 2 + (h)) * HTB)
#define PG8_SB(b, h) ((4 + (b) * 2 + (h)) * HTB)
#define PG8_STAGE(bufoff, gbase, voff) do { _Pragma("unroll") for (int _i = 0; _i < 2; ++_i) \
        __builtin_amdgcn_global_load_lds((const unsigned*)((const char*)(gbase) + (voff)[_i]), (LAS unsigned*)(lds + (bufoff) + ldsw + _i * 8192), 16, 0, 0); } while (0)
#define PG8_STAGE_A(bufoff, gbase, h) PG8_STAGE(bufoff, gbase, roA[h])
#define PG8_LDA(dst, b, h) do { _Pragma("unroll") for (int m = 0; m < 4; ++m) _Pragma("unroll") for (int k = 0; k < 2; ++k) dst[m][k] = *(const LAS bf16x8*)(lds + PG8_SA(b, h) + aoff + m * 2048 + k * 1024); } while (0)
#define PG8_LDB(dst, b, h) do { _Pragma("unroll") for (int n = 0; n < 2; ++n) _Pragma("unroll") for (int k = 0; k < 2; ++k) dst[n][k] = *(const LAS bf16x8*)(lds + PG8_SB(b, h) + boff + n * 2048 + k * 1024); } while (0)
#define PG8_MMA(ai, bj, At, Bt) do { __builtin_amdgcn_s_setprio(1); _Pragma("unroll") for (int m = 0; m < 4; ++m) _Pragma("unroll") for (int n = 0; n < 2; ++n) _Pragma("unroll") for (int k = 0; k < 2; ++k) \
        acc[ai][bj][m][n] = __builtin_amdgcn_mfma_f32_16x16x32_bf16(Bt[n][k], At[m][k], acc[ai][bj][m][n], 0, 0, 0); __builtin_amdgcn_s_setprio(0); } while (0)
#define PG8_WAIT_V(n) asm volatile("s_waitcnt vmcnt(" #n ")" ::: "memory")
#define PG8_WAIT_L(n) asm volatile("s_waitcnt lgkmcnt(" #n ")" ::: "memory")
#define PG8_BAR __builtin_amdgcn_s_barrier()
#define PG8_SCHED __builtin_amdgcn_sched_barrier(0)
#define PG8_LOAD_RO() do { _Pragma("unroll") for (int _h = 0; _h < 2; ++_h) _Pragma("unroll") for (int _i = 0; _i < 2; ++_i) roA[_h][_i] = gtl[_h * HALF + RA[_i]] * lda2 + (unsigned)CA[_i]; } while (0)
    GUnit cur, nxt; int ui = 0;
    if (!S.next(0, cur)) return;
    f32x4 acc[2][2][4][2];
#pragma unroll
    for (int a = 0; a < 2; ++a)
#pragma unroll
        for (int b = 0; b < 2; ++b)
#pragma unroll
            for (int m = 0; m < 4; ++m)
#pragma unroll
                for (int n = 0; n < 2; ++n) acc[a][b][m][n] = (f32x4){0.f, 0.f, 0.f, 0.f};
    bf16x8 At[4][2], B0[2][2], B1[2][2];
    const char* cA = cur.A; const char* cB = cur.B;
    if constexpr (GATHER) {
        if (wid < 4) __builtin_amdgcn_global_load_lds((const unsigned*)(cur.gtab + wid * 64 + lane), (LAS unsigned*)(gtl + wid * 64), 4, 0, 0);
        PG8_WAIT_V(0); PG8_BAR; asm volatile("" ::: "memory");
        PG8_LOAD_RO();
        PG8_WAIT_L(0); PG8_BAR; asm volatile("" ::: "memory");
    }
    PG8_STAGE(PG8_SB(0, 0), cB, voffB); PG8_STAGE(PG8_SB(0, 1), cB + hstepB, voffB); PG8_STAGE_A(PG8_SA(0, 0), cA, 0); PG8_STAGE_A(PG8_SA(0, 1), cA, 1);
    if (wr == 1) PG8_BAR;
    PG8_WAIT_V(2); PG8_BAR;
    PG8_STAGE(PG8_SB(1, 0), cB + kstep, voffB); PG8_STAGE_A(PG8_SA(1, 0), cA + kstep, 0); PG8_STAGE(PG8_SB(1, 1), cB + hstepB + kstep, voffB);
    PG8_WAIT_V(6); PG8_BAR;
    for (;;) {
        const bool has_next = S.next(ui + 1, nxt);
        const char* nA = has_next ? nxt.A : cA; const char* nB = has_next ? nxt.B : cB;
        for (int t = 0; t < nt; t += 2) {
            const bool last = (t == nt - 2);
            const char* a1 = cA + (size_t)(t + 1) * kstep;
            const char* a2 = last ? nA : cA + (size_t)(t + 2) * kstep; const char* b2 = last ? nB : cB + (size_t)(t + 2) * kstep;
            const char* a3 = a2 + kstep; const char* b3 = b2 + kstep;
            if constexpr (GATHER) {
                if (has_next && t == nt - 4 && wid < 4) __builtin_amdgcn_global_load_lds((const unsigned*)(nxt.gtab + wid * 64 + lane), (LAS unsigned*)(gtl + wid * 64), 4, 0, 0);
            }
            PG8_LDB(B0, 0, 0); PG8_LDB(B1, 0, 1); PG8_SCHED; PG8_LDA(At, 0, 0); PG8_STAGE_A(PG8_SA(1, 1), a1, 1);
            PG8_WAIT_V(8); PG8_WAIT_L(0); PG8_BAR; PG8_MMA(0, 0, At, B0); PG8_MMA(0, 1, At, B1); PG8_BAR; PG8_SCHED;
            if constexpr (GATHER) { if (last && has_next) { asm volatile("" ::: "memory"); PG8_LOAD_RO(); } }
            PG8_LDA(At, 0, 1); PG8_STAGE(PG8_SB(0, 0), b2, voffB); PG8_STAGE(PG8_SB(0, 1), b2 + hstepB, voffB); PG8_STAGE_A(PG8_SA(0, 0), a2, 0);
            PG8_WAIT_V(8); PG8_WAIT_L(0); PG8_BAR; PG8_MMA(1, 0, At, B0); PG8_MMA(1, 1, At, B1); PG8_BAR; PG8_SCHED;
            PG8_LDB(B0, 1, 0); PG8_LDB(B1, 1, 1); PG8_SCHED; PG8_LDA(At, 1, 0); PG8_STAGE_A(PG8_SA(0, 1), a2, 1);
            PG8_WAIT_V(8); PG8_WAIT_L(0); PG8_BAR; PG8_MMA(0, 0, At, B0); PG8_MMA(0, 1, At, B1); PG8_BAR; PG8_SCHED;
            PG8_LDA(At, 1, 1); PG8_STAGE(PG8_SB(1, 0), b3, voffB); PG8_STAGE(PG8_SB(1, 1), b3 + hstepB, voffB); PG8_STAGE_A(PG8_SA(1, 0), a3, 0);
            PG8_WAIT_V(8); PG8_WAIT_L(0); PG8_BAR; PG8_MMA(1, 0, At, B0); PG8_MMA(1, 1, At, B1); PG8_BAR; PG8_SCHED;
        }
        if (wr == 0) PG8_BAR;
        E(acc, cur, wr, wc, fr, fq);
        if (!has_next) break;
#pragma unroll
        for (int a = 0; a < 2; ++a)
#pragma unroll
            for (int b = 0; b < 2; ++b)
#pragma unroll
                for (int m = 0; m < 4; ++m)
#pragma unroll
                    for (int n = 0; n < 2; ++n) acc[a][b][m][n] = (f32x4){0.f, 0.f, 0.f, 0.f};
        cur = nxt; cA = nA; cB = nB; ++ui;
        if (wr == 1) PG8_BAR;
    }
    PG8_WAIT_V(0);
    PG8_BAR;
#undef PG8_SA
#undef PG8_SB
#undef PG8_STAGE
#undef PG8_STAGE_A
#undef PG8_LDA
#undef PG8_LDB
#undef PG8_MMA
#undef PG8_WAIT_V
#undef PG8_WAIT_L
#undef PG8_BAR
#undef PG8_SCHED
#undef PG8_LOAD_RO
}
}

#define XB_TMO      128
#define XB_XCNT(j)  (256  + 64 * (j))
#define XB_XSUB(j)  (1280 + 64 * (j))
#define XB_XGEN(j)  (2304 + 64 * (j))
#define XB_TOP      3328
#define XB_TOPGEN   3392
#define XCD_BAR_WORDS 3456
#define XB_SPIN_CAP (1u << 18)

__device__ __forceinline__ unsigned xb_ld(unsigned* p)              { return __hip_atomic_load(p, __ATOMIC_RELAXED, __HIP_MEMORY_SCOPE_AGENT); }
__device__ __forceinline__ unsigned xb_add(unsigned* p, unsigned v) { return __hip_atomic_fetch_add(p, v, __ATOMIC_RELAXED, __HIP_MEMORY_SCOPE_AGENT); }
__device__ __forceinline__ unsigned xb_xcc_id() { return (unsigned)__builtin_amdgcn_s_getreg((3 << 11) | 20) & 0xFu; }
#define XB_SPIN(cond, bar) do { unsigned _sp = 0; while (cond) { __builtin_amdgcn_s_sleep(1); \
    if ((++_sp & 255u) == 0u) { if (xb_ld(&(bar)[XB_TMO])) break; if (_sp > XB_SPIN_CAP) { atomicAdd(&(bar)[XB_TMO], 1u); break; } } } } while (0)

struct XcdBarrier { unsigned* bar; unsigned x; volatile LAS unsigned* st; };

__device__ __forceinline__ XcdBarrier xcd_barrier_post(unsigned* bar, volatile LAS unsigned* st) {
    XcdBarrier b; b.bar = bar; b.x = xb_xcc_id(); b.st = st;
    if (threadIdx.x == 0) (void)xb_add(&bar[XB_XCNT(b.x)], 1u);
    return b;
}
__device__ __forceinline__ void xcd_barrier_complete(unsigned* bar, unsigned x, unsigned& nloc, unsigned& nx) {
    const unsigned G = gridDim.x * gridDim.y * gridDim.z;
    unsigned sum, cnt, mine, sp = 0u;
    for (;;) {
        sum = 0u; cnt = 0u; mine = 0u;
#pragma unroll
        for (unsigned j = 0; j < 16; ++j) { const unsigned c = xb_ld(&bar[XB_XCNT(j)]); sum += c; cnt += (c > 0u) ? 1u : 0u; mine = (j == x) ? c : mine; }
        if (sum == G) break;
        __builtin_amdgcn_s_sleep(1);
        if ((++sp & 255u) == 0u) { if (xb_ld(&bar[XB_TMO])) break; if (sp > XB_SPIN_CAP) { atomicAdd(&bar[XB_TMO], 1u); break; } }
    }
    nloc = mine > 0u ? mine : 1u; nx = cnt > 0u ? cnt : 1u;
}
__device__ __forceinline__ void xcd_barrier(const XcdBarrier& b) {
    asm volatile("s_waitcnt vmcnt(0)" ::: "memory");
    __syncthreads();
    if (threadIdx.x == 0) {
        unsigned* bar = b.bar;
        __builtin_amdgcn_s_waitcnt(0);
        unsigned nloc = b.st[0], nx = b.st[1];
        if (nloc == 0u) { xcd_barrier_complete(bar, b.x, nloc, nx); b.st[0] = nloc; b.st[1] = nx; }
        const unsigned old = xb_add(&bar[XB_XSUB(b.x)], 1u);
        const unsigned gen = old / nloc;
        if (old + 1u == (gen + 1u) * nloc) {
            __builtin_amdgcn_fence(__ATOMIC_RELEASE, "agent");
            asm volatile("s_waitcnt vmcnt(0)" ::: "memory");
            const unsigned og = xb_add(&bar[XB_TOP], 1u);
            const unsigned tg = og / nx;
            if (og + 1u == (tg + 1u) * nx) xb_add(&bar[XB_TOPGEN], 1u);
            else XB_SPIN(xb_ld(&bar[XB_TOPGEN]) == tg, bar);
            __builtin_amdgcn_fence(__ATOMIC_ACQUIRE, "agent");
            xb_add(&bar[XB_XGEN(b.x)], 1u);
            asm volatile("s_waitcnt vmcnt(0)" ::: "memory");
        } else {
            XB_SPIN(xb_ld(&bar[XB_XGEN(b.x)]) == gen, bar);
            __builtin_amdgcn_fence(__ATOMIC_ACQUIRE, "agent");
            asm volatile("s_waitcnt vmcnt(0)" ::: "memory");
        }
    }
    __syncthreads();
}

constexpr int NWAVES = 8, NTHR = 512;
struct Args { const float* in[23]; float* out; unsigned char* ws; int ph_lo, ph_hi; };
struct Frame {
    LAS unsigned char* lds;
    int tid, lane, wave, vcu, G;
    unsigned char* ws;
    const float* const* in;
};
enum { I_X = 0, I_C, I_CTX, I_CCTX, I_WADA, I_BADA, I_G1, I_G2, I_WQKV, I_GQ, I_GK, I_SINK, I_WO, I_WPOOL, I_PSCALE, I_WR, I_BR, I_WG, I_WU, I_WD, I_SG, I_SU, I_SD };

__device__ __forceinline__ unsigned f2bf(float f) { unsigned u = __builtin_bit_cast(unsigned, f); return (u + 0x7fffu + ((u >> 16) & 1u)) >> 16; }
__device__ __forceinline__ unsigned pk2(float lo, float hi) { return f2bf(lo) | (f2bf(hi) << 16); }
__device__ __forceinline__ void p0_transpose_item(const float* W, int N, bf16* WT, int ldt, int drow0, int k0, int n0, LAS float* scr, int lane) {
#pragma unroll 16
    for (int i = 0; i < 32; ++i) { const int kk = 2 * i + (lane >> 5); scr[kk * 33 + (lane & 31)] = W[(size_t)(k0 + kk) * N + n0 + (lane & 31)]; }
    LDS_WAIT(); asm volatile("" ::: "memory");
    const int c = lane & 7;
#pragma unroll
    for (int j = 0; j < 4; ++j) { const int n = (lane >> 3) + 8 * j; const LAS float* s = scr + (8 * c) * 33 + n;
        v4u o; o.x = pk2(s[0 * 33], s[1 * 33]); o.y = pk2(s[2 * 33], s[3 * 33]); o.z = pk2(s[4 * 33], s[5 * 33]); o.w = pk2(s[6 * 33], s[7 * 33]);
        *(GAS v4u*)(WT + (size_t)(drow0 + n) * ldt + k0 + 8 * c) = o; }
    LDS_WAIT(); asm volatile("" ::: "memory");
}

__device__ __forceinline__ void p0_prologue(Frame& F) {
    const int gw = F.vcu * NWAVES + F.wave, NGW = F.G * NWAVES;
    const int gtid = gw * 64 + F.lane, NGT = NGW * 64;
    unsigned char* ws = F.ws;
    if (F.vcu < 96) {
        const int l = F.vcu / 48, jg = F.vcu % 48, j0 = jg * 256;
        LAS float* sil = (LAS float*)F.lds;
        LAS float* red = (LAS float*)(F.lds + 24576);
        for (int i = F.tid; i < 3 * D; i += NTHR) { const int r = i / D, k = i % D; const float v = (r < 2) ? F.in[I_C][r * D + k] : F.in[I_CCTX][k]; sil[i] = v * fast_sigmoid(v); }
        __syncthreads();
        const float* wa = F.in[I_WADA] + (size_t)l * D * (6 * D) + j0 + F.lane * 4;
        f32x4 a0 = {0.f, 0.f, 0.f, 0.f}, a1 = a0, a2 = a0;
        const int kb = F.wave * 256;
#pragma unroll 8
        for (int k = 0; k < 256; ++k) { const f32x4 w = *(const GAS f32x4*)(wa + (size_t)(kb + k) * (6 * D)); const float s0 = sil[kb + k], s1 = sil[D + kb + k], s2 = sil[2 * D + kb + k]; a0 += w * s0; a1 += w * s1; a2 += w * s2; }
        *(LAS f32x4*)(red + (F.wave * 3 + 0) * 256 + F.lane * 4) = a0; *(LAS f32x4*)(red + (F.wave * 3 + 1) * 256 + F.lane * 4) = a1; *(LAS f32x4*)(red + (F.wave * 3 + 2) * 256 + F.lane * 4) = a2;
        __syncthreads();
        for (int i = F.tid; i < 768; i += NTHR) { const int r = i / 256, c = i % 256; float s = F.in[I_BADA][l * 6 * D + j0 + c];
#pragma unroll
            for (int w = 0; w < 8; ++w) s += red[(w * 3 + r) * 256 + c];
            ((float*)(ws + WS_MOD))[(size_t)(l * 3 + r) * 6 * D + j0 + c] = s; }
        __syncthreads();
    }
    for (int l = 0; l < 2; ++l) {
        v4u* t4 = (v4u*)(ws + WS_TOK + l * LIST_L); v4u* d4 = (v4u*)(ws + WS_DST + l * LIST_L);
        for (int i = gtid; i < NE * ECAP / 4; i += NGT) { t4[i] = (v4u){0u, 0u, 0u, 0u}; d4[i] = (v4u){0u, 0u, 0u, 0u}; }
        unsigned* ts = (unsigned*)(ws + WS_TOK + l * LIST_L) + NE * ECAP; unsigned* ds = (unsigned*)(ws + WS_DST + l * LIST_L) + NE * ECAP; float* gs = (float*)(ws + WS_GW + l * LIST_L) + NE * ECAP;
        for (int i = gtid; i < M; i += NGT) { ts[i] = (unsigned)i; ds[i] = (unsigned)(i * 9 + 8 + 1); gs[i] = 1.0f; }
    }
    for (int i = gtid; i < 128 * 32; i += NGT) { const int p = i >> 5, f = i & 31; const float inv = powf(10000.0f, -(float)f / 32.0f); const float a = (float)p * inv;
        ((float*)(ws + WS_ROPE))[i] = cosf(a); ((float*)(ws + WS_ROPE))[4096 + i] = sinf(a); }
    for (int i = gtid; i < 2 * NE * D; i += NGT) { const int l = i / (NE * D), r = i % (NE * D), e = r / D, k = r % D; const float w = F.in[I_WR][((size_t)l * D + k) * NE + e];
        const unsigned hi = f2bf(w); const float lo = w - __uint_as_float(hi << 16);
        bf16* wr = (bf16*)(ws + WS_WR) + (size_t)l * 2 * NE * D; wr[e * D + k] = (bf16)hi; wr[NE * D + e * D + k] = (bf16)f2bf(lo); }
    LAS float* scr = (LAS float*)(F.lds + F.wave * 16384);
    constexpr int IT_QKV = 32 * 96, IT_WO = 32 * 64, IT_POOL = 4 * 128, IT_BASE = IT_QKV + IT_WO + IT_POOL, IT_ALL = IT_BASE + 2 * NE1 * 3 * 512;
    for (int it = gw; it < IT_ALL; it += NGW) {
        if (it < IT_QKV) { const int kb = it / 96, nb = it % 96; p0_transpose_item(F.in[I_WQKV], 3072, (bf16*)(ws + WS_WQKV), D, nb * 32, kb * 64, nb * 32, scr, F.lane); continue; }
        int r = it - IT_QKV;
        if (r < IT_WO) { const int kb = r / 64, nb = r % 64; p0_transpose_item(F.in[I_WO], D, (bf16*)(ws + WS_WO), D, nb * 32, kb * 64, nb * 32, scr, F.lane); continue; }
        r -= IT_WO;
        if (r < IT_POOL) { const int g = r / 128, r2 = r % 128, kb = r2 / 16, nb = r2 % 16; p0_transpose_item(F.in[I_WPOOL] + (size_t)g * 512 * 512, 512, (bf16*)(ws + WS_WPOOL) + (size_t)g * 512 * 512, 512, nb * 32, kb * 64, nb * 32, scr, F.lane); continue; }
        r -= IT_POOL;
        const int m = r >> 9, r2 = r & 511, type = m % 3, le = m / 3, l = le / NE1, e = le % NE1;
        if (type < 2) {
            const int kb = r2 / 16, nb = r2 % 16, n0 = nb * 32;
            const float* src = (e < NE) ? (F.in[type == 0 ? I_WG : I_WU] + (size_t)(l * NE + e) * D * FF) : (F.in[type == 0 ? I_SG : I_SU] + (size_t)l * D * FF);
            bf16* dst = (bf16*)(ws + WS_W1) + (size_t)(l * NE1 + e) * 1024 * D;
            p0_transpose_item(src, FF, dst, D, (n0 / 128) * 256 + (n0 % 128) + (type == 1 ? 128 : 0), kb * 64, n0, scr, F.lane);
        } else {
            const int kb = r2 / 64, nb = r2 % 64;
            const float* src = (e < NE) ? (F.in[I_WD] + (size_t)(l * NE + e) * FF * D) : (F.in[I_SD] + (size_t)l * FF * D);
            bf16* dst = (bf16*)(ws + WS_W2) + (size_t)(l * NE1 + e) * D * FF;
            p0_transpose_item(src, D, dst, FF, nb * 32, kb * 64, nb * 32, scr, F.lane);
        }
    }
}

struct ModVec { f32x4 a[8], b[8]; };
__device__ __forceinline__ void load_modvec(ModVec& mv, const float* gnorm, const float* shift, const float* scale, int lane) {
#pragma unroll
    for (int jj = 0; jj < 8; ++jj) { const int col = 4 * lane + 256 * jj;
        const f32x4 g = *(const GAS f32x4*)(gnorm + col), sc = *(const GAS f32x4*)(scale + col); mv.a[jj] = g * (sc + 1.0f); mv.b[jj] = *(const GAS f32x4*)(shift + col); }
}
__device__ __forceinline__ void norm_mod_store(const f32x4 (&v)[8], const ModVec& mv, bf16* orow, int lane) {
    float ss = 0.f;
#pragma unroll
    for (int jj = 0; jj < 8; ++jj) ss += (v[jj].x * v[jj].x + v[jj].y * v[jj].y) + (v[jj].z * v[jj].z + v[jj].w * v[jj].w);
    const float rstd = 1.0f / sqrtf(wave_sum(ss) * (1.0f / D) + EPS);
#pragma unroll
    for (int jj = 0; jj < 8; ++jj) { const f32x4 o = v[jj] * rstd * mv.a[jj] + mv.b[jj]; v2u w; w.x = cvt_pk_bf16(o.x, o.y); w.y = cvt_pk_bf16(o.z, o.w);
        *(GAS v2u*)(orow + 4 * lane + 256 * jj) = w; }
}
__device__ __forceinline__ const float* modp(Frame& F, int l, int r, int which) { return (const float*)(F.ws + WS_MOD) + (size_t)(l * 3 + r) * 6 * D + which * D; }

__device__ __forceinline__ void p1_norm1(Frame& F) {
    const int gw = F.vcu * NWAVES + F.wave, NGW = F.G * NWAVES;
    bf16* HN = (bf16*)(F.ws + WS_ACTA);
    for (int rb = gw; rb < M / 8; rb += NGW) {
        const int row0 = rb * 8, b = row0 / S;
        ModVec mv; load_modvec(mv, F.in[I_G1], modp(F, 0, b, 0), modp(F, 0, b, 1), F.lane);
        for (int j = 0; j < 8; ++j) { const int row = row0 + j; f32x4 v[8];
#pragma unroll
            for (int jj = 0; jj < 8; ++jj) v[jj] = *(const GAS f32x4*)(F.in[I_X] + (size_t)row * D + 4 * F.lane + 256 * jj);
            norm_mod_store(v, mv, HN + (size_t)row * D, F.lane); }
    }
    for (int r = gw; r < MC; r += NGW) {
        ModVec mv; load_modvec(mv, F.in[I_G1], modp(F, 0, 2, 0), modp(F, 0, 2, 1), F.lane);
        f32x4 v[8];
#pragma unroll
        for (int jj = 0; jj < 8; ++jj) v[jj] = *(const GAS f32x4*)(F.in[I_CTX] + (size_t)r * D + 4 * F.lane + 256 * jj);
        norm_mod_store(v, mv, HN + (size_t)(M + r) * D, F.lane);
    }
}

using pg8::GUnit;
struct SchedQK { const char* A; const char* B; int G, c;
    __device__ __forceinline__ bool next(int i, GUnit& u) const { const int L = i * G + c; if (L >= 644) return false; int pm, pn; if (L < 640) { pm = L / 10; pn = L % 10; } else { pm = 64 + (L - 640) / 2; pn = 8 + (L - 640) % 2; }
        u.A = A + (size_t)pm * 256 * D * 2; u.B = B + (size_t)pn * 256 * D * 2; u.gtab = nullptr; u.i0 = pm; u.i1 = pn; u.i2 = 0; u.i3 = 0; return true; } };
struct EpiQK { static constexpr bool PERM = true; bf16* Q; bf16* Kb;
    __device__ __forceinline__ void operator()(const f32x4 (&acc)[2][2][4][2], const GUnit& u, int wr, int wc, int fr, int fq) const {
        const int pm = u.i0, pn = u.i1; bf16* base; int ldc, colt;
        if (pn < 8) { base = Q; ldc = D; colt = pn * 256; } else { base = Kb; ldc = 512; colt = (pn - 8) * 256; }
        const int row0 = pm * 256 + wr * 64 + fr, col0 = colt + wc * 32 + 8 * fq;
#pragma unroll
        for (int ai = 0; ai < 2; ++ai)
#pragma unroll
            for (int m = 0; m < 4; ++m) { bf16* rowp = base + (size_t)(row0 + ai * 128 + m * 16) * ldc + col0;
#pragma unroll
                for (int bj = 0; bj < 2; ++bj) { const f32x4 v0 = acc[ai][bj][m][0], v1 = acc[ai][bj][m][1]; v4u w; w.x = cvt_pk_bf16(v0[0], v0[1]); w.y = cvt_pk_bf16(v0[2], v0[3]); w.z = cvt_pk_bf16(v1[0], v1[1]); w.w = cvt_pk_bf16(v1[2], v1[3]);
                    *(GAS v4u*)(rowp + bj * 128) = w; } }
    } };
struct SchedVT { const char* A; const char* B; int G, c;
    __device__ __forceinline__ bool next(int i, GUnit& u) const { const int L = i * G + c; if (L >= 132) return false; const int pmv = L % 2, pnv = L / 2;
        u.A = A + (size_t)pmv * 256 * D * 2; u.B = B + (size_t)pnv * 256 * D * 2; u.gtab = nullptr; u.i0 = pmv; u.i1 = pnv; u.i2 = 0; u.i3 = 0; return true; } };
struct EpiVT { static constexpr bool PERM = true; bf16* Vt;
    __device__ __forceinline__ void operator()(const f32x4 (&acc)[2][2][4][2], const GUnit& u, int wr, int wc, int fr, int fq) const {
        const int row0 = u.i0 * 256 + wr * 64 + fr, col0 = u.i1 * 256 + wc * 32 + 8 * fq;
#pragma unroll
        for (int ai = 0; ai < 2; ++ai)
#pragma unroll
            for (int m = 0; m < 4; ++m) { bf16* rowp = Vt + (size_t)(row0 + ai * 128 + m * 16) * MT + col0;
#pragma unroll
                for (int bj = 0; bj < 2; ++bj) { const f32x4 v0 = acc[ai][bj][m][0], v1 = acc[ai][bj][m][1]; v4u w; w.x = cvt_pk_bf16(v0[0], v0[1]); w.y = cvt_pk_bf16(v0[2], v0[3]); w.z = cvt_pk_bf16(v1[0], v1[1]); w.w = cvt_pk_bf16(v1[2], v1[3]);
                    *(GAS v4u*)(rowp + bj * 128) = w; } }
    } };
struct SchedRes { const char* A; const char* B; int G, c, mode;
    __device__ __forceinline__ bool next(int i, GUnit& u) const { const int L = i * G + c; if (L >= 512) return false; const int pm = L / 8, pn = L % 8;
        if (mode == 0) { u.A = A + (size_t)pm * 256 * D * 2; u.B = B + (size_t)pn * 256 * D * 2; }
        else { const int g = pn / 2, p2 = pn % 2; u.A = A + (size_t)pm * 256 * D * 2 + (size_t)g * 512 * 2; u.B = B + ((size_t)g * 512 + p2 * 256) * 512 * 2; }
        u.gtab = nullptr; u.i0 = pm; u.i1 = pn; u.i2 = 0; u.i3 = 0; return true; } };
struct EpiRes { static constexpr bool PERM = false; const float* base; float* out; const float* gate0; const float* gate1; const float* cs; float* ssq;
    __device__ __forceinline__ void operator()(const f32x4 (&acc)[2][2][4][2], const GUnit& u, int wr, int wc, int fr, int fq) const {
        const int pm = u.i0, pn = u.i1; const float* gate = (pm < 32) ? gate0 : gate1;
        const int col0 = pn * 256 + wc * 32 + 4 * fq;
        f32x4 gv[2][2];
#pragma unroll
        for (int bj = 0; bj < 2; ++bj)
#pragma unroll
            for (int n = 0; n < 2; ++n) { gv[bj][n] = *(const GAS f32x4*)(gate + col0 + bj * 128 + n * 16); if (cs) gv[bj][n] = gv[bj][n] * *(const GAS f32x4*)(cs + col0 + bj * 128 + n * 16); }
#pragma unroll
        for (int ai = 0; ai < 2; ++ai)
#pragma unroll
            for (int m = 0; m < 4; ++m) { const int row = pm * 256 + ai * 128 + wr * 64 + m * 16 + fr; const size_t off = (size_t)row * D + col0; float s = 0.f;
#pragma unroll
                for (int bj = 0; bj < 2; ++bj)
#pragma unroll
                    for (int n = 0; n < 2; ++n) { const f32x4 bs = *(const GAS f32x4*)(base + off + bj * 128 + n * 16); const f32x4 o = bs + gv[bj][n] * acc[ai][bj][m][n];
                        *(GAS f32x4*)(out + off + bj * 128 + n * 16) = o; s += (o.x * o.x + o.y * o.y) + (o.z * o.z + o.w * o.w); }
                s += __shfl_xor(s, 16); s += __shfl_xor(s, 32);
                if (fq == 0) ssq[(size_t)row * 32 + pn * 4 + wc] = s; }
    } };
__device__ __forceinline__ int moe_expert_of(const LAS int* toff, int ti, int lane) {
    const int v = toff[lane + 1]; const unsigned long long bal = __ballot(v <= ti); return (int)__popcll(bal); }
struct SchedMoe1 { const char* A; const char* W1; const unsigned* tok; const LAS int* toff; int G, c, lane;
    __device__ __forceinline__ bool next(int i, GUnit& u) const { const int L = i * G + c, ti = L / 4, pn = L % 4; if (ti >= toff[65]) return false;
        const int e = moe_expert_of(toff, ti, lane), tl = ti - toff[e];
        u.A = A; u.B = W1 + ((size_t)e * 1024 + pn * 256) * D * 2; u.gtab = tok + (size_t)e * ECAP + tl * 256; u.i0 = ti; u.i1 = pn; u.i2 = e; u.i3 = tl; return true; } };
struct EpiMoe1 { static constexpr bool PERM = true; bf16* HID;
    __device__ __forceinline__ void operator()(const f32x4 (&acc)[2][2][4][2], const GUnit& u, int wr, int wc, int fr, int fq) const {
        const int row0 = u.i0 * 256 + wr * 64 + fr, col0 = u.i1 * 128 + wc * 32 + 8 * fq;
#pragma unroll
        for (int ai = 0; ai < 2; ++ai)
#pragma unroll
            for (int m = 0; m < 4; ++m) { float h[8];
#pragma unroll
                for (int n = 0; n < 2; ++n)
#pragma unroll
                    for (int j = 0; j < 4; ++j) { const float g = acc[ai][0][m][n][j], up = acc[ai][1][m][n][j]; h[n * 4 + j] = g * fast_sigmoid(g) * up; }
                v4u w; w.x = cvt_pk_bf16(h[0], h[1]); w.y = cvt_pk_bf16(h[2], h[3]); w.z = cvt_pk_bf16(h[4], h[5]); w.w = cvt_pk_bf16(h[6], h[7]);
                *(GAS v4u*)(HID + (size_t)(row0 + ai * 128 + m * 16) * FF + col0) = w; }
    } };
struct SchedMoe2 { const char* A; const char* W2; const LAS int* toff; int G, c, lane;
    __device__ __forceinline__ bool next(int i, GUnit& u) const { const int L = i * G + c, ti = L / 8, pn = L % 8; if (ti >= toff[65]) return false;
        const int e = moe_expert_of(toff, ti, lane), tl = ti - toff[e];
        u.A = A + (size_t)ti * 256 * FF * 2; u.B = W2 + ((size_t)e * D + pn * 256) * FF * 2; u.gtab = nullptr; u.i0 = ti; u.i1 = pn; u.i2 = e; u.i3 = tl; return true; } };
struct EpiMoe2 { static constexpr bool PERM = true; bf16* Y; const unsigned* dst; const float* gw;
    __device__ __forceinline__ void operator()(const f32x4 (&acc)[2][2][4][2], const GUnit& u, int wr, int wc, int fr, int fq) const {
        const int pn = u.i1, e = u.i2, tl = u.i3; const int r0 = tl * 256 + wr * 64 + fr, col0 = pn * 256 + wc * 32 + 8 * fq;
        const unsigned* dp = dst + (size_t)e * ECAP; const float* gp = gw + (size_t)e * ECAP;
#pragma unroll
        for (int ai = 0; ai < 2; ++ai)
#pragma unroll
            for (int m = 0; m < 4; ++m) { const int r = r0 + ai * 128 + m * 16; const unsigned dv = dp[r]; const float g = gp[r]; const unsigned drow = dv ? dv - 1u : (unsigned)(M * 9);
                bf16* rowp = Y + (size_t)drow * D + col0;
#pragma unroll
                for (int bj = 0; bj < 2; ++bj) { const f32x4 v0 = acc[ai][bj][m][0] * g, v1 = acc[ai][bj][m][1] * g; v4u w; w.x = cvt_pk_bf16(v0[0], v0[1]); w.y = cvt_pk_bf16(v0[2], v0[3]); w.z = cvt_pk_bf16(v1[0], v1[1]); w.w = cvt_pk_bf16(v1[2], v1[3]);
                    *(GAS v4u*)(rowp + bj * 128) = w; } }
    } };

constexpr float QSCALE = 0.08838834764831845f * 1.4426950408889634f;
__device__ __forceinline__ void qk_fix(bf16* ptr, const f32x4 g, const f32x4 cs, const f32x4 sn, int half, float scale) {
    const v2u raw = *(const GAS v2u*)ptr;
    f32x4 x = {bflo(raw.x), bfhi(raw.x), bflo(raw.y), bfhi(raw.y)};
    float ss = (x.x * x.x + x.y * x.y) + (x.z * x.z + x.w * x.w);
#pragma unroll
    for (int o = 1; o < 32; o <<= 1) ss += __shfl_xor(ss, o);
    const float r = 1.0f / sqrtf(ss * (1.0f / HD) + EPS);
    const f32x4 y = x * r * g;
    f32x4 p; p.x = __shfl_xor(y.x, 8); p.y = __shfl_xor(y.y, 8); p.z = __shfl_xor(y.z, 8); p.w = __shfl_xor(y.w, 8);
    const f32x4 o = (half ? (y * cs + p * sn) : (y * cs - p * sn)) * scale;
    v2u w; w.x = cvt_pk_bf16(o.x, o.y); w.y = cvt_pk_bf16(o.z, o.w);
    *(GAS v2u*)ptr = w;
}
__device__ __forceinline__ void p3_qk_finalize(Frame& F) {
    const int gw = F.vcu * NWAVES + F.wave, NGW = F.G * NWAVES;
    const int l32 = F.lane & 31, hsel = F.lane >> 5, axis = l32 >> 4, half = (l32 >> 3) & 1, f0 = 4 * (l32 & 7);
    const float* ropec = (const float*)(F.ws + WS_ROPE); const float* ropes = ropec + 4096;
    const f32x4 gq = *(const GAS f32x4*)(F.in[I_GQ] + 4 * l32), gk = *(const GAS f32x4*)(F.in[I_GK] + 4 * l32);
    bf16* Q = (bf16*)(F.ws + WS_ACTB); bf16* Kb = (bf16*)(F.ws + WS_KB);
    for (int row = gw; row < MT; row += NGW) {
        const bool lat = row < M; const int s = row & (S - 1); const int pos = axis ? (s & 63) : (s >> 6);
        f32x4 cs = {1.f, 1.f, 1.f, 1.f}, sn = {0.f, 0.f, 0.f, 0.f};
        if (lat) { cs = *(const GAS f32x4*)(ropec + pos * 32 + f0); sn = *(const GAS f32x4*)(ropes + pos * 32 + f0); }
        if (lat) {
#pragma unroll
            for (int it = 0; it < 8; ++it) qk_fix(Q + (size_t)row * D + (2 * it + hsel) * HD + 4 * l32, gq, cs, sn, half, QSCALE);
        }
#pragma unroll
        for (int it = 0; it < 2; ++it) qk_fix(Kb + (size_t)row * 512 + (2 * it + hsel) * HD + 4 * l32, gk, cs, sn, half, 1.0f);
    }
}

__device__ __forceinline__ void p4_attention(Frame& F) {
    const bf16* Q = (const bf16*)(F.ws + WS_ACTB); const bf16* Kb = (const bf16*)(F.ws + WS_KB); const bf16* Vt = (const bf16*)(F.ws + WS_VT); bf16* O = (bf16*)(F.ws + WS_ACTC);
    LAS unsigned char* lds = F.lds;
    const int tid = F.tid, lane = F.lane, wid = F.wave, r32 = lane & 31, hi = lane >> 5;
    constexpr int KOFF = 0, VOFF = 32768;
    for (int u = F.vcu; u < 1024; u += F.G) {
        const int b = u >> 9, rem = u & 511, n = rem >> 3, kvh = (rem >> 1) & 3, hp = rem & 1;
        const int head = kvh * 4 + hp * 2 + (wid >> 2);
        const int qloc0 = n * 128 + (wid & 3) * 32;
        const size_t qrow = (size_t)b * S + qloc0 + r32;
        bf16x8 qf[8];
#pragma unroll
        for (int ds = 0; ds < 8; ++ds) qf[ds] = *(const GAS bf16x8*)(Q + qrow * D + head * HD + 16 * ds + 8 * hi);
        const int kstart = (n == 0) ? 0 : n * 128 - 128, kend = (n == 63) ? S : n * 128 + 256, nloc = (kend - kstart) >> 6, NT = nloc + 4;
        float mrun = F.in[I_SINK][head] * 1.4426950408889634f, lrun = (hi == 0) ? 1.0f : 0.0f;
        f32x16 o[4];
#pragma unroll
        for (int db = 0; db < 4; ++db)
#pragma unroll
            for (int r = 0; r < 16; ++r) o[db][r] = 0.f;
        v4u kreg[2], vreg[2];
#define ATT_LOAD(t) do { const int _t = (t); const int _kr0 = (_t < nloc) ? (b * S + kstart + 64 * _t) : (M + b * CTX + 64 * (_t - nloc)); \
            _Pragma("unroll") for (int _i = 0; _i < 2; ++_i) { const int _L = _i * 512 + tid; \
                { const int _row = _L >> 4, _c = (_L & 15) ^ (_row & 15); kreg[_i] = *(const GAS v4u*)(Kb + (size_t)(_kr0 + _row) * 512 + kvh * HD + _c * 8); } \
                { const int _d = _L >> 3, _c = (_L & 7) ^ ((_d >> 1) & 7); vreg[_i] = *(const GAS v4u*)(Vt + (size_t)(kvh * HD + _d) * MT + _kr0 + _c * 8); } } } while (0)
#define ATT_STORE(buf) do { _Pragma("unroll") for (int _i = 0; _i < 2; ++_i) { const int _L = _i * 512 + tid; \
                *(LAS v4u*)(lds + KOFF + (buf) * 16384 + _L * 16) = kreg[_i]; *(LAS v4u*)(lds + VOFF + (buf) * 16384 + _L * 16) = vreg[_i]; } } while (0)
        ATT_LOAD(0); ATT_STORE(0);
        __syncthreads();
        for (int t = 0; t < NT; ++t) {
            const int buf = t & 1;
            if (t + 1 < NT) ATT_LOAD(t + 1);
            const int kloc0 = kstart + 64 * t;
            const bool isloc = t < nloc;
            const bool need = !isloc || ((kloc0 + 63 >= qloc0 - 128) && (kloc0 <= qloc0 + 31 + 128));
            if (need) {
                const LAS unsigned char* kb_ = lds + KOFF + buf * 16384; const LAS unsigned char* vb_ = lds + VOFF + buf * 16384;
                f32x16 p[2];
#pragma unroll
                for (int kb = 0; kb < 2; ++kb) {
#pragma unroll
                    for (int r = 0; r < 16; ++r) p[kb][r] = 0.f;
                    const int row = 32 * kb + r32;
#pragma unroll
                    for (int ds = 0; ds < 8; ++ds) { const bf16x8 kf = *(const LAS bf16x8*)(kb_ + row * 256 + (((2 * ds + hi) ^ (row & 15)) << 4));
                        p[kb] = __builtin_amdgcn_mfma_f32_32x32x16_bf16(kf, qf[ds], p[kb], 0, 0, 0); }
                }
                if (isloc && !((kloc0 >= qloc0 + 31 - 128) && (kloc0 + 63 <= qloc0 + 128))) {
                    const int q = qloc0 + r32;
#pragma unroll
                    for (int kb = 0; kb < 2; ++kb)
#pragma unroll
                        for (int r = 0; r < 16; ++r) { const int key = kloc0 + 32 * kb + (r & 3) + 8 * (r >> 2) + 4 * hi; const int dlt = key - q; if (dlt > 128 || dlt < -128) p[kb][r] = -INFINITY; }
                }
                float mx = p[0][0];
#pragma unroll
                for (int r = 1; r < 16; ++r) mx = fmaxf(mx, p[0][r]);
#pragma unroll
                for (int r = 0; r < 16; ++r) mx = fmaxf(mx, p[1][r]);
                mx = fmaxf(mx, __shfl_xor(mx, 32));
                const float mnew = fmaxf(mrun, mx), alpha = __builtin_amdgcn_exp2f(mrun - mnew);
                mrun = mnew;
                float ls = 0.f;
#pragma unroll
                for (int kb = 0; kb < 2; ++kb)
#pragma unroll
                    for (int r = 0; r < 16; ++r) { p[kb][r] = __builtin_amdgcn_exp2f(p[kb][r] - mnew); ls += p[kb][r]; }
                lrun = lrun * alpha + ls;
#pragma unroll
                for (int db = 0; db < 4; ++db)
#pragma unroll
                    for (int r = 0; r < 16; ++r) o[db][r] *= alpha;
                bf16x8 pb[2][2];
#pragma unroll
                for (int kb = 0; kb < 2; ++kb)
#pragma unroll
                    for (int s2 = 0; s2 < 2; ++s2) { v4u w; w.x = cvt_pk_bf16(p[kb][8 * s2 + 0], p[kb][8 * s2 + 1]); w.y = cvt_pk_bf16(p[kb][8 * s2 + 2], p[kb][8 * s2 + 3]);
                        w.z = cvt_pk_bf16(p[kb][8 * s2 + 4], p[kb][8 * s2 + 5]); w.w = cvt_pk_bf16(p[kb][8 * s2 + 6], p[kb][8 * s2 + 7]); pb[kb][s2] = __builtin_bit_cast(bf16x8, w); }
#pragma unroll
                for (int db = 0; db < 4; ++db) { const int d = 32 * db + r32, sw = (d >> 1) & 7;
#pragma unroll
                    for (int kb = 0; kb < 2; ++kb)
#pragma unroll
                        for (int s2 = 0; s2 < 2; ++s2) { const int c1 = 4 * kb + 2 * s2;
                            const v2u a0 = *(const LAS v2u*)(vb_ + d * 128 + ((c1 ^ sw) << 4) + 8 * hi), a1 = *(const LAS v2u*)(vb_ + d * 128 + (((c1 + 1) ^ sw) << 4) + 8 * hi);
                            const v4u av = {a0.x, a0.y, a1.x, a1.y};
                            o[db] = __builtin_amdgcn_mfma_f32_32x32x16_bf16(__builtin_bit_cast(bf16x8, av), pb[kb][s2], o[db], 0, 0, 0); } }
            }
            if (t + 1 < NT) ATT_STORE(buf ^ 1);
            __syncthreads();
        }
#undef ATT_LOAD
#undef ATT_STORE
        const float ltot = lrun + __shfl_xor(lrun, 32), inv = 1.0f / ltot;
        bf16* orow = O + qrow * D + head * HD + 4 * hi;
#pragma unroll
        for (int db = 0; db < 4; ++db)
#pragma unroll
            for (int g = 0; g < 4; ++g) { v2u w; w.x = cvt_pk_bf16(o[db][4 * g] * inv, o[db][4 * g + 1] * inv); w.y = cvt_pk_bf16(o[db][4 * g + 2] * inv, o[db][4 * g + 3] * inv);
                *(GAS v2u*)(orow + 32 * db + 8 * g) = w; }
    }
}

__device__ __forceinline__ float rdlane(float v, int l) { return __uint_as_float(__builtin_amdgcn_readlane(__float_as_uint(v), l)); }
__device__ __forceinline__ void moe_route(Frame& F, const int l) {
    const float* X1 = (const float*)(F.ws + WS_X1); const float* SSQ = (const float*)(F.ws + WS_SSQ); bf16* H2 = (bf16*)(F.ws + WS_ACTA);
    const bf16* WRh = (const bf16*)(F.ws + WS_WR) + (size_t)l * 2 * NE * D; const bf16* WRl = WRh + NE * D;
    unsigned* tokl = (unsigned*)(F.ws + WS_TOK + l * LIST_L); unsigned* dstl = (unsigned*)(F.ws + WS_DST + l * LIST_L); float* gwl = (float*)(F.ws + WS_GW + l * LIST_L);
    unsigned* cntg = (unsigned*)(F.ws + WS_CTL) + CW_CNT + l * 64 * 64;
    LAS unsigned char* lds = F.lds;
    constexpr int AH = 0, AL = 32768, LOG = 65536, PEND = 98304, LCNT = 102400, LBASE = 102656;
    const int tid = F.tid, lane = F.lane, w = F.wave;
    for (int tb = F.vcu; tb < M / 64; tb += F.G) {
        const int row0 = tb * 64, b = row0 / S;
        if (tid < 64) ((LAS unsigned*)(lds + LCNT))[tid] = 0u;
        float rstd[8];
#pragma unroll
        for (int j = 0; j < 8; ++j) { const int row = row0 + 8 * w + j; const float v = (lane < 32) ? SSQ[(size_t)row * 32 + lane] : 0.f; rstd[j] = 1.0f / sqrtf(wave_sum(v) * (1.0f / D) + EPS); }
        const float* g2 = F.in[I_G2] + l * D; const float* sh2 = modp(F, l, b, 3); const float* sc2 = modp(F, l, b, 4);
        const int nt = w & 3, kh = w >> 2, r16 = lane & 15, kq = lane >> 4;
        f32x4 acc[4];
#pragma unroll
        for (int mt = 0; mt < 4; ++mt) acc[mt] = (f32x4){0.f, 0.f, 0.f, 0.f};
        for (int kc = 0; kc < 8; ++kc) {
            const int k0 = kc * 256 + 4 * lane;
            const f32x4 av = *(const GAS f32x4*)(g2 + k0) * (*(const GAS f32x4*)(sc2 + k0) + 1.0f), bv = *(const GAS f32x4*)(sh2 + k0);
#pragma unroll
            for (int j = 0; j < 8; ++j) { const int rl = 8 * w + j, row = row0 + rl;
                const f32x4 x = *(const GAS f32x4*)(X1 + (size_t)row * D + k0); const f32x4 h = x * rstd[j] * av + bv;
                v2u hh; hh.x = cvt_pk_bf16(h.x, h.y); hh.y = cvt_pk_bf16(h.z, h.w);
                *(GAS v2u*)(H2 + (size_t)row * D + k0) = hh;
                const f32x4 lo = {h.x - bflo(hh.x), h.y - bfhi(hh.x), h.z - bflo(hh.y), h.w - bfhi(hh.y)};
                v2u ll; ll.x = cvt_pk_bf16(lo.x, lo.y); ll.y = cvt_pk_bf16(lo.z, lo.w);
                const int off = rl * 512 + ((((lane >> 1) ^ (rl & 15))) << 4) + 8 * (lane & 1);
                *(LAS v2u*)(lds + AH + off) = hh; *(LAS v2u*)(lds + AL + off) = ll; }
            __syncthreads();
#pragma unroll
            for (int ks4 = 0; ks4 < 4; ++ks4) { const int ks = kh * 4 + ks4;
                const size_t wo = (size_t)(16 * nt + r16) * D + kc * 256 + 32 * ks + 8 * kq;
                const bf16x8 bh = *(const GAS bf16x8*)(WRh + wo), bl = *(const GAS bf16x8*)(WRl + wo);
#pragma unroll
                for (int mt = 0; mt < 4; ++mt) { const int row = 16 * mt + r16; const int off = row * 512 + (((4 * ks + kq) ^ (row & 15)) << 4);
                    const bf16x8 ah = *(const LAS bf16x8*)(lds + AH + off), al = *(const LAS bf16x8*)(lds + AL + off);
                    acc[mt] = __builtin_amdgcn_mfma_f32_16x16x32_bf16(ah, bh, acc[mt], 0, 0, 0);
                    acc[mt] = __builtin_amdgcn_mfma_f32_16x16x32_bf16(ah, bl, acc[mt], 0, 0, 0);
                    acc[mt] = __builtin_amdgcn_mfma_f32_16x16x32_bf16(al, bh, acc[mt], 0, 0, 0); } }
            __syncthreads();
        }
        LAS float* logp = (LAS float*)(lds + LOG);
#pragma unroll
        for (int mt = 0; mt < 4; ++mt)
#pragma unroll
            for (int r = 0; r < 4; ++r) logp[kh * 4096 + (16 * mt + 4 * kq + r) * 64 + 16 * nt + r16] = acc[mt][r];
        __syncthreads();
        const float br = F.in[I_BR][l * NE + lane];
        for (int j = 0; j < 8; ++j) { const int rl = 8 * w + j;
            const float logit = logp[rl * 64 + lane] + logp[4096 + rl * 64 + lane];
            const float s = 1.0f / (1.0f + __expf(-logit)), sb = s + br;
            float m1 = sb; m1 = fmaxf(m1, __shfl_xor(m1, 1)); m1 = fmaxf(m1, __shfl_xor(m1, 2)); m1 = fmaxf(m1, __shfl_xor(m1, 4));
            const unsigned long long eq = __ballot(sb == m1); const int g = lane >> 3; const unsigned gm = (unsigned)(eq >> (8 * g)) & 0xffu; const int first = __ffs(gm) - 1;
            float m2 = ((lane & 7) == first) ? -INFINITY : sb; m2 = fmaxf(m2, __shfl_xor(m2, 1)); m2 = fmaxf(m2, __shfl_xor(m2, 2)); m2 = fmaxf(m2, __shfl_xor(m2, 4));
            const float gs = m1 + m2;
            float gv = gs; bool gsel = false;
#pragma unroll
            for (int it = 0; it < 4; ++it) { float mm = gv;
#pragma unroll
                for (int o = 1; o < 64; o <<= 1) mm = fmaxf(mm, __shfl_xor(mm, o));
                const unsigned long long bm = __ballot(gv == mm); const int gwin = (__ffsll((long long)bm) - 1) >> 3;
                if (g == gwin) { gsel = true; gv = -INFINITY; } }
            float val = gsel ? sb : -1e30f; int rank = 64;
#pragma unroll
            for (int it = 0; it < TOPK; ++it) { float mm = val;
#pragma unroll
                for (int o = 1; o < 64; o <<= 1) mm = fmaxf(mm, __shfl_xor(mm, o));
                const unsigned long long bm = __ballot(val == mm); const int win = __ffsll((long long)bm) - 1;
                if (lane == win) { rank = it; val = -INFINITY; } }
            const bool sel = rank < TOPK;
            const float tot = wave_sum(sel ? s : 0.f), gate = s / tot * 2.5f;
            if (sel) { const unsigned lpos = __hip_atomic_fetch_add((LAS unsigned*)(lds + LCNT) + lane, 1u, __ATOMIC_RELAXED, __HIP_MEMORY_SCOPE_WORKGROUP);
                *(LAS v2u*)(lds + PEND + (rl * 8 + rank) * 8) = (v2u){(unsigned)lane | (lpos << 8), __float_as_uint(gate)}; }
        }
        __syncthreads();
        if (tid < 64) { const unsigned c = ((LAS unsigned*)(lds + LCNT))[tid]; ((LAS unsigned*)(lds + LBASE))[tid] = c ? __hip_atomic_fetch_add(cntg + tid * 64, c, RLX_AGENT) : 0u; }
        __syncthreads();
        { const int rl = tid >> 3, rank = tid & 7; const v2u pe = *(const LAS v2u*)(lds + PEND + (rl * 8 + rank) * 8); const unsigned e = pe.x & 0xffu, lpos = pe.x >> 8;
            const unsigned pos = ((LAS unsigned*)(lds + LBASE))[e] + lpos; const unsigned token = (unsigned)(row0 + rl); const size_t o = (size_t)e * ECAP + pos;
            tokl[o] = token; dstl[o] = token * 9u + (unsigned)rank + 1u; gwl[o] = __uint_as_float(pe.y); }
        __syncthreads();
    }
}
__device__ __forceinline__ void moe_build_toff(Frame& F, const int l) {
    LAS int* toff = (LAS int*)(F.lds + TOFF_OFF);
    if (F.wave == 0) { const unsigned* cntg = (const unsigned*)(F.ws + WS_CTL) + CW_CNT + l * 64 * 64;
        const int c = (int)__hip_atomic_load(cntg + F.lane * 64, RLX_AGENT); const int ntl = (c + 255) >> 8; int inc = ntl;
#pragma unroll
        for (int o = 1; o < 64; o <<= 1) { const int v = __shfl_up(inc, o); if (F.lane >= o) inc += v; }
        toff[F.lane] = inc - ntl; if (F.lane == 63) { toff[64] = inc; toff[65] = inc + 64; } }
    __syncthreads();
}
__device__ __forceinline__ void moe_gemm1(Frame& F, const int l) {
    moe_build_toff(F, l);
    SchedMoe1 Sd{(const char*)(F.ws + WS_ACTA), (const char*)(F.ws + WS_W1) + (size_t)l * NE1 * 1024 * D * 2, (const unsigned*)(F.ws + WS_TOK + l * LIST_L), (const LAS int*)(F.lds + TOFF_OFF), F.G, F.vcu, F.lane};
    EpiMoe1 E{(bf16*)(F.ws + WS_HID)};
    pg8::gemm_phase<EpiMoe1, SchedMoe1, true>(F.lds, (LAS unsigned*)(F.lds + GTL_OFF), D, D, D, Sd, E);
}
__device__ __forceinline__ void moe_gemm2(Frame& F, const int l) {
    moe_build_toff(F, l);
    SchedMoe2 Sd{(const char*)(F.ws + WS_HID), (const char*)(F.ws + WS_W2) + (size_t)l * NE1 * D * FF * 2, (const LAS int*)(F.lds + TOFF_OFF), F.G, F.vcu, F.lane};
    EpiMoe2 E{(bf16*)(F.ws + WS_Y), (const unsigned*)(F.ws + WS_DST + l * LIST_L), (const float*)(F.ws + WS_GW + l * LIST_L)};
    pg8::gemm_phase<EpiMoe2, SchedMoe2, false>(F.lds, (LAS unsigned*)(F.lds + GTL_OFF), FF, FF, FF, Sd, E);
}
template <bool LAST>
__device__ __forceinline__ void moe_combine(Frame& F, const int l, float* xo_buf) {
    const int gw = F.vcu * NWAVES + F.wave, NGW = F.G * NWAVES;
    const float* X1 = (const float*)(F.ws + WS_X1); const bf16* Y = (const bf16*)(F.ws + WS_Y); bf16* H1 = (bf16*)(F.ws + WS_ACTA);
    for (int rb = gw; rb < M / 8; rb += NGW) {
        const int row0 = rb * 8, b = row0 / S;
        const float* ga2 = modp(F, l, b, 5);
        ModVec mv;
        if (!LAST) load_modvec(mv, F.in[I_G1] + D, modp(F, 1, b, 0), modp(F, 1, b, 1), F.lane);
        for (int j = 0; j < 8; ++j) { const int row = row0 + j; f32x4 v[8];
#pragma unroll
            for (int jj = 0; jj < 8; ++jj) { const int col = 4 * F.lane + 256 * jj; f32x4 ys = {0.f, 0.f, 0.f, 0.f};
#pragma unroll
                for (int k = 0; k < 9; ++k) { const v2u y = *(const GAS v2u*)(Y + ((size_t)row * 9 + k) * D + col); ys += (f32x4){bflo(y.x), bfhi(y.x), bflo(y.y), bfhi(y.y)}; }
                v[jj] = *(const GAS f32x4*)(X1 + (size_t)row * D + col) + *(const GAS f32x4*)(ga2 + col) * ys;
                *(GAS f32x4*)(xo_buf + (size_t)row * D + col) = v[jj]; }
            if (!LAST) norm_mod_store(v, mv, H1 + (size_t)row * D, F.lane); }
    }
}
__device__ __forceinline__ void pool_diff(Frame& F) {
    const bf16* H1 = (const bf16*)(F.ws + WS_ACTA); bf16* DP = (bf16*)(F.ws + WS_ACTB);
    const int col = 4 * F.tid, g = F.tid >> 7, wdw = 2 << g, back = wdw >> 1, fwd = wdw - back;
    for (int tb = F.vcu; tb < M / 64; tb += F.G) {
        const int t00 = tb * 64, bb = t00 / S;
#pragma unroll 2
        for (int j = 0; j < 64; ++j) { const int t = (t00 + j) - bb * S; int lo = t - back; lo = lo < 0 ? 0 : lo; int hi = t + fwd; hi = hi > S ? S : hi;
            f32x4 sum = {0.f, 0.f, 0.f, 0.f};
            for (int tt = lo; tt < hi; ++tt) { const v2u y = *(const GAS v2u*)(H1 + ((size_t)bb * S + tt) * D + col); sum += (f32x4){bflo(y.x), bfhi(y.x), bflo(y.y), bfhi(y.y)}; }
            const v2u c = *(const GAS v2u*)(H1 + ((size_t)bb * S + t) * D + col); const float inv = 1.0f / (float)(hi - lo);
            const f32x4 o = sum * inv - (f32x4){bflo(c.x), bfhi(c.x), bflo(c.y), bfhi(c.y)};
            v2u w; w.x = cvt_pk_bf16(o.x, o.y); w.y = cvt_pk_bf16(o.z, o.w);
            *(GAS v2u*)(DP + ((size_t)bb * S + t) * D + col) = w; }
    }
}

constexpr int N_PHASES = 16;
__global__ void __launch_bounds__(NTHR, 2) fwd_kernel(Args args) {
    extern __shared__ __attribute__((aligned(16))) unsigned char lds[];
    Frame F;
    F.lds = (LAS unsigned char*)lds; F.tid = threadIdx.x; F.lane = F.tid & 63; F.wave = __builtin_amdgcn_readfirstlane(F.tid >> 6);
    F.G = gridDim.x; { const int bx = blockIdx.x; F.vcu = (F.G % 8 == 0) ? (bx % 8) * (F.G / 8) + bx / 8 : bx; }
    F.ws = args.ws; F.in = args.in;
    volatile LAS unsigned* MISC = (volatile LAS unsigned*)(F.lds + MISC_OFF);
    if (F.tid < 32) MISC[F.tid] = 0u;
    __syncthreads();
    unsigned* ctl = (unsigned*)(F.ws + WS_CTL);
    XcdBarrier bar; bar.bar = ctl + CW_BAR; bar.x = 0; bar.st = nullptr;
    const int lo = args.ph_lo, hi = args.ph_hi;
    if (hi - lo > 1) bar = xcd_barrier_post(ctl + CW_BAR, MISC + 8);
#ifndef PHASE_MASK
#define PHASE_MASK 0xFFFF
#endif
#define IN(k) (((PHASE_MASK >> (k)) & 1) && lo <= (k) && (k) < hi)
#define SEAM(k) do { if (IN(k) && IN((k) + 1)) xcd_barrier(bar); } while (0)
    if (IN(0)) p0_prologue(F);
    SEAM(0);
    if (IN(1)) p1_norm1(F);
    SEAM(1);
    if (IN(2)) {
        { SchedQK Sd{(const char*)(F.ws + WS_ACTA), (const char*)(F.ws + WS_WQKV), F.G, F.vcu}; EpiQK E{(bf16*)(F.ws + WS_ACTB), (bf16*)(F.ws + WS_KB)};
          pg8::gemm_phase<EpiQK, SchedQK, false>(F.lds, (LAS unsigned*)(F.lds + GTL_OFF), D, D, D, Sd, E); }
        { SchedVT Sd{(const char*)(F.ws + WS_WQKV) + (size_t)2560 * D * 2, (const char*)(F.ws + WS_ACTA), F.G, F.G - 1 - F.vcu}; EpiVT E{(bf16*)(F.ws + WS_VT)};
          pg8::gemm_phase<EpiVT, SchedVT, false>(F.lds, (LAS unsigned*)(F.lds + GTL_OFF), D, D, D, Sd, E); }
    }
    SEAM(2);
    if (IN(3)) p3_qk_finalize(F);
    SEAM(3);
    if (IN(4)) p4_attention(F);
    SEAM(4);
    if (IN(5)) { SchedRes Sd{(const char*)(F.ws + WS_ACTC), (const char*)(F.ws + WS_WO), F.G, F.vcu, 0};
        EpiRes E{F.in[I_X], (float*)(F.ws + WS_X1), modp(F, 0, 0, 2), modp(F, 0, 1, 2), nullptr, (float*)(F.ws + WS_SSQ)};
        pg8::gemm_phase<EpiRes, SchedRes, false>(F.lds, (LAS unsigned*)(F.lds + GTL_OFF), D, D, D, Sd, E); }
    SEAM(5);
    if (IN(6)) moe_route(F, 0);
    SEAM(6);
    if (IN(7)) moe_gemm1(F, 0);
    SEAM(7);
    if (IN(8)) moe_gemm2(F, 0);
    SEAM(8);
    if (IN(9)) moe_combine<false>(F, 0, args.out);
    SEAM(9);
    if (IN(10)) pool_diff(F);
    SEAM(10);
    if (IN(11)) { SchedRes Sd{(const char*)(F.ws + WS_ACTB), (const char*)(F.ws + WS_WPOOL), F.G, F.vcu, 1};
        EpiRes E{args.out, (float*)(F.ws + WS_X1), modp(F, 1, 0, 2), modp(F, 1, 1, 2), F.in[I_PSCALE], (float*)(F.ws + WS_SSQ)};
        pg8::gemm_phase<EpiRes, SchedRes, false>(F.lds, (LAS unsigned*)(F.lds + GTL_OFF), FF, D, FF, Sd, E); }
    SEAM(11);
    if (IN(12)) moe_route(F, 1);
    SEAM(12);
    if (IN(13)) moe_gemm1(F, 1);
    SEAM(13);
    if (IN(14)) moe_gemm2(F, 1);
    SEAM(14);
    if (IN(15)) moe_combine<true>(F, 1, args.out);
#undef IN
#undef SEAM
}

extern "C" void kernel_launch(void* const* d_in, const int* in_sizes, int n_in, void* d_out, int out_size, void* d_ws, size_t ws_size, hipStream_t stream) {
    static int grid = 0;
    if (grid == 0) {
        if (n_in != 23 || out_size != M * D || ws_size < WS_END) { fprintf(stderr, "kernel_launch: bad shapes n_in %d out %d ws %zu\n", n_in, out_size, ws_size); grid = -1; return; }
        int dev = 0, cus = 0, per_cu = 0;
        if (hipGetDevice(&dev) != hipSuccess || hipDeviceGetAttribute(&cus, hipDeviceAttributeMultiprocessorCount, dev) != hipSuccess) { grid = -1; return; }
        if (hipFuncSetAttribute((const void*)fwd_kernel, hipFuncAttributeMaxDynamicSharedMemorySize, LDS_BYTES) != hipSuccess) { fprintf(stderr, "kernel_launch: hipFuncSetAttribute failed\n"); grid = -1; return; }
        if (hipOccupancyMaxActiveBlocksPerMultiprocessor(&per_cu, (const void*)fwd_kernel, NTHR, LDS_BYTES) != hipSuccess || per_cu < 1) fprintf(stderr, "kernel_launch: occupancy query says %d\n", per_cu);
        (void)hipGetLastError();
        grid = cus;
    }
    if (grid < 0) return;
    (void)hipMemsetAsync((char*)d_ws + WS_CTL, 0, CTL_ZERO_BYTES, stream);
    Args a{};
    for (int i = 0; i < 23; ++i) a.in[i] = (const float*)d_in[i];
    a.out = (float*)d_out; a.ws = (unsigned char*)d_ws;
#if MK_N_LAUNCHES == 1
    a.ph_lo = 0; a.ph_hi = N_PHASES;
    hipLaunchKernelGGL(fwd_kernel, dim3(grid), dim3(NTHR), LDS_BYTES, stream, a);
#else
    for (int p = 0; p < N_PHASES; ++p) { a.ph_lo = p; a.ph_hi = p + 1; hipLaunchKernelGGL(fwd_kernel, dim3(grid), dim3(NTHR), LDS_BYTES, stream, a); }
#endif
}
```

```cpp
#include <hip/hip_runtime.h>
#include <cstdio>
#include <cstdint>

#ifndef MK_N_LAUNCHES
#define MK_N_LAUNCHES 1
#endif

#define GAS __attribute__((address_space(1)))
#define LAS __attribute__((address_space(3)))
typedef unsigned short bf16;
typedef unsigned v4u __attribute__((ext_vector_type(4)));
typedef unsigned v2u __attribute__((ext_vector_type(2)));
typedef float f32x4 __attribute__((ext_vector_type(4)));
typedef float f32x2 __attribute__((ext_vector_type(2)));
typedef float f32x16 __attribute__((ext_vector_type(16)));
typedef short bf16x8 __attribute__((ext_vector_type(8)));
typedef short s16x4 __attribute__((ext_vector_type(4)));
typedef GAS unsigned gu32;
#define RLX_AGENT __ATOMIC_RELAXED, __HIP_MEMORY_SCOPE_AGENT
#define LDS_WAIT() asm volatile("s_waitcnt lgkmcnt(0)" ::: "memory")
#define VM_WAIT() asm volatile("s_waitcnt vmcnt(0)" ::: "memory")

constexpr int D = 2048, NB = 2, S = 8192, M = NB * S, CTX = 256, MC = NB * CTX, MT = M + MC;
constexpr int NH = 16, NKV = 4, HD = 128, NE = 64, FF = 512, TOPK = 8, NE1 = NE + 1;
constexpr int ECAP = 16384;
constexpr float EPS = 1e-6f;
constexpr float QSCALE = 0.08838834764831845f * 1.4426950408889634f;
constexpr float W1_SCALE = 64.0f, W2_SCALE = 32.0f, H2_SCALE = 16.0f, HID_SCALE = 8.0f, Y_SCALE = 16.0f;
constexpr int NCX_QKV = 0, NCX_MOE = 0;
constexpr int CVT_L0_P0 = 6240;
constexpr int CVT_L1_P7 = 2900;
constexpr float PW_SCALE = 16.0f, DP_SCALE = 16.0f; constexpr int SC_PW = 0x7b7b7b7b, SC_DP = 0x7b7b7b7b;
constexpr float O_SCALE = 32.0f; constexpr int SC_O = 0x7a7a7a7a;
constexpr int SC_W1 = 0x79797979, SC_W2 = 0x7a7a7a7a, SC_H2 = 0x7b7b7b7b, SC_HID = 0x7c7c7c7c;
constexpr int YROWS = M * 9 + 256;
constexpr int HID_TILES = 640;

constexpr size_t MiB = 1u << 20;
constexpr size_t WS_CTL = 0, CTL_ZERO_BYTES = 256 * 1024;
constexpr size_t WS_MOD = 1 * MiB;
constexpr size_t WS_ROPE = 2 * MiB;
constexpr size_t WS_WR = 3 * MiB;
constexpr size_t WS_RSTD2 = 7 * MiB;
constexpr size_t WS_SSQ = 5 * MiB;
constexpr size_t WS_TOK = 8 * MiB;
constexpr size_t WS_DST = 18 * MiB;
constexpr size_t WS_GW = 28 * MiB;
constexpr size_t LIST_L = 5 * MiB;
constexpr size_t WS_WQKV = 40 * MiB;
constexpr size_t WS_WO = 52 * MiB;
constexpr size_t WS_WPOOL = 60 * MiB;
constexpr size_t WS_W1 = 64 * MiB;
constexpr size_t WS_W2 = 584 * MiB;
constexpr size_t WS_ACTA = 844 * MiB;
constexpr size_t WS_ACTB = 910 * MiB;
constexpr size_t WS_ACTC = 974 * MiB;
constexpr size_t WS_KB = 1038 * MiB;
constexpr size_t WS_VT = 1055 * MiB;
constexpr size_t WS_X1 = 1072 * MiB;
constexpr size_t WS_X2 = 1136 * MiB;
constexpr size_t WS_HID = 1200 * MiB;
constexpr size_t WS_Y = 1360 * MiB;
constexpr size_t WS_END = 1940 * MiB;
static_assert(WS_Y + (size_t)YROWS * D * 2 <= WS_END, "ws map");
static_assert(WS_W1 + (size_t)2 * NE1 * 1024 * 2048 * 2 <= WS_W2 && WS_W2 + (size_t)2 * NE1 * 2048 * 512 * 2 <= WS_ACTA, "ws map");
constexpr int CW_BAR = 4096;
constexpr int CW_CVT = 12288;
constexpr int CW_PRO = 13312;
constexpr int CW_QKV = 13312 + 64;
constexpr int CW_CNT = 16384;

constexpr int RING_BYTES = 131072;
constexpr int GTL_OFF = RING_BYTES;
constexpr int TOFF_OFF = GTL_OFF + 1024;
constexpr int MISC_OFF = TOFF_OFF + 512;
constexpr int ETL_OFF = RING_BYTES + 2048;
constexpr int LDS_BYTES = 155648;

typedef __bf16 bf16x2n __attribute__((ext_vector_type(2)));
__device__ __forceinline__ unsigned cvt_pk_bf16_n(float lo, float hi) { const f32x2 v = {lo, hi}; return __builtin_bit_cast(unsigned, __builtin_convertvector(v, bf16x2n)); }
__device__ __forceinline__ unsigned cvt_pk_bf16(float lo, float hi) { return cvt_pk_bf16_n(lo, hi); }
__device__ __forceinline__ float clamp448(float x) { return __builtin_amdgcn_fmed3f(x, -448.0f, 448.0f); }
__device__ __forceinline__ unsigned pk4_fp8(float a, float b, float c, float d) { int w = 0; w = __builtin_amdgcn_cvt_pk_fp8_f32(clamp448(a), clamp448(b), w, false); w = __builtin_amdgcn_cvt_pk_fp8_f32(clamp448(c), clamp448(d), w, true); return (unsigned)w; }
__device__ __forceinline__ float bf2f(unsigned short u) { return __uint_as_float((unsigned)u << 16); }
__device__ __forceinline__ float bflo(unsigned u) { return __uint_as_float(u << 16); }
__device__ __forceinline__ float bfhi(unsigned u) { return __uint_as_float(u & 0xffff0000u); }
#define DPPF(v, ctrl) __uint_as_float((unsigned)__builtin_amdgcn_update_dpp(0, (int)__float_as_uint(v), (ctrl), 0xf, 0xf, true))
__device__ __forceinline__ float grp8_max(float v) { v = fmaxf(v, DPPF(v, 0xB1)); v = fmaxf(v, DPPF(v, 0x4E)); v = fmaxf(v, DPPF(v, 0x141)); return v; }
__device__ __forceinline__ float wave_sum(float v) {
#pragma unroll
    for (int o = 1; o < 64; o <<= 1) v += __shfl_xor(v, o);
    return v;
}
__device__ __forceinline__ float fast_sigmoid(float x) { return __builtin_amdgcn_rcpf(1.0f + __builtin_amdgcn_exp2f(-1.4426950408889634f * x)); }

namespace pg8 {
constexpr int BM = 256, BK = 64, HALF = 128, HTB = HALF * BK * 2, STAGE_BYTES = 8 * HTB;
__host__ __device__ __forceinline__ int lds_byte(int r, int c) { const int st = (r >> 4) * 2 + (c >> 5), rr = r & 15, cc = c & 31, ob = rr * 64 + cc * 2; return st * 1024 + (ob ^ (((ob >> 9) & 1) << 5)); }
__host__ __device__ __forceinline__ void stage_rc(int b, int& R, int& C) { const int st = b / 1024, sb = b % 1024, swz = sb ^ (((sb >> 9) & 1) << 5); R = (st >> 1) * 16 + swz / 64; C = (st & 1) * 32 + (swz % 64) / 2; }
__host__ __device__ __forceinline__ int perm32(int rho) { const int n = rho >> 4, i = rho & 15; return 8 * (i >> 2) + 4 * n + (i & 3); }

struct GUnit { const char* A; const char* B; const unsigned* gtab; const unsigned* e0; const unsigned* e1; int i0, i1, i2, i3; };

typedef int v4i_t __attribute__((ext_vector_type(4)));
typedef int v8i_t __attribute__((ext_vector_type(8)));
__device__ __forceinline__ v8i_t cat8(const bf16x8 a, const bf16x8 b) { return __builtin_shufflevector(__builtin_bit_cast(v4i_t, a), __builtin_bit_cast(v4i_t, b), 0, 1, 2, 3, 4, 5, 6, 7); }
__device__ __forceinline__ void mfma_fp8(f32x4& acc, const v8i_t a, const v8i_t b, const int sa, const int sb) {
    asm volatile("v_mfma_scale_f32_16x16x128_f8f6f4 %0, %1, %2, %0, %3, %4 op_sel_hi:[0,0,0]" : "+v"(acc) : "v"(a), "v"(b), "v"(sa), "v"(sb)); }
struct NoPre { __device__ __forceinline__ void operator()() const {} };
template <class Epi, class Sched, bool GATHER, bool FP8 = false, int SCW = 0x7f7f7f7f, int SCA = 0x7f7f7f7f, class Pre = NoPre>
__device__ __forceinline__ void gemm_phase(LAS unsigned char* lds, LAS unsigned* gtl, const int K, const int lda, const int ldb, const Sched& S, const Epi& E, const Pre& pre = Pre()) {
    LAS unsigned* etl = (LAS unsigned*)(lds + ETL_OFF);
    const int tid = threadIdx.x, wid = __builtin_amdgcn_readfirstlane(tid >> 6), lane = tid & 63, wr = wid >> 2, wc = wid & 3, fr = lane & 15, fq = lane >> 4;
    int nt = K / BK; asm volatile("" : "+s"(nt));
    unsigned roA[2][2], voffB[2][2];
    int RA[2], CA[2];
#pragma unroll
    for (int i = 0; i < 2; ++i) { int R, C; stage_rc(tid * 16 + i * 8192, R, C); const int Rb = Epi::PERM ? ((R & ~31) + perm32(R & 31)) : R;
        RA[i] = R; CA[i] = C * 2;
#pragma unroll
        for (int h = 0; h < 2; ++h) { roA[h][i] = (unsigned)((h * HALF + R) * lda + C) * 2u;
            const int p32 = perm32(R & 31); const int Bc = Epi::P16 ? (64 * (R >> 5) + 16 * (p32 >> 3) + 8 * h + (p32 & 7)) : (h * HALF + Rb);
            voffB[h][i] = (unsigned)(Bc * ldb + C) * 2u; } }
    const size_t kstep = (size_t)(BK * 2);
    const unsigned lda2 = (unsigned)lda * 2u;
    const unsigned ldsw = (unsigned)wid * 1024u;
    const int aoff = lds_byte(wr * 64 + fr, fq * 8), boff = lds_byte(wc * 32 + fr, fq * 8);
#define PG8_SA(b, h) (((b) * 2 + (h)) * HTB)
#define PG8_SB(b, h) ((4 + (b) * 2 + (h)) * HTB)
#define PG8_STAGE(bufoff, gbase, voff) do { const char* _gb = (const char*)(gbase); asm volatile("" : "+s"(_gb)); _Pragma("unroll") for (int _i = 0; _i < 2; ++_i) \
        __builtin_amdgcn_global_load_lds((const unsigned*)(_gb + (voff)[_i]), (LAS unsigned*)(lds + (bufoff) + ldsw + _i * 8192), 16, 0, 0); } while (0)
#define PG8_STAGE_A(bufoff, gbase, h) PG8_STAGE(bufoff, gbase, roA[h])
#define PG8_LDA(dst, b, h) do { _Pragma("unroll") for (int m = 0; m < 4; ++m) _Pragma("unroll") for (int k = 0; k < 2; ++k) dst[m][k] = *(const LAS bf16x8*)(lds + PG8_SA(b, h) + aoff + m * 2048 + k * 1024); } while (0)
#define PG8_LDB(dst, b, h) do { _Pragma("unroll") for (int n = 0; n < 2; ++n) _Pragma("unroll") for (int k = 0; k < 2; ++k) dst[n][k] = *(const LAS bf16x8*)(lds + PG8_SB(b, h) + boff + n * 2048 + k * 1024); } while (0)
#define PG8_MMA(ai, bj, At, Bt) do { __builtin_amdgcn_s_setprio(1); if constexpr (FP8) asm volatile("s_nop 1"); _Pragma("unroll") for (int m = 0; m < 4; ++m) _Pragma("unroll") for (int n = 0; n < 2; ++n) { \
        if constexpr (FP8) mfma_fp8(acc[ai][bj][m][n], cat8(Bt[n][0], Bt[n][1]), cat8(At[m][0], At[m][1]), SCW, SCA); \
        else { _Pragma("unroll") for (int k = 0; k < 2; ++k) acc[ai][bj][m][n] = __builtin_amdgcn_mfma_f32_16x16x32_bf16(Bt[n][k], At[m][k], acc[ai][bj][m][n], 0, 0, 0); } } __builtin_amdgcn_s_setprio(0); } while (0)
#define PG8_WAIT_V(n) asm volatile("s_waitcnt vmcnt(" #n ")" ::: "memory")
#define PG8_WAIT_L(n) asm volatile("s_waitcnt lgkmcnt(" #n ")" ::: "memory")
#define PG8_BAR __builtin_amdgcn_s_barrier()
#define PG8_SCHED __builtin_amdgcn_sched_barrier(0)
#define PG8_LOAD_RO() do { _Pragma("unroll") for (int _h = 0; _h < 2; ++_h) _Pragma("unroll") for (int _i = 0; _i < 2; ++_i) roA[_h][_i] = gtl[_h * HALF + RA[_i]] * lda2 + (unsigned)CA[_i]; } while (0)
    GUnit cur, nxt; int ui = 0;
    if (!S.next(0, cur)) { pre(); return; }
    f32x4 acc[2][2][4][2];
#pragma unroll
    for (int a = 0; a < 2; ++a)
#pragma unroll
        for (int b = 0; b < 2; ++b)
#pragma unroll
            for (int m = 0; m < 4; ++m)
#pragma unroll
                for (int n = 0; n < 2; ++n) acc[a][b][m][n] = (f32x4){0.f, 0.f, 0.f, 0.f};
    bf16x8 At[4][2], B0[2][2], B1[2][2];
    const char* cA = cur.A; const char* cB = cur.B;
    if constexpr (GATHER) {
        if (wid < 4) __builtin_amdgcn_global_load_lds((const unsigned*)(cur.gtab + wid * 64 + lane), (LAS unsigned*)(gtl + wid * 64), 4, 0, 0);
        PG8_WAIT_V(0); PG8_BAR; asm volatile("" ::: "memory");
        PG8_LOAD_RO();
        PG8_WAIT_L(0); PG8_BAR; asm volatile("" ::: "memory");
    }
    PG8_STAGE(PG8_SB(0, 0), cB, voffB[0]); PG8_STAGE(PG8_SB(0, 1), cB, voffB[1]); PG8_STAGE_A(PG8_SA(0, 0), cA, 0); PG8_STAGE_A(PG8_SA(0, 1), cA, 1);
    if (wr == 1) PG8_BAR;
    PG8_WAIT_V(2); PG8_BAR;
    PG8_STAGE(PG8_SB(1, 0), cB + kstep, voffB[0]); PG8_STAGE_A(PG8_SA(1, 0), cA + kstep, 0); PG8_STAGE(PG8_SB(1, 1), cB + kstep, voffB[1]);
    PG8_WAIT_V(6); PG8_BAR;
    for (;;) {
        const bool has_next = S.next(ui + 1, nxt);
        const char* nA = has_next ? nxt.A : cA; const char* nB = has_next ? nxt.B : cB;
#pragma unroll 1
        for (int t = 0; t < nt; t += 2) {
            const bool last = (t == nt - 2);
            asm volatile("" : "+v"(voffB[0][0]), "+v"(voffB[0][1]), "+v"(voffB[1][0]), "+v"(voffB[1][1]), "+v"(roA[0][0]), "+v"(roA[0][1]), "+v"(roA[1][0]), "+v"(roA[1][1]));
            const char* a1 = cA + (size_t)(t + 1) * kstep;
            const char* a2 = last ? nA : cA + (size_t)(t + 2) * kstep; const char* b2 = last ? nB : cB + (size_t)(t + 2) * kstep;
            const char* a3 = a2 + kstep; const char* b3 = b2 + kstep;
            if constexpr (Epi::ETAB) {
                if (t == 0) { const unsigned* src = (wid < 4) ? (cur.e0 + wid * 64 + lane) : (cur.e1 + (wid - 4) * 64 + lane);
                    __builtin_amdgcn_global_load_lds(src, (LAS unsigned*)(etl + (ui & 1) * 512 + wid * 64), 4, 0, 0); }
            }
            if constexpr (GATHER) {
                if (has_next && t == nt - 4 && wid < 4) __builtin_amdgcn_global_load_lds((const unsigned*)(nxt.gtab + wid * 64 + lane), (LAS unsigned*)(gtl + wid * 64), 4, 0, 0);
            }
            PG8_LDB(B0, 0, 0); PG8_LDB(B1, 0, 1); PG8_SCHED; PG8_LDA(At, 0, 0); PG8_STAGE_A(PG8_SA(1, 1), a1, 1);
            PG8_WAIT_V(8); PG8_WAIT_L(0); PG8_BAR; PG8_MMA(0, 0, At, B0); PG8_MMA(0, 1, At, B1); PG8_BAR; PG8_SCHED;
            if constexpr (GATHER) { if (last && has_next) { asm volatile("" ::: "memory"); PG8_LOAD_RO(); } }
            PG8_LDA(At, 0, 1); PG8_STAGE(PG8_SB(0, 0), b2, voffB[0]); PG8_STAGE(PG8_SB(0, 1), b2, voffB[1]); PG8_STAGE_A(PG8_SA(0, 0), a2, 0);
            PG8_WAIT_V(8); PG8_WAIT_L(0); PG8_BAR; PG8_MMA(1, 0, At, B0); PG8_MMA(1, 1, At, B1); PG8_BAR; PG8_SCHED;
            PG8_LDB(B0, 1, 0); PG8_LDB(B1, 1, 1); PG8_SCHED; PG8_LDA(At, 1, 0); PG8_STAGE_A(PG8_SA(0, 1), a2, 1);
            PG8_WAIT_V(8); PG8_WAIT_L(0); PG8_BAR; PG8_MMA(0, 0, At, B0); PG8_MMA(0, 1, At, B1); PG8_BAR; PG8_SCHED;
            PG8_LDA(At, 1, 1); PG8_STAGE(PG8_SB(1, 0), b3, voffB[0]); PG8_STAGE(PG8_SB(1, 1), b3, voffB[1]); PG8_STAGE_A(PG8_SA(1, 0), a3, 0);
            PG8_WAIT_V(8); PG8_WAIT_L(0); PG8_BAR; PG8_MMA(1, 0, At, B0); PG8_MMA(1, 1, At, B1); PG8_BAR; PG8_SCHED;
        }
        if (wr == 0) PG8_BAR;
        if (ui == 0) pre();
        if constexpr (FP8) asm volatile("s_nop 15\n\ts_nop 15");
#pragma unroll
        for (int a = 0; a < 2; ++a)
#pragma unroll
            for (int b = 0; b < 2; ++b)
#pragma unroll
                for (int m = 0; m < 4; ++m)
#pragma unroll
                    for (int n = 0; n < 2; ++n) asm volatile("" : "+v"(acc[a][b][m][n]));
        E(acc, cur, wr, wc, fr, fq, etl + (ui & 1) * 512);
        if (!has_next) break;
#pragma unroll
        for (int a = 0; a < 2; ++a)
#pragma unroll
            for (int b = 0; b < 2; ++b)
#pragma unroll
                for (int m = 0; m < 4; ++m)
#pragma unroll
                    for (int n = 0; n < 2; ++n) acc[a][b][m][n] = (f32x4){0.f, 0.f, 0.f, 0.f};
        cur = nxt; cA = nA; cB = nB; ++ui;
        if (wr == 1) PG8_BAR;
    }
    PG8_WAIT_V(0);
    PG8_BAR;
#undef PG8_SA
#undef PG8_SB
#undef PG8_STAGE
#undef PG8_STAGE_A
#undef PG8_LDA
#undef PG8_LDB
#undef PG8_MMA
#undef PG8_WAIT_V
#undef PG8_WAIT_L
#undef PG8_BAR
#undef PG8_SCHED
#undef PG8_LOAD_RO
}
}

#define XB_TMO      128
#define XB_XCNT(j)  (256  + 64 * (j))
#define XB_XSUB(j)  (1280 + 64 * (j))
#define XB_XGEN(j)  (2304 + 64 * (j))
#define XB_TOP      3328
#define XB_TOPGEN   3392
#define XCD_BAR_WORDS 3456
#define XB_SPIN_CAP (1u << 18)

__device__ __forceinline__ unsigned xb_ld(unsigned* p)              { return __hip_atomic_load(p, __ATOMIC_RELAXED, __HIP_MEMORY_SCOPE_AGENT); }
__device__ __forceinline__ unsigned xb_add(unsigned* p, unsigned v) { return __hip_atomic_fetch_add(p, v, __ATOMIC_RELAXED, __HIP_MEMORY_SCOPE_AGENT); }
__device__ __forceinline__ unsigned xb_xcc_id() { return (unsigned)__builtin_amdgcn_s_getreg((3 << 11) | 20) & 0xFu; }
#define XB_SPIN(cond, bar) do { unsigned _sp = 0; while (cond) { __builtin_amdgcn_s_sleep(1); \
    if ((++_sp & 255u) == 0u) { if (xb_ld(&(bar)[XB_TMO])) break; if (_sp > XB_SPIN_CAP) { atomicAdd(&(bar)[XB_TMO], 1u); break; } } } } while (0)

struct XcdBarrier { unsigned* bar; unsigned x; volatile LAS unsigned* st; };

__device__ __forceinline__ XcdBarrier xcd_barrier_post(unsigned* bar, volatile LAS unsigned* st) {
    XcdBarrier b; b.bar = bar; b.x = xb_xcc_id(); b.st = st;
    if (threadIdx.x == 0) (void)xb_add(&bar[XB_XCNT(b.x)], 1u);
    return b;
}
__device__ __forceinline__ void xcd_barrier_complete(unsigned* bar, unsigned x, unsigned& nloc, unsigned& nx) {
    const unsigned G = gridDim.x * gridDim.y * gridDim.z;
    unsigned sum, cnt, mine, sp = 0u;
    for (;;) {
        sum = 0u; cnt = 0u; mine = 0u;
#pragma unroll
        for (unsigned j = 0; j < 16; ++j) { const unsigned c = xb_ld(&bar[XB_XCNT(j)]); sum += c; cnt += (c > 0u) ? 1u : 0u; mine = (j == x) ? c : mine; }
        if (sum == G) break;
        __builtin_amdgcn_s_sleep(1);
        if ((++sp & 255u) == 0u) { if (xb_ld(&bar[XB_TMO])) break; if (sp > XB_SPIN_CAP) { atomicAdd(&bar[XB_TMO], 1u); break; } }
    }
    nloc = mine > 0u ? mine : 1u; nx = cnt > 0u ? cnt : 1u;
}
__device__ __forceinline__ void xcd_barrier(const XcdBarrier& b) {
    asm volatile("s_waitcnt vmcnt(0)" ::: "memory");
    __syncthreads();
    if (threadIdx.x == 0) {
        unsigned* bar = b.bar;
        __builtin_amdgcn_s_waitcnt(0);
        unsigned nloc = b.st[0], nx = b.st[1];
        if (nloc == 0u) { xcd_barrier_complete(bar, b.x, nloc, nx); b.st[0] = nloc; b.st[1] = nx; }
        const unsigned old = xb_add(&bar[XB_XSUB(b.x)], 1u);
        const unsigned gen = old / nloc;
        if (old + 1u == (gen + 1u) * nloc) {
            __builtin_amdgcn_fence(__ATOMIC_RELEASE, "agent");
            asm volatile("s_waitcnt vmcnt(0)" ::: "memory");
            const unsigned og = xb_add(&bar[XB_TOP], 1u);
            const unsigned tg = og / nx;
            if (og + 1u == (tg + 1u) * nx) xb_add(&bar[XB_TOPGEN], 1u);
            else XB_SPIN(xb_ld(&bar[XB_TOPGEN]) == tg, bar);
            __builtin_amdgcn_fence(__ATOMIC_ACQUIRE, "agent");
            xb_add(&bar[XB_XGEN(b.x)], 1u);
            asm volatile("s_waitcnt vmcnt(0)" ::: "memory");
        } else {
            XB_SPIN(xb_ld(&bar[XB_XGEN(b.x)]) == gen, bar);
            __builtin_amdgcn_fence(__ATOMIC_ACQUIRE, "agent");
            asm volatile("s_waitcnt vmcnt(0)" ::: "memory");
        }
    }
    __syncthreads();
}

constexpr int NWAVES = 8, NTHR = 512;
struct Args { const float* in[23]; float* out; unsigned char* ws; int ph_lo, ph_hi; };
struct Frame {
    LAS unsigned char* lds;
    int tid, lane, wave, vcu, G;
    unsigned char* ws;
    const float* const* in;
};
struct Role { bool cvt; int rank, n; };
__device__ __forceinline__ Role cu_role(const Frame& F, int ncx) { Role r; if (F.G != 256) { r.cvt = false; r.rank = F.vcu; r.n = F.G; return r; }
    const int x = F.vcu >> 5, j = F.vcu & 31; r.cvt = j >= 32 - ncx; if (r.cvt) { r.rank = x * ncx + (j - (32 - ncx)); r.n = 8 * ncx; } else { r.rank = x * (32 - ncx) + j; r.n = 8 * (32 - ncx); } return r; }
enum { I_X = 0, I_C, I_CTX, I_CCTX, I_WADA, I_BADA, I_G1, I_G2, I_WQKV, I_GQ, I_GK, I_SINK, I_WO, I_WPOOL, I_PSCALE, I_WR, I_BR, I_WG, I_WU, I_WD, I_SG, I_SU, I_SD };

__device__ __forceinline__ unsigned f2bf(float f) { unsigned u = __builtin_bit_cast(unsigned, f); return (u + 0x7fffu + ((u >> 16) & 1u)) >> 16; }
__device__ __forceinline__ unsigned pk2(float lo, float hi) { return f2bf(lo) | (f2bf(hi) << 16); }
typedef short v4i16_t __attribute__((ext_vector_type(4)));
__device__ __forceinline__ void p0_transpose_item(const float* W, int N, bf16* WT, int ldt, int drow0, int k0, int n0, LAS unsigned char* scr, int lane) {
    constexpr int RS = 192;
    const int lk = lane >> 4, ln = (lane & 15) * 4;
    f32x4 v[16];
#pragma unroll
    for (int i = 0; i < 16; ++i) v[i] = *(const GAS f32x4*)(W + (size_t)(k0 + 4 * i + lk) * N + n0 + ln);
#pragma unroll
    for (int i = 0; i < 16; ++i) { v2u w; w.x = cvt_pk_bf16(v[i].x, v[i].y); w.y = cvt_pk_bf16(v[i].z, v[i].w); *(LAS v2u*)(scr + (4 * i + lk) * RS + ln * 2) = w; }
    LDS_WAIT(); asm volatile("" ::: "memory");
    const int g = lane >> 4, q = (lane >> 2) & 3, pp = lane & 3;
    const LAS unsigned char* rb = scr + q * RS + (16 * g + 4 * pp) * 2;
    bf16* orow = WT + (size_t)(drow0 + 16 * g + (lane & 15)) * ldt + k0;
#pragma unroll
    for (int j = 0; j < 8; ++j) {
        const v4i16_t a = __builtin_amdgcn_ds_read_tr16_b64_v4i16((LAS v4i16_t*)(rb + (8 * j) * RS)), b = __builtin_amdgcn_ds_read_tr16_b64_v4i16((LAS v4i16_t*)(rb + (8 * j + 4) * RS));
        const v2u a2 = __builtin_bit_cast(v2u, a), b2 = __builtin_bit_cast(v2u, b);
        *(GAS v4u*)(orow + 8 * j) = (v4u){a2.x, a2.y, b2.x, b2.y}; }
    LDS_WAIT(); asm volatile("" ::: "memory");
}

__host__ __device__ __forceinline__ int qk_hcol(int d) { const int f = d & 31; return (d & 64) + 16 * (f >> 3) + 8 * ((d >> 5) & 1) + (f & 7); }
struct CvtTile { const float* src; unsigned char* dst; int N, ldt, k0, n0, gu; float scale; };
__device__ __forceinline__ void cvt_decode(Frame& F, int l, int id, CvtTile& t) {
    if (l == 2) {
        if (id < 192) { t.src = F.in[I_WQKV]; t.dst = F.ws + WS_WQKV; t.N = 3072; t.k0 = (id / 12) * 128; t.n0 = (id % 12) * 256; t.gu = 3; }
        else if (id < 320) { const int r = id - 192; t.src = F.in[I_WO]; t.dst = F.ws + WS_WO; t.N = D; t.k0 = (r / 8) * 128; t.n0 = (r % 8) * 256; t.gu = 0; }
        else { const int r = id - 320, g = r >> 3, r2 = r & 7;
            t.src = F.in[I_WPOOL] + (size_t)g * 512 * 512; t.dst = F.ws + WS_WPOOL + (size_t)g * 512 * 512; t.N = 512; t.ldt = 512; t.k0 = (r2 >> 1) * 128; t.n0 = (r2 & 1) * 256; t.gu = 0; t.scale = PW_SCALE; return; }
        t.ldt = D; t.scale = W1_SCALE; return; }
    const int m = id >> 5, r = id & 31, type = m % 3, e = m / 3;
    if (type < 2) { t.src = (e < NE) ? (F.in[type == 0 ? I_WG : I_WU] + (size_t)(l * NE + e) * D * FF) : (F.in[type == 0 ? I_SG : I_SU] + (size_t)l * D * FF);
        t.dst = F.ws + WS_W1 + (size_t)(l * NE1 + e) * 1024 * D; t.N = FF; t.ldt = D; t.k0 = (r >> 1) * 128; t.n0 = (r & 1) * 256; t.gu = 1 + type; t.scale = W1_SCALE;
    } else { t.src = (e < NE) ? (F.in[I_WD] + (size_t)(l * NE + e) * FF * D) : (F.in[I_SD] + (size_t)l * FF * D);
        t.dst = F.ws + WS_W2 + (size_t)(l * NE1 + e) * D * FF; t.N = D; t.ldt = FF; t.k0 = (r >> 3) * 128; t.n0 = (r & 7) * 256; t.gu = 0; t.scale = W2_SCALE; }
}
__device__ __forceinline__ void cvt_load(const CvtTile& t, f32x4 (&v)[16], int wave, int lane) {
    const float* p = t.src + (size_t)(t.k0 + wave * 16) * t.N + t.n0 + lane * 4;
#pragma unroll
    for (int i = 0; i < 16; ++i) v[i] = __builtin_nontemporal_load((const GAS f32x4*)(p + (size_t)i * t.N));
}
__device__ __forceinline__ void cvt_finish(const CvtTile& t, const f32x4 (&v)[16], LAS unsigned char* img, int wave, int lane) {
    constexpr int RS = 576;
    const float scale = t.scale;
#pragma unroll
    for (int i = 0; i < 16; ++i) { v2u w; w.x = cvt_pk_bf16(v[i].x * scale, v[i].y * scale); w.y = cvt_pk_bf16(v[i].z * scale, v[i].w * scale); *(LAS v2u*)(img + (wave * 16 + i) * RS + lane * 8) = w; }
    LDS_WAIT(); __builtin_amdgcn_s_barrier(); asm volatile("" ::: "memory");
    const int g = lane >> 4, cb = g & 1, kh = g >> 1, q = (lane >> 2) & 3, pp = lane & 3;
    const int ncol = 32 * wave + 16 * cb + (lane & 15);
    const LAS unsigned char* rb = img + (64 * kh + q) * RS + (32 * wave + 16 * cb + 4 * pp) * 2;
    const int c = t.n0 + ncol; int drow = c;
    if (t.gu == 1 || t.gu == 2) drow = (c >> 7) * 256 + (c & 127) + (t.gu == 2 ? 128 : 0);
    else if (t.gu == 3 && c < 2560) { const int d = c & 127; drow = (c & ~127) + qk_hcol(d); }
    unsigned char* orow = t.dst + (size_t)drow * t.ldt + t.k0 + 64 * kh;
#pragma unroll
    for (int j = 0; j < 4; ++j) { v2u tt[4];
#pragma unroll
        for (int h = 0; h < 4; ++h) tt[h] = __builtin_bit_cast(v2u, __builtin_amdgcn_ds_read_tr16_b64_v4i16((LAS v4i16_t*)(rb + (16 * j + 4 * h) * RS)));
        v4u o;
        o.x = pk4_fp8(bflo(tt[0].x), bfhi(tt[0].x), bflo(tt[0].y), bfhi(tt[0].y)); o.y = pk4_fp8(bflo(tt[1].x), bfhi(tt[1].x), bflo(tt[1].y), bfhi(tt[1].y));
        o.z = pk4_fp8(bflo(tt[2].x), bfhi(tt[2].x), bflo(tt[2].y), bfhi(tt[2].y)); o.w = pk4_fp8(bflo(tt[3].x), bfhi(tt[3].x), bflo(tt[3].y), bfhi(tt[3].y));
        *(GAS v4u*)(orow + 16 * j) = o; }
    LDS_WAIT(); __builtin_amdgcn_s_barrier(); asm volatile("" ::: "memory");
}
constexpr int CVT_PER_LAYER = NE1 * 3 * 32;
__device__ __forceinline__ void convert_experts(Frame& F, const int l, const int lo, const int hi, const int brank, const int nb) {
    LAS unsigned char* img = F.lds;
    int id = lo + brank; if (id >= hi) return;
    __syncthreads();
    CvtTile ca, cb; f32x4 va[16], vb[16];
    cvt_decode(F, l, id, ca); cvt_load(ca, va, F.wave, F.lane);
    for (;;) {
        const int id1 = id + nb; const bool m1 = id1 < hi;
        if (m1) { cvt_decode(F, l, id1, cb); cvt_load(cb, vb, F.wave, F.lane); }
        cvt_finish(ca, va, img, F.wave, F.lane);
        if (!m1) break;
        const int id2 = id1 + nb; const bool m2 = id2 < hi;
        if (m2) { cvt_decode(F, l, id2, ca); cvt_load(ca, va, F.wave, F.lane); }
        cvt_finish(cb, vb, img, F.wave, F.lane);
        if (!m2) break;
        id = id2;
    }
}

constexpr int NDENSE = 352;
constexpr int CVT_ALL = NDENSE + 2 * CVT_PER_LAYER;
__device__ __forceinline__ void cvt_decode_all(Frame& F, int id, CvtTile& t) { if (id < NDENSE) cvt_decode(F, 2, id, t); else if (id < NDENSE + CVT_PER_LAYER) cvt_decode(F, 0, id - NDENSE, t); else cvt_decode(F, 1, id - NDENSE - CVT_PER_LAYER, t); }
__device__ __forceinline__ int cvt_publish(volatile LAS unsigned* slot, unsigned tk, int tid) {
    if (tid == 0) *slot = tk;
    LDS_WAIT(); __builtin_amdgcn_s_barrier(); asm volatile("" ::: "memory");
    const int id = (int)*slot;
    LDS_WAIT(); __builtin_amdgcn_s_barrier(); asm volatile("" ::: "memory");
    return __builtin_amdgcn_readfirstlane(id);
}
__device__ __forceinline__ void cvt_signal(Frame& F, const int id) {
    if (id < 192) {
        asm volatile("s_waitcnt vmcnt(0)" ::: "memory"); __syncthreads();
        if (F.tid == 0) { __builtin_amdgcn_fence(__ATOMIC_RELEASE, "agent"); asm volatile("s_waitcnt vmcnt(0)" ::: "memory"); __hip_atomic_fetch_add((unsigned*)(F.ws + WS_CTL) + CW_QKV, 1u, RLX_AGENT); }
    }
}
__device__ __forceinline__ void convert_all_dynamic(Frame& F, unsigned* ctr) {
    LAS unsigned char* img = F.lds; volatile LAS unsigned* slot = (volatile LAS unsigned*)(F.lds + MISC_OFF + 64);
    __syncthreads();
    unsigned tk0 = 0u, tk1 = 0u;
    if (F.tid == 0) { tk0 = __hip_atomic_fetch_add(ctr, 1u, RLX_AGENT); tk1 = __hip_atomic_fetch_add(ctr, 1u, RLX_AGENT); }
    CvtTile ca, cb; f32x4 va[16], vb[16];
    int ida = cvt_publish(slot, tk0, F.tid); if (ida >= CVT_ALL) return;
    cvt_decode_all(F, ida, ca); cvt_load(ca, va, F.wave, F.lane);
    for (;;) {
        const int idb = cvt_publish(slot, tk1, F.tid); if (F.tid == 0) tk1 = __hip_atomic_fetch_add(ctr, 1u, RLX_AGENT);
        const bool mb = idb < CVT_ALL;
        if (mb) { cvt_decode_all(F, idb, cb); cvt_load(cb, vb, F.wave, F.lane); }
        cvt_finish(ca, va, img, F.wave, F.lane); cvt_signal(F, ida);
        if (!mb) break;
        ida = cvt_publish(slot, tk1, F.tid); if (F.tid == 0) tk1 = __hip_atomic_fetch_add(ctr, 1u, RLX_AGENT);
        const bool ma = ida < CVT_ALL;
        if (ma) { cvt_decode_all(F, ida, ca); cvt_load(ca, va, F.wave, F.lane); }
        cvt_finish(cb, vb, img, F.wave, F.lane); cvt_signal(F, idb);
        if (!ma) break;
    }
}

__device__ __forceinline__ void p0_prologue(Frame& F) {
    const int gw = F.vcu * NWAVES + F.wave, NGW = F.G * NWAVES;
    const int gtid = gw * 64 + F.lane, NGT = NGW * 64;
    unsigned char* ws = F.ws;
    __syncthreads();
    if (F.vcu < 96) {
        const int l = F.vcu / 48, jg = F.vcu % 48, j0 = jg * 256;
        LAS float* sil = (LAS float*)F.lds;
        LAS float* red = (LAS float*)(F.lds + 24576);
        for (int i = F.tid; i < 3 * D; i += NTHR) { const int r = i / D, k = i % D; const float v = (r < 2) ? F.in[I_C][r * D + k] : F.in[I_CCTX][k]; sil[i] = v * fast_sigmoid(v); }
        __syncthreads();
        const float* wa = F.in[I_WADA] + (size_t)l * D * (6 * D) + j0 + F.lane * 4;
        f32x4 a0 = {0.f, 0.f, 0.f, 0.f}, a1 = a0, a2 = a0;
        const int kb = F.wave * 256;
#pragma unroll 8
        for (int k = 0; k < 256; ++k) { const f32x4 w = *(const GAS f32x4*)(wa + (size_t)(kb + k) * (6 * D)); const float s0 = sil[kb + k], s1 = sil[D + kb + k], s2 = sil[2 * D + kb + k]; a0 += w * s0; a1 += w * s1; a2 += w * s2; }
        *(LAS f32x4*)(red + (F.wave * 3 + 0) * 256 + F.lane * 4) = a0; *(LAS f32x4*)(red + (F.wave * 3 + 1) * 256 + F.lane * 4) = a1; *(LAS f32x4*)(red + (F.wave * 3 + 2) * 256 + F.lane * 4) = a2;
        __syncthreads();
        for (int i = F.tid; i < 768; i += NTHR) { const int r = i / 256, c = i % 256; float s = F.in[I_BADA][l * 6 * D + j0 + c];
#pragma unroll
            for (int w = 0; w < 8; ++w) s += red[(w * 3 + r) * 256 + c];
            ((float*)(ws + WS_MOD))[(size_t)(l * 3 + r) * 6 * D + j0 + c] = s; }
        __syncthreads();
    }
    for (int l = 0; l < 2; ++l) {
        v4u* t4 = (v4u*)(ws + WS_TOK + l * LIST_L); v4u* d4 = (v4u*)(ws + WS_DST + l * LIST_L);
        for (int i = gtid; i < NE * ECAP / 4; i += NGT) { t4[i] = (v4u){0u, 0u, 0u, 0u}; d4[i] = (v4u){0u, 0u, 0u, 0u}; }
        unsigned* ts = (unsigned*)(ws + WS_TOK + l * LIST_L) + NE * ECAP; unsigned* ds = (unsigned*)(ws + WS_DST + l * LIST_L) + NE * ECAP; float* gs = (float*)(ws + WS_GW + l * LIST_L) + NE * ECAP;
        for (int i = gtid; i < M; i += NGT) { ts[i] = (unsigned)i; ds[i] = (unsigned)(i * 9 + 8 + 1); gs[i] = 1.0f; }
    }
    for (int i = gtid; i < 128 * 32; i += NGT) { const int p = i >> 5, f = i & 31; const float inv = powf(10000.0f, -(float)f / 32.0f); const float a = (float)p * inv;
        ((float*)(ws + WS_ROPE))[i] = cosf(a); ((float*)(ws + WS_ROPE))[4096 + i] = sinf(a); }
    for (int i = gtid; i < 2 * NE * D; i += NGT) { const int l = i / (NE * D), r = i % (NE * D), e = r / D, k = r % D; const float w = F.in[I_WR][((size_t)l * D + k) * NE + e];
        const unsigned hi = f2bf(w); const float lo = w - __uint_as_float(hi << 16);
        bf16* wr = (bf16*)(ws + WS_WR) + (size_t)l * 2 * NE * D; wr[e * D + k] = (bf16)hi; wr[NE * D + e * D + k] = (bf16)f2bf(lo); }
    LAS unsigned char* scr = F.lds + F.wave * 12288;
    __syncthreads();
    asm volatile("s_waitcnt vmcnt(0)" ::: "memory"); __syncthreads();
    if (F.tid == 0) { __builtin_amdgcn_fence(__ATOMIC_RELEASE, "agent"); asm volatile("s_waitcnt vmcnt(0)" ::: "memory"); __hip_atomic_fetch_add((unsigned*)(ws + WS_CTL) + CW_PRO, 1u, RLX_AGENT); }
}

struct ModVec { f32x4 a[8], b[8]; };
__device__ __forceinline__ void load_modvec(ModVec& mv, const float* gnorm, const float* shift, const float* scale, int lane) {
#pragma unroll
    for (int jj = 0; jj < 8; ++jj) { const int col = 4 * lane + 256 * jj;
        const f32x4 g = *(const GAS f32x4*)(gnorm + col), sc = *(const GAS f32x4*)(scale + col); mv.a[jj] = g * (sc + 1.0f); mv.b[jj] = *(const GAS f32x4*)(shift + col); }
}
__device__ __forceinline__ void norm_mod_store(const f32x4 (&v)[8], const ModVec& mv, bf16* orow, int lane) {
    float ss = 0.f;
#pragma unroll
    for (int jj = 0; jj < 8; ++jj) ss += (v[jj].x * v[jj].x + v[jj].y * v[jj].y) + (v[jj].z * v[jj].z + v[jj].w * v[jj].w);
    const float rstd = 1.0f / sqrtf(wave_sum(ss) * (1.0f / D) + EPS);
#pragma unroll
    for (int jj = 0; jj < 8; ++jj) { const f32x4 o = v[jj] * rstd * mv.a[jj] + mv.b[jj]; v2u w; w.x = cvt_pk_bf16(o.x, o.y); w.y = cvt_pk_bf16(o.z, o.w);
        *(GAS v2u*)(orow + 4 * lane + 256 * jj) = w; }
}
__device__ __forceinline__ void norm_mod_store_fp8(const f32x4 (&v)[8], const ModVec& mv, unsigned char* orow, int lane, float scale) {
    float ss = 0.f;
#pragma unroll
    for (int jj = 0; jj < 8; ++jj) ss += (v[jj].x * v[jj].x + v[jj].y * v[jj].y) + (v[jj].z * v[jj].z + v[jj].w * v[jj].w);
    const float rstd = 1.0f / sqrtf(wave_sum(ss) * (1.0f / D) + EPS);
#pragma unroll
    for (int jj = 0; jj < 8; ++jj) { const f32x4 o = (v[jj] * rstd * mv.a[jj] + mv.b[jj]) * scale; *(GAS unsigned*)(orow + 4 * lane + 256 * jj) = pk4_fp8(o.x, o.y, o.z, o.w); }
}
__device__ __forceinline__ const float* modp(Frame& F, int l, int r, int which) { return (const float*)(F.ws + WS_MOD) + (size_t)(l * 3 + r) * 6 * D + which * D; }

__device__ __forceinline__ void p1_norm1(Frame& F) {
    const int gw = F.vcu * NWAVES + F.wave, NGW = F.G * NWAVES;
    unsigned char* HN = F.ws + WS_ACTA;
    for (int rb = gw; rb < M / 8; rb += NGW) {
        const int row0 = rb * 8, b = row0 / S;
        ModVec mv; load_modvec(mv, F.in[I_G1], modp(F, 0, b, 0), modp(F, 0, b, 1), F.lane);
        for (int j = 0; j < 8; ++j) { const int row = row0 + j; f32x4 v[8];
#pragma unroll
            for (int jj = 0; jj < 8; ++jj) v[jj] = *(const GAS f32x4*)(F.in[I_X] + (size_t)row * D + 4 * F.lane + 256 * jj);
            norm_mod_store_fp8(v, mv, HN + (size_t)row * D, F.lane, H2_SCALE); }
    }
}

using pg8::GUnit;
struct SchedQK { const char* A; const char* B; int G, c, lim;
    __device__ __forceinline__ bool next(int i, GUnit& u) const { const int L = i * G + c; if (L >= lim) return false; int pm, pn; if (L < 640) { pm = L / 10; pn = L % 10; } else { pm = 64 + (L - 640) / 2; pn = 8 + (L - 640) % 2; }
        u.A = A + (size_t)pm * 256 * D; u.B = B + (size_t)pn * 256 * D; u.gtab = nullptr; u.e0 = nullptr; u.e1 = nullptr; u.i0 = pm; u.i1 = pn; u.i2 = 0; u.i3 = 0; return true; } };
struct EpiQK { static constexpr bool ETAB = false; static constexpr bool P16 = true; static constexpr bool PERM = true; bf16* Q; bf16* Kb; const float* gq; const float* gk; const float* rope; LAS float* xch;
    __device__ __forceinline__ void operator()(const f32x4 (&acc)[2][2][4][2], const GUnit& u, int wr, int wc, int fr, int fq, const LAS unsigned* et) const {
        const int pm = u.i0, pn = u.i1; bf16* base; int ldc, colt; const float* g; float scale;
        if (pn < 8) { base = Q; ldc = D; colt = pn * 256; g = gq; scale = QSCALE; } else { base = Kb; ldc = 512; colt = (pn - 8) * 256; g = gk; scale = 1.0f; }
        const int axis = wc & 1, rloc0 = wr * 64 + fr;
#pragma unroll
        for (int ai = 0; ai < 2; ++ai)
#pragma unroll
            for (int m = 0; m < 4; ++m) { float ss = 0.f;
#pragma unroll
                for (int bj = 0; bj < 2; ++bj)
#pragma unroll
                    for (int n = 0; n < 2; ++n) { const f32x4 x = acc[ai][bj][m][n]; ss += (x.x * x.x + x.y * x.y) + (x.z * x.z + x.w * x.w); }
                ss += __shfl_xor(ss, 16); ss += __shfl_xor(ss, 32);
                if (fq == 0) xch[(rloc0 + ai * 128 + m * 16) * 4 + wc] = ss; }
        const f32x4 g1a = *(const GAS f32x4*)(g + axis * 64 + 8 * fq), g1b = *(const GAS f32x4*)(g + axis * 64 + 8 * fq + 4), g2a = *(const GAS f32x4*)(g + axis * 64 + 32 + 8 * fq), g2b = *(const GAS f32x4*)(g + axis * 64 + 32 + 8 * fq + 4);
        asm volatile("s_waitcnt lgkmcnt(0)" ::: "memory"); __builtin_amdgcn_s_barrier(); asm volatile("" ::: "memory");
        const int row0 = pm * 256 + rloc0, col0 = colt + wc * 64 + 16 * fq; const bool lat = pm < 64;
#pragma unroll
        for (int ai = 0; ai < 2; ++ai)
#pragma unroll
            for (int m = 0; m < 4; ++m) { const int rl = rloc0 + ai * 128 + m * 16, row = row0 + ai * 128 + m * 16;
                const float r = 1.0f / sqrtf((xch[rl * 4 + wc] + xch[rl * 4 + (wc ^ 1)]) * (1.0f / HD) + EPS);
                f32x4 ca = {1.f, 1.f, 1.f, 1.f}, cb = ca, sa = {0.f, 0.f, 0.f, 0.f}, sb = sa;
                if (lat) { const int sq = row & (S - 1), pos = axis ? (sq & 63) : (sq >> 6); const float* rp = rope + pos * 32 + 8 * fq;
                    ca = *(const GAS f32x4*)rp; cb = *(const GAS f32x4*)(rp + 4); sa = *(const GAS f32x4*)(rp + 4096); sb = *(const GAS f32x4*)(rp + 4100); }
                const f32x4 y1a = acc[ai][0][m][0] * r * g1a, y1b = acc[ai][0][m][1] * r * g1b, y2a = acc[ai][1][m][0] * r * g2a, y2b = acc[ai][1][m][1] * r * g2b;
                const f32x4 o1a = (y1a * ca - y2a * sa) * scale, o1b = (y1b * cb - y2b * sb) * scale, o2a = (y2a * ca + y1a * sa) * scale, o2b = (y2b * cb + y1b * sb) * scale;
                bf16* rowp = base + (size_t)row * ldc + col0;
                v4u w; w.x = cvt_pk_bf16(o1a.x, o1a.y); w.y = cvt_pk_bf16(o1a.z, o1a.w); w.z = cvt_pk_bf16(o1b.x, o1b.y); w.w = cvt_pk_bf16(o1b.z, o1b.w); *(GAS v4u*)rowp = w;
                w.x = cvt_pk_bf16(o2a.x, o2a.y); w.y = cvt_pk_bf16(o2a.z, o2a.w); w.z = cvt_pk_bf16(o2b.x, o2b.y); w.w = cvt_pk_bf16(o2b.z, o2b.w); *(GAS v4u*)(rowp + 8) = w; }
    } };
struct SchedVT { const char* A; const char* B; int G, c, lim;
    __device__ __forceinline__ bool next(int i, GUnit& u) const { const int L = i * G + c; if (L >= lim) return false; const int pmv = L % 2, pnv = L / 2;
        u.A = A + (size_t)pmv * 256 * D; u.B = B + (size_t)pnv * 256 * D; u.gtab = nullptr; u.e0 = nullptr; u.e1 = nullptr; u.i0 = pmv; u.i1 = pnv; u.i2 = 0; u.i3 = 0; return true; } };
struct EpiVT { static constexpr bool ETAB = false; static constexpr bool P16 = true; static constexpr bool PERM = true; bf16* Vt;
    __device__ __forceinline__ void operator()(const f32x4 (&acc)[2][2][4][2], const GUnit& u, int wr, int wc, int fr, int fq, const LAS unsigned* et) const {
        const int row0 = u.i0 * 256 + wr * 64 + fr, col0 = u.i1 * 256 + wc * 64 + 16 * fq;
#pragma unroll
        for (int ai = 0; ai < 2; ++ai)
#pragma unroll
            for (int m = 0; m < 4; ++m) { bf16* rowp = Vt + (size_t)(row0 + ai * 128 + m * 16) * MT + col0;
#pragma unroll
                for (int h = 0; h < 2; ++h) { const f32x4 v0 = acc[ai][0][m][h], v1 = acc[ai][1][m][h]; v4u w; w.x = cvt_pk_bf16(v0[0], v0[1]); w.y = cvt_pk_bf16(v0[2], v0[3]); w.z = cvt_pk_bf16(v1[0], v1[1]); w.w = cvt_pk_bf16(v1[2], v1[3]);
                    *(GAS v4u*)(rowp + h * 8) = w; } }
    } };
struct SchedRes { const char* A; const char* B; int G, c, mode;
    __device__ __forceinline__ bool next(int i, GUnit& u) const { const int L = i * G + c; if (L >= 512) return false; const int pm = L / 8, pn = L % 8;
        if (mode == 0) { u.A = A + (size_t)pm * 256 * D; u.B = B + (size_t)pn * 256 * D; }
        else { const int g = pn / 2, p2 = pn % 2; u.A = A + (size_t)pm * 256 * D + (size_t)g * 512; u.B = B + ((size_t)g * 512 + p2 * 256) * 512; }
        u.gtab = nullptr; u.e0 = nullptr; u.e1 = nullptr; u.i0 = pm; u.i1 = pn; u.i2 = 0; u.i3 = 0; return true; } };
template <bool BASE_BF16> struct EpiRes { static constexpr bool ETAB = false; static constexpr bool P16 = true; static constexpr bool PERM = true; const void* base; bf16* out; const float* gate0; const float* gate1; const float* cs; float* ssq;
    __device__ __forceinline__ void operator()(const f32x4 (&acc)[2][2][4][2], const GUnit& u, int wr, int wc, int fr, int fq, const LAS unsigned* et) const {
        const int pm = u.i0, pn = u.i1; const float* gate = (pm < 32) ? gate0 : gate1;
        const int col0 = pn * 256 + wc * 64 + 16 * fq;
        f32x4 gv[2][2];
#pragma unroll
        for (int bj = 0; bj < 2; ++bj)
#pragma unroll
            for (int n = 0; n < 2; ++n) { gv[bj][n] = *(const GAS f32x4*)(gate + col0 + bj * 8 + n * 4); if (cs) gv[bj][n] = gv[bj][n] * *(const GAS f32x4*)(cs + col0 + bj * 8 + n * 4); }
        float sq[2][4];
#pragma unroll
        for (int ai = 0; ai < 2; ++ai) {
            f32x4 b[4][2][2];
#pragma unroll
            for (int m = 0; m < 4; ++m) { const size_t off = (size_t)(pm * 256 + ai * 128 + wr * 64 + m * 16 + fr) * D + col0;
#pragma unroll
                for (int bj = 0; bj < 2; ++bj) {
                    if constexpr (BASE_BF16) { const v4u r = *(const GAS v4u*)((const bf16*)base + off + bj * 8); b[m][bj][0] = __builtin_bit_cast(f32x4, r); }
                    else { b[m][bj][0] = *(const GAS f32x4*)((const float*)base + off + bj * 8); b[m][bj][1] = *(const GAS f32x4*)((const float*)base + off + bj * 8 + 4); } } }
#pragma unroll
            for (int m = 0; m < 4; ++m) { const size_t off = (size_t)(pm * 256 + ai * 128 + wr * 64 + m * 16 + fr) * D + col0; float s = 0.f;
#pragma unroll
                for (int bj = 0; bj < 2; ++bj) { f32x4 b0, b1;
                    if constexpr (BASE_BF16) { const v4u r = __builtin_bit_cast(v4u, b[m][bj][0]); b0 = (f32x4){bflo(r.x), bfhi(r.x), bflo(r.y), bfhi(r.y)}; b1 = (f32x4){bflo(r.z), bfhi(r.z), bflo(r.w), bfhi(r.w)}; }
                    else { b0 = b[m][bj][0]; b1 = b[m][bj][1]; }
                    const f32x4 o0 = b0 + gv[bj][0] * acc[ai][bj][m][0], o1 = b1 + gv[bj][1] * acc[ai][bj][m][1];
                    v4u w; w.x = cvt_pk_bf16(o0.x, o0.y); w.y = cvt_pk_bf16(o0.z, o0.w); w.z = cvt_pk_bf16(o1.x, o1.y); w.w = cvt_pk_bf16(o1.z, o1.w); *(GAS v4u*)(out + off + bj * 8) = w;
                    s += ((o0.x * o0.x + o0.y * o0.y) + (o0.z * o0.z + o0.w * o0.w)) + ((o1.x * o1.x + o1.y * o1.y) + (o1.z * o1.z + o1.w * o1.w)); }
                s += __shfl_xor(s, 16); s += __shfl_xor(s, 32); sq[ai][m] = s; } }
        if (fq == 0) {
#pragma unroll
            for (int ai = 0; ai < 2; ++ai)
#pragma unroll
                for (int m = 0; m < 4; ++m) ssq[(size_t)(pm * 256 + ai * 128 + wr * 64 + m * 16 + fr) * 32 + pn * 4 + wc] = sq[ai][m]; }
    } };
__device__ __forceinline__ int moe_expert_of(const LAS int* toff, int ti, int lane) {
    asm volatile("" : "+v"(lane));
    const int v = toff[lane + 1]; const unsigned long long bal = __ballot(v <= ti); return (int)__popcll(bal); }
struct SchedMoe1 { const char* A; const char* W1; const unsigned* tok; const LAS int* toff; int G, c, lane;
    __device__ __forceinline__ bool next(int i, GUnit& u) const { const int L = i * G + c, ti = L / 4, pn = L % 4; if (ti >= __builtin_amdgcn_readfirstlane(toff[65])) return false;
        const int e = __builtin_amdgcn_readfirstlane(moe_expert_of(toff, ti, lane)), tl = ti - __builtin_amdgcn_readfirstlane(toff[e]);
        u.A = A; u.B = W1 + ((size_t)e * 1024 + pn * 256) * D; u.gtab = tok + (size_t)e * ECAP + tl * 256; u.e0 = nullptr; u.e1 = nullptr; u.i0 = ti; u.i1 = pn; u.i2 = e; u.i3 = tl; return true; } };
struct EpiMoe1 { static constexpr bool ETAB = false; static constexpr bool P16 = false; static constexpr bool PERM = true; unsigned char* HID;
    __device__ __forceinline__ void operator()(const f32x4 (&acc)[2][2][4][2], const GUnit& u, int wr, int wc, int fr, int fq, const LAS unsigned* et) const {
        const int row0 = u.i0 * 256 + wr * 64 + fr, col0 = u.i1 * 128 + wc * 32 + 8 * fq;
#pragma unroll
        for (int ai = 0; ai < 2; ++ai)
#pragma unroll
            for (int m = 0; m < 4; ++m) { float h[8];
#pragma unroll
                for (int n = 0; n < 2; ++n)
#pragma unroll
                    for (int j = 0; j < 4; ++j) { const float g = acc[ai][0][m][n][j], up = acc[ai][1][m][n][j]; h[n * 4 + j] = g * fast_sigmoid(g) * up * HID_SCALE; }
                v2u w; w.x = pk4_fp8(h[0], h[1], h[2], h[3]); w.y = pk4_fp8(h[4], h[5], h[6], h[7]);
                *(GAS v2u*)(HID + (size_t)(row0 + ai * 128 + m * 16) * FF + col0) = w; }
    } };
struct SchedMoe2 { const char* A; const char* W2; const unsigned* dst; const float* gw; const LAS int* toff; int G, c, lane;
    __device__ __forceinline__ bool next(int i, GUnit& u) const { const int TT = __builtin_amdgcn_readfirstlane(toff[64]); const int R = (TT * 8 + G - 1) / G; if (i >= R) return false;
        const int rr = (i < R - 1) ? (R - 2 - i) : (R - 1); const int L = rr * G + c, ti = L / 8, pn = L % 8; if (ti >= TT) return false;
        const int e = __builtin_amdgcn_readfirstlane(moe_expert_of(toff, ti, lane)), tl = ti - __builtin_amdgcn_readfirstlane(toff[e]);
        u.A = A + (size_t)ti * 256 * FF; u.B = W2 + ((size_t)e * D + pn * 256) * FF; u.gtab = nullptr; u.e0 = dst + (size_t)e * ECAP + tl * 256; u.e1 = (const unsigned*)(gw + (size_t)e * ECAP + tl * 256); u.i0 = ti; u.i1 = pn; u.i2 = e; u.i3 = tl; return true; } };
struct EpiMoe2 { static constexpr bool ETAB = true; static constexpr bool P16 = true; static constexpr bool PERM = true; unsigned char* Y;
    __device__ __forceinline__ void operator()(const f32x4 (&acc)[2][2][4][2], const GUnit& u, int wr, int wc, int fr, int fq, const LAS unsigned* et) const {
        const int pn = u.i1; int r0 = wr * 64 + fr; asm volatile("" : "+v"(r0)); const int col0 = pn * 256 + wc * 64 + 16 * fq;
#pragma unroll
        for (int ai = 0; ai < 2; ++ai)
#pragma unroll
            for (int m = 0; m < 4; ++m) { const int r = r0 + ai * 128 + m * 16; const unsigned dv = et[r]; const float g = __uint_as_float(et[256 + r]) * Y_SCALE; const unsigned d1 = dv - 1u;
                const unsigned off = (dv ? (((d1 >> 4) * 8u + (unsigned)pn) * 8u + (d1 & 15u)) * 256u : (unsigned)M * 16384u + (unsigned)pn * 256u) + (unsigned)(wc * 64 + 16 * fq); v4u w;
                { const f32x4 v0 = acc[ai][0][m][0] * g, v1 = acc[ai][0][m][1] * g; w.x = pk4_fp8(v0[0], v0[1], v0[2], v0[3]); w.y = pk4_fp8(v1[0], v1[1], v1[2], v1[3]); }
                { const f32x4 v0 = acc[ai][1][m][0] * g, v1 = acc[ai][1][m][1] * g; w.z = pk4_fp8(v0[0], v0[1], v0[2], v0[3]); w.w = pk4_fp8(v1[0], v1[1], v1[2], v1[3]); }
                *(GAS v4u*)(Y + off) = w; }
    } };

__device__ __forceinline__ v4u qk_fix8(const v4u raw, const f32x4 g0, const f32x4 g1, const f32x4 c0, const f32x4 c1, const f32x4 s0, const f32x4 s1, int half, float scale) {
    f32x4 x0 = {bflo(raw.x), bfhi(raw.x), bflo(raw.y), bfhi(raw.y)}, x1 = {bflo(raw.z), bfhi(raw.z), bflo(raw.w), bfhi(raw.w)};
    float ss = ((x0.x * x0.x + x0.y * x0.y) + (x0.z * x0.z + x0.w * x0.w)) + ((x1.x * x1.x + x1.y * x1.y) + (x1.z * x1.z + x1.w * x1.w));
#pragma unroll
    for (int o = 1; o < 16; o <<= 1) ss += __shfl_xor(ss, o);
    const float r = 1.0f / sqrtf(ss * (1.0f / HD) + EPS);
    const f32x4 y0 = x0 * r * g0, y1 = x1 * r * g1;
    f32x4 p0, p1;
    p0.x = __shfl_xor(y0.x, 4); p0.y = __shfl_xor(y0.y, 4); p0.z = __shfl_xor(y0.z, 4); p0.w = __shfl_xor(y0.w, 4);
    p1.x = __shfl_xor(y1.x, 4); p1.y = __shfl_xor(y1.y, 4); p1.z = __shfl_xor(y1.z, 4); p1.w = __shfl_xor(y1.w, 4);
    const f32x4 o0 = (half ? (y0 * c0 + p0 * s0) : (y0 * c0 - p0 * s0)) * scale, o1 = (half ? (y1 * c1 + p1 * s1) : (y1 * c1 - p1 * s1)) * scale;
    v4u w; w.x = cvt_pk_bf16(o0.x, o0.y); w.y = cvt_pk_bf16(o0.z, o0.w); w.z = cvt_pk_bf16(o1.x, o1.y); w.w = cvt_pk_bf16(o1.z, o1.w); return w;
}
__device__ __forceinline__ void p3_qk_finalize(Frame& F) {
    const int gw = F.vcu * NWAVES + F.wave, NGW = F.G * NWAVES;
    const int c = F.lane & 15, hq = F.lane >> 4, axis = c >> 3, half = (c >> 2) & 1, f0 = 8 * (c & 3);
    const float* ropec = (const float*)(F.ws + WS_ROPE); const float* ropes = ropec + 4096;
    const f32x4 gq0 = *(const GAS f32x4*)(F.in[I_GQ] + 8 * c), gq1 = *(const GAS f32x4*)(F.in[I_GQ] + 8 * c + 4), gk0 = *(const GAS f32x4*)(F.in[I_GK] + 8 * c), gk1 = *(const GAS f32x4*)(F.in[I_GK] + 8 * c + 4);
    bf16* Q = (bf16*)(F.ws + WS_ACTB); bf16* Kb = (bf16*)(F.ws + WS_KB);
    for (int row = gw; row < MT; row += NGW) {
        const bool lat = row < M; const int s = row & (S - 1); const int pos = axis ? (s & 63) : (s >> 6);
        f32x4 c0 = {1.f, 1.f, 1.f, 1.f}, c1 = c0, s0 = {0.f, 0.f, 0.f, 0.f}, s1 = s0;
        bf16* kp = Kb + (size_t)row * 512 + hq * HD + 8 * c;
        const v4u kr = *(const GAS v4u*)kp;
        if (lat) {
            c0 = *(const GAS f32x4*)(ropec + pos * 32 + f0); c1 = *(const GAS f32x4*)(ropec + pos * 32 + f0 + 4); s0 = *(const GAS f32x4*)(ropes + pos * 32 + f0); s1 = *(const GAS f32x4*)(ropes + pos * 32 + f0 + 4);
            bf16* qp = Q + (size_t)row * D + hq * HD + 8 * c;
            v4u qr[4];
#pragma unroll
            for (int it = 0; it < 4; ++it) qr[it] = *(const GAS v4u*)(qp + it * 512);
#pragma unroll
            for (int it = 0; it < 4; ++it) qr[it] = qk_fix8(qr[it], gq0, gq1, c0, c1, s0, s1, half, QSCALE);
#pragma unroll
            for (int it = 0; it < 4; ++it) *(GAS v4u*)(qp + it * 512) = qr[it];
        }
        *(GAS v4u*)kp = qk_fix8(kr, gk0, gk1, c0, c1, s0, s1, half, 1.0f);
    }
}

#define ATT_PROBE_FAKE -1
#define ATT_THR 8.0f
#define ATT_PROBE_FAKE2 -1
#define ATT_PROBE_SPLIT ((wid & 1) == 0)
#define ATT_PROBE_QK 0
#define ATT_PROBE_PV 0
__device__ __forceinline__ void p4_attention(Frame& F) {
    const bf16* Q = (const bf16*)(F.ws + WS_ACTB); const bf16* Kb = (const bf16*)(F.ws + WS_KB); const bf16* Vt = (const bf16*)(F.ws + WS_VT); unsigned char* O = F.ws + WS_ACTC;
    LAS unsigned char* lds = F.lds;
    const int wid = F.wave;
    for (int u = F.vcu; u < 1024; u += F.G) {
        int tq = F.tid; asm volatile("" : "+v"(tq));
        const int r32 = tq & 31, hi = (tq >> 5) & 1;
        const unsigned voffK = (unsigned)(((tq >> 4) * 512 + (((tq & 15) ^ ((tq >> 4) & 15)) * 8)) * 2), voffV = (unsigned)(((tq >> 3) * MT + (((tq & 7) ^ ((tq >> 4) & 7)) * 8)) * 2);
        const int b = u >> 9, rem = u & 511, n = rem >> 3, kvh = (rem >> 1) & 3, hp = rem & 1;
        const int head = kvh * 4 + hp * 2 + ((wid & 3) >> 1);
        const int qloc0 = n * 128 + ((wid & 1) + 2 * (wid >> 2)) * 32;
        const size_t qrow = (size_t)b * S + qloc0 + r32;
        bf16x8 qf[8];
#pragma unroll
        for (int ds = 0; ds < 8; ++ds) qf[ds] = *(const GAS bf16x8*)(Q + qrow * D + head * HD + 16 * ds + 8 * hi);
        const int kstart = (n == 0) ? 0 : n * 128 - 128, kend = (n == 63) ? S : n * 128 + 256, nloc = (kend - kstart) >> 6, NT = nloc + 4;
        float mrun = F.in[I_SINK][head] * 1.4426950408889634f, lrun = (hi == 0) ? 1.0f : 0.0f;
        f32x16 o[4];
#pragma unroll
        for (int db = 0; db < 4; ++db)
#pragma unroll
            for (int r = 0; r < 16; ++r) o[db][r] = 0.f;
#define ATT_DMA(t) do { const int _t = (t); const int _kr0 = (_t < nloc) ? (b * S + kstart + 64 * _t) : (M + b * CTX + 64 * (_t - nloc)); const int _sl = (_t & 3) * 32768; \
            _Pragma("unroll") for (int _i = 0; _i < 2; ++_i) { \
                { const char* _gb = (const char*)(Kb + (size_t)(_kr0 + 32 * _i) * 512 + kvh * HD); asm volatile("" : "+s"(_gb)); __builtin_amdgcn_global_load_lds((const unsigned*)(_gb + voffK), (LAS unsigned*)(lds + _sl + (_i * 512 + wid * 64) * 16), 16, 0, 0); } \
                { const char* _gb = (const char*)(Vt + (size_t)(kvh * HD + 64 * _i) * MT + _kr0); asm volatile("" : "+s"(_gb)); __builtin_amdgcn_global_load_lds((const unsigned*)(_gb + voffV), (LAS unsigned*)(lds + _sl + 16384 + (_i * 512 + wid * 64) * 16), 16, 0, 0); } } } while (0)
#define ATT_NEED(t) (((t) >= nloc) || ((kstart + 64 * (t) + 63 >= qloc0 - 128) && (kstart + 64 * (t) <= qloc0 + 31 + 128)))
#define ATT_KREAD(t) do { int _kbt = lbK + ((t) & 3) * 32768; asm volatile("" : "+v"(_kbt)); \
            _Pragma("unroll") for (int kb = 0; kb < 2; ++kb) _Pragma("unroll") for (int ds = 0; ds < 8; ++ds) kf[kb * 8 + ds] = *(const LAS bf16x8*)(lds + ((_kbt ^ (ds << 5)) + kb * 8192)); } while (0)
        const int lbK = r32 * 256 + (((r32 & 15) ^ hi) << 4);
        const int lbV = r32 * 128 + ((((r32 >> 1) & 7) ^ hi) << 4);
        auto pass = [&](auto FLc) __attribute__((always_inline)) {
        constexpr int FL = decltype(FLc)::value;
        constexpr bool real_ = (FL & 128) != 0;
        asm volatile("s_waitcnt vmcnt(0)" ::: "memory"); __builtin_amdgcn_s_barrier();
        if (real_) { ATT_DMA(0); ATT_DMA(1); ATT_DMA(2); }
        asm volatile("s_waitcnt vmcnt(8)" ::: "memory"); __builtin_amdgcn_s_barrier(); asm volatile("" ::: "memory");
        bf16x8 kf[16];
        if constexpr (FL & 16) { ATT_KREAD(0); } else { _Pragma("unroll") for (int i = 0; i < 16; ++i) asm volatile("" : "=v"(kf[i])); }
#pragma unroll 1
        for (int t = 0; t < NT; ++t) {
            if (t + 2 < NT) asm volatile("s_waitcnt vmcnt(4)" ::: "memory"); else asm volatile("s_waitcnt vmcnt(0)" ::: "memory");
            if constexpr (FL & 64) __builtin_amdgcn_s_barrier();
            asm volatile("" ::: "memory");
            if (real_ && t + 3 < NT) ATT_DMA(t + 3);
            if (ATT_NEED(t)) {
            f32x16 p[2];
            if constexpr (FL & 1) {
#pragma unroll
                for (int kb = 0; kb < 2; ++kb) {
#pragma unroll
                    for (int r = 0; r < 16; ++r) p[kb][r] = 0.f;
                }
#pragma unroll
                for (int ds = 0; ds < 8; ++ds)
#pragma unroll
                    for (int kb = 0; kb < 2; ++kb) p[kb] = __builtin_amdgcn_mfma_f32_32x32x16_bf16(kf[kb * 8 + ds], qf[ds], p[kb], 0, 0, 0);
            } else {
#pragma unroll
                for (int i = 0; i < 16; ++i) asm volatile("" :: "v"(kf[i]));
#pragma unroll
                for (int kb = 0; kb < 2; ++kb) asm volatile("" : "=v"(p[kb]));
            }
            __builtin_amdgcn_sched_barrier(0);
            bf16x8 vf[4][4];
            if constexpr (FL & 2) {   int vbt = lbV + (t & 3) * 32768 + 16384; asm volatile("" : "+v"(vbt));
#pragma unroll
                for (int db = 0; db < 4; ++db)
#pragma unroll
                    for (int g = 0; g < 4; ++g) vf[db][g] = *(const LAS bf16x8*)(lds + ((vbt ^ (g << 5)) + db * 4096));
            } else {
#pragma unroll
                for (int db = 0; db < 4; ++db)
#pragma unroll
                    for (int g = 0; g < 4; ++g) asm volatile("" : "=v"(vf[db][g]));
            }
            __builtin_amdgcn_sched_barrier(0);
            if constexpr (FL & 32) {
                const int kloc0 = kstart + 64 * t;
                if (t < nloc && !((kloc0 >= qloc0 + 31 - 128) && (kloc0 + 63 <= qloc0 + 128))) {
                    const int q = qloc0 + r32;
#pragma unroll
                    for (int kb = 0; kb < 2; ++kb)
#pragma unroll
                        for (int r = 0; r < 16; ++r) { const int key = kloc0 + 32 * kb + (r & 3) + 8 * (r >> 2) + 4 * hi; const int dlt = key - q; if (dlt > 128 || dlt < -128) p[kb][r] = -INFINITY; }
                }
            }
            bf16x8 pb[2][2];
            if constexpr (FL & 4) {
                float mq[4];
#pragma unroll
                for (int i = 0; i < 4; ++i) { const int kb = i >> 1, r0 = 8 * (i & 1);
                    float m = fmaxf(fmaxf(p[kb][r0], p[kb][r0 + 1]), p[kb][r0 + 2]); m = fmaxf(fmaxf(m, p[kb][r0 + 3]), p[kb][r0 + 4]); m = fmaxf(fmaxf(m, p[kb][r0 + 5]), p[kb][r0 + 6]); mq[i] = fmaxf(m, p[kb][r0 + 7]); }
                float mx = fmaxf(fmaxf(fmaxf(mq[0], mq[1]), mq[2]), mq[3]);
                float mb = mx; asm volatile("s_nop 1\n\tv_permlane32_swap_b32 %0, %1" : "+v"(mx), "+v"(mb));
                mx = fmaxf(mx, mb);
                const bool grow = mx > mrun + ATT_THR;
                if (__builtin_amdgcn_ballot_w64(grow) != 0ull) {
                    const float mnew = grow ? mx : mrun, alpha = __builtin_amdgcn_exp2f(mrun - mnew);
                    mrun = mnew; lrun *= alpha;
#pragma unroll
                    for (int db = 0; db < 4; ++db)
#pragma unroll
                        for (int r = 0; r < 16; r += 2) { f32x2 d = {o[db][r], o[db][r + 1]}; d *= f32x2{alpha, alpha}; o[db][r] = d[0]; o[db][r + 1] = d[1]; }
                }
                const f32x2 mn2 = {mrun, mrun};
                f32x2 ls2[4] = {{0.f, 0.f}, {0.f, 0.f}, {0.f, 0.f}, {0.f, 0.f}};
#pragma unroll
                for (int kb = 0; kb < 2; ++kb)
#pragma unroll
                    for (int r = 0; r < 16; r += 2) { f32x2 d = {p[kb][r], p[kb][r + 1]}; d -= mn2; d[0] = __builtin_amdgcn_exp2f(d[0]); d[1] = __builtin_amdgcn_exp2f(d[1]);
                        p[kb][r] = d[0]; p[kb][r + 1] = d[1]; ls2[(r >> 1) & 3] += d; }
                const f32x2 lsum = (ls2[0] + ls2[1]) + (ls2[2] + ls2[3]);
                const float ls = lsum[0] + lsum[1];
                lrun += ls;
#pragma unroll
                for (int kb = 0; kb < 2; ++kb)
#pragma unroll
                    for (int s2 = 0; s2 < 2; ++s2) { v4u w; w.x = cvt_pk_bf16_n(p[kb][8 * s2 + 0], p[kb][8 * s2 + 1]); w.y = cvt_pk_bf16_n(p[kb][8 * s2 + 2], p[kb][8 * s2 + 3]);
                        w.z = cvt_pk_bf16_n(p[kb][8 * s2 + 4], p[kb][8 * s2 + 5]); w.w = cvt_pk_bf16_n(p[kb][8 * s2 + 6], p[kb][8 * s2 + 7]); pb[kb][s2] = __builtin_bit_cast(bf16x8, w); }
            } else {
#pragma unroll
                for (int kb = 0; kb < 2; ++kb) asm volatile("" :: "v"(p[kb]));
#pragma unroll
                for (int kb = 0; kb < 2; ++kb)
#pragma unroll
                    for (int s2 = 0; s2 < 2; ++s2) asm volatile("" : "=v"(pb[kb][s2]));
            }
            if constexpr (FL & 8) {
#pragma unroll
                for (int kb = 0; kb < 2; ++kb)
#pragma unroll
                    for (int s2 = 0; s2 < 2; ++s2)
#pragma unroll
                        for (int db = 0; db < 4; ++db) o[db] = __builtin_amdgcn_mfma_f32_32x32x16_bf16(vf[db][2 * kb + s2], pb[kb][s2], o[db], 0, 0, 0);
            } else {
#pragma unroll
                for (int db = 0; db < 4; ++db)
#pragma unroll
                    for (int g = 0; g < 4; ++g) asm volatile("" :: "v"(vf[db][g]));
#pragma unroll
                for (int kb = 0; kb < 2; ++kb)
#pragma unroll
                    for (int s2 = 0; s2 < 2; ++s2) asm volatile("" :: "v"(pb[kb][s2]));
            }
            }
            __builtin_amdgcn_sched_barrier(0);
            if constexpr (FL & 16) { ATT_KREAD(t + 1); }
            else { _Pragma("unroll") for (int i = 0; i < 16; ++i) asm volatile("" : "=v"(kf[i])); }
        }
        };
#if ATT_PROBE_FAKE >= 0
        if (ATT_PROBE_SPLIT) pass(std::integral_constant<int, ATT_PROBE_FAKE>{}); else pass(std::integral_constant<int, ATT_PROBE_FAKE2>{});
#pragma unroll
        for (int db = 0; db < 4; ++db)
#pragma unroll
            for (int r = 0; r < 16; ++r) { asm volatile("" :: "v"(o[db][r])); o[db][r] = 0.f; }
        asm volatile("" :: "v"(lrun)); mrun = F.in[I_SINK][head] * 1.4426950408889634f; lrun = (hi == 0) ? 1.0f : 0.0f;
#endif
        pass(std::integral_constant<int, 255>{});
#undef ATT_KREAD
#undef ATT_DMA
#undef ATT_NEED
        float lb_ = lrun; asm volatile("s_nop 1\n\tv_permlane32_swap_b32 %0, %1" : "+v"(lrun), "+v"(lb_));
        const float ltot = lrun + lb_, inv = O_SCALE / ltot;
        int tq2 = F.tid; asm volatile("" : "+v"(tq2));
        unsigned char* orow = O + ((size_t)b * S + qloc0 + (tq2 & 31)) * D + head * HD + 16 * ((tq2 >> 5) & 1);
#pragma unroll
        for (int db = 0; db < 4; ++db) { unsigned wq[4];
#pragma unroll
            for (int g = 0; g < 4; ++g) wq[g] = pk4_fp8(o[db][4 * g] * inv, o[db][4 * g + 1] * inv, o[db][4 * g + 2] * inv, o[db][4 * g + 3] * inv);
            asm volatile("s_nop 1\n\tv_permlane32_swap_b32 %0, %1" : "+v"(wq[0]), "+v"(wq[2]));
            asm volatile("s_nop 1\n\tv_permlane32_swap_b32 %0, %1" : "+v"(wq[1]), "+v"(wq[3]));
            *(GAS v4u*)(orow + 32 * db) = (v4u){wq[0], wq[2], wq[1], wq[3]}; }
    }
}

typedef int v4i_k __attribute__((ext_vector_type(4)));
__device__ __forceinline__ float rdlane(float v, int l) { return __uint_as_float(__builtin_amdgcn_readlane(__float_as_uint(v), l)); }
#define ROUTE_PROBE_REP 1
__device__ __forceinline__ void moe_route(Frame& F, const int l) {
    const bf16* X1 = (const bf16*)(F.ws + WS_X1); const float* SSQ = (const float*)(F.ws + WS_SSQ); unsigned char* H2 = F.ws + WS_ACTA;
    const bf16* WRh = (const bf16*)(F.ws + WS_WR) + (size_t)l * 2 * NE * D; const bf16* WRl = WRh + NE * D;
    unsigned* tokl = (unsigned*)(F.ws + WS_TOK + l * LIST_L); unsigned* dstl = (unsigned*)(F.ws + WS_DST + l * LIST_L); float* gwl = (float*)(F.ws + WS_GW + l * LIST_L);
    unsigned* cntg = (unsigned*)(F.ws + WS_CTL) + CW_CNT + l * 64 * 64;
    LAS unsigned char* lds = F.lds;
    constexpr int AH = 0, AL = 32768, LOG = 65536, PEND = 98304, LCNT = 102400, LBASE = 102656;
    const int tid = F.tid, lane = F.lane, w = F.wave;
    for (int tb = F.vcu; tb < M / 64; tb += F.G) {
        const int row0 = tb * 64, b = row0 / S;
        if (tid < 64) ((LAS unsigned*)(lds + LCNT))[tid] = 0u;
        float rstd[8];
#pragma unroll
        for (int j = 0; j < 8; ++j) { const int row = row0 + 8 * w + j; const float v = (lane < 32) ? SSQ[(size_t)row * 32 + lane] : 0.f; rstd[j] = 1.0f / sqrtf(wave_sum(v) * (1.0f / D) + EPS); }
        const float* g2 = F.in[I_G2] + l * D; const float* sh2 = modp(F, l, b, 3); const float* sc2 = modp(F, l, b, 4);
        const int nt = w & 3, kh = w >> 2, r16 = lane & 15, kq = lane >> 4;
        f32x4 acc[4];
#pragma unroll 1
        for (int rep_ = 0; rep_ < ROUTE_PROBE_REP; ++rep_) {
        if (rep_) { _Pragma("unroll") for (int mt = 0; mt < 4; ++mt) asm volatile("" :: "v"(acc[mt])); }
#pragma unroll
        for (int mt = 0; mt < 4; ++mt) acc[mt] = (f32x4){0.f, 0.f, 0.f, 0.f};
        v2u xc[8], xn[8];
#pragma unroll
        for (int j = 0; j < 8; ++j) { xc[j] = *(const GAS v2u*)(X1 + (size_t)(row0 + 8 * w + j) * D + 4 * lane); xn[j] = *(const GAS v2u*)(X1 + (size_t)(row0 + 8 * w + j) * D + 4 * lane + 256); }
        const unsigned lo16 = (unsigned)lane * 16u;
#define ROUTE_MODLD(kcn) do { const char* _a = (const char*)g2 + (kcn) * 1024; const char* _b = (const char*)sc2 + (kcn) * 1024; const char* _c = (const char*)sh2 + (kcn) * 1024; asm volatile("" : "+s"(_a), "+s"(_b), "+s"(_c)); \
            g2n = *(const GAS f32x4*)(_a + lo16); sc2n = *(const GAS f32x4*)(_b + lo16); sh2n = *(const GAS f32x4*)(_c + lo16); } while (0)
        f32x4 g2n, sc2n, sh2n; ROUTE_MODLD(0);
#pragma unroll 1
        for (int kc = 0; kc < 8; ++kc) {
            const int k0 = kc * 256 + 4 * lane;
            const f32x4 av = g2n * (sc2n + 1.0f), bv = sh2n;
            if (kc < 7) ROUTE_MODLD(kc + 1);
            v2u xnn[8];
            if (kc < 6) {
#pragma unroll
                for (int j = 0; j < 8; ++j) xnn[j] = *(const GAS v2u*)(X1 + (size_t)(row0 + 8 * w + j) * D + k0 + 512);
            }
            bf16x8 wbh[4], wbl[4];
#pragma unroll
            for (int ks4 = 0; ks4 < 4; ++ks4) { const size_t wo = (size_t)(16 * nt + r16) * D + kc * 256 + 32 * (kh * 4 + ks4) + 8 * kq; wbh[ks4] = *(const GAS bf16x8*)(WRh + wo); wbl[ks4] = *(const GAS bf16x8*)(WRl + wo); }
#pragma unroll
            for (int j = 0; j < 8; ++j) { const int rl = 8 * w + j, row = row0 + rl;
                const f32x4 xf = {bflo(xc[j].x), bfhi(xc[j].x), bflo(xc[j].y), bfhi(xc[j].y)}; const f32x4 h = xf * rstd[j] * av + bv;
                v2u hh; hh.x = cvt_pk_bf16(h.x, h.y); hh.y = cvt_pk_bf16(h.z, h.w);
                *(GAS unsigned*)(H2 + (size_t)row * D + k0) = pk4_fp8(h.x * H2_SCALE, h.y * H2_SCALE, h.z * H2_SCALE, h.w * H2_SCALE);
                const f32x4 lo = {h.x - bflo(hh.x), h.y - bfhi(hh.x), h.z - bflo(hh.y), h.w - bfhi(hh.y)};
                v2u ll; ll.x = cvt_pk_bf16(lo.x, lo.y); ll.y = cvt_pk_bf16(lo.z, lo.w);
                const int off = rl * 512 + ((((lane >> 1) ^ (rl & 15))) << 4) + 8 * (lane & 1);
                *(LAS v2u*)(lds + AH + off) = hh; *(LAS v2u*)(lds + AL + off) = ll; }
#pragma unroll
            for (int j = 0; j < 8; ++j) { xc[j] = xn[j]; if (kc < 6) xn[j] = xnn[j]; }
            asm volatile("s_waitcnt lgkmcnt(0)" ::: "memory"); __builtin_amdgcn_s_barrier(); asm volatile("" ::: "memory");
#pragma unroll
            for (int ks4 = 0; ks4 < 4; ++ks4) { const int ks = kh * 4 + ks4;
                const bf16x8 bh = wbh[ks4], bl = wbl[ks4];
#pragma unroll
                for (int mt = 0; mt < 4; ++mt) { const int row = 16 * mt + r16; const int off = row * 512 + (((4 * ks + kq) ^ (row & 15)) << 4);
                    const bf16x8 ah = *(const LAS bf16x8*)(lds + AH + off), al = *(const LAS bf16x8*)(lds + AL + off);
                    acc[mt] = __builtin_amdgcn_mfma_f32_16x16x32_bf16(ah, bh, acc[mt], 0, 0, 0);
                    acc[mt] = __builtin_amdgcn_mfma_f32_16x16x32_bf16(ah, bl, acc[mt], 0, 0, 0);
                    acc[mt] = __builtin_amdgcn_mfma_f32_16x16x32_bf16(al, bh, acc[mt], 0, 0, 0); } }
            asm volatile("s_waitcnt lgkmcnt(0)" ::: "memory"); __builtin_amdgcn_s_barrier(); asm volatile("" ::: "memory");
        }
        }
        int tid_o = F.tid; asm volatile("" : "+v"(tid_o));
        { const int tid = tid_o, lane = tid_o & 63, r16 = lane & 15, kq = lane >> 4;
        LAS float* logp = (LAS float*)(lds + LOG);
#pragma unroll
        for (int mt = 0; mt < 4; ++mt)
#pragma unroll
            for (int r = 0; r < 4; ++r) logp[kh * 4096 + (16 * mt + 4 * kq + r) * 64 + 16 * nt + r16] = acc[mt][r];
        __syncthreads();
        const float br = F.in[I_BR][l * NE + lane];
        LAS int* kkey = (LAS int*)(lds + 110592) + w * 128; LAS float* ksc = (LAS float*)(kkey + 64);
        for (int j2 = 0; j2 < 8; j2 += 2) {
#pragma unroll
            for (int r = 0; r < 2; ++r) { const int rl = 8 * w + j2 + r;
                const float logit = logp[rl * 64 + lane] + logp[4096 + rl * 64 + lane];
                const float s = 1.0f / (1.0f + __expf(-logit)), sb = s + br;
                const float m1 = grp8_max(sb);
                const unsigned long long eq = __ballot(sb == m1); const int g = lane >> 3; const unsigned gm = (unsigned)(eq >> (8 * g)) & 0xffu; const int first = __ffs(gm) - 1;
                const float m2 = grp8_max(((lane & 7) == first) ? -INFINITY : sb);
                const float gs = m1 + m2;
                int grank = 0;
#pragma unroll
                for (int g2i = 0; g2i < 8; ++g2i) { const float v = rdlane(gs, 8 * g2i); grank += (v > gs || (v == gs && g2i < g)) ? 1 : 0; }
                int kb = __float_as_int(sb); kb ^= (kb >> 31) & 0x7fffffff;
                if (grank < 4) { const int c = r * 32 + grank * 8 + (lane & 7); kkey[c] = (kb & ~63) | (63 - lane); ksc[c] = s; }
            }
            asm volatile("s_waitcnt lgkmcnt(0)" ::: "memory");
            const int hr = lane >> 5; const int key = kkey[lane]; const float ms = ksc[lane];
            int rank = 0;
#pragma unroll
            for (int q4 = 0; q4 < 8; ++q4) { const v4i_k kk = *(const LAS v4i_k*)(kkey + hr * 32 + 4 * q4); rank += (kk.x > key ? 1 : 0) + (kk.y > key ? 1 : 0) + (kk.z > key ? 1 : 0) + (kk.w > key ? 1 : 0); }
            asm volatile("s_waitcnt lgkmcnt(0)" ::: "memory");
            const bool sel = rank < TOPK;
            float ts = sel ? ms : 0.f; ts += DPPF(ts, 0xB1); ts += DPPF(ts, 0x4E); ts += DPPF(ts, 0x141); ts += DPPF(ts, 0x140);
            const float tot = hr ? (rdlane(ts, 32) + rdlane(ts, 48)) : (rdlane(ts, 0) + rdlane(ts, 16)), gate = ms / tot * 2.5f;
            if (sel) { const int e = 63 - (key & 63), rl = 8 * w + j2 + hr;
                const unsigned lpos = __hip_atomic_fetch_add((LAS unsigned*)(lds + LCNT) + e, 1u, __ATOMIC_RELAXED, __HIP_MEMORY_SCOPE_WORKGROUP);
                *(LAS v2u*)(lds + PEND + (rl * 8 + rank) * 8) = (v2u){(unsigned)e | (lpos << 8), __float_as_uint(gate)}; }
        }
        __syncthreads();
        if (tid < 64) { const unsigned c = ((LAS unsigned*)(lds + LCNT))[tid]; ((LAS unsigned*)(lds + LBASE))[tid] = c ? __hip_atomic_fetch_add(cntg + tid * 64, c, RLX_AGENT) : 0u; }
        __syncthreads();
        { const int rl = tid >> 3, rank = tid & 7; const v2u pe = *(const LAS v2u*)(lds + PEND + (rl * 8 + rank) * 8); const unsigned e = pe.x & 0xffu, lpos = pe.x >> 8;
            const unsigned pos = ((LAS unsigned*)(lds + LBASE))[e] + lpos; const unsigned token = (unsigned)(row0 + rl); const size_t o = (size_t)e * ECAP + pos;
            tokl[o] = token; dstl[o] = token * 16u + (unsigned)rank + 1u; gwl[o] = __uint_as_float(pe.y); }
        __syncthreads();
        }
    }
}
__device__ __forceinline__ void moe_build_toff(Frame& F, const int l) {
    LAS int* toff = (LAS int*)(F.lds + TOFF_OFF);
    if (F.wave == 0) { const unsigned* cntg = (const unsigned*)(F.ws + WS_CTL) + CW_CNT + l * 64 * 64;
        const int c = (int)__hip_atomic_load(cntg + F.lane * 64, RLX_AGENT); const int ntl = (c + 255) >> 8; int inc = ntl;
#pragma unroll
        for (int o = 1; o < 64; o <<= 1) { const int v = __shfl_up(inc, o); if (F.lane >= o) inc += v; }
        toff[F.lane] = inc - ntl; if (F.lane == 63) { toff[64] = inc; toff[65] = inc + 64; } }
    __syncthreads();
}
__device__ __forceinline__ void moe_gemm1(Frame& F, const int l, const int G, const int c) {
    moe_build_toff(F, l);
    SchedMoe1 Sd{(const char*)(F.ws + WS_ACTA), (const char*)(F.ws + WS_W1) + (size_t)l * NE1 * 1024 * D, (const unsigned*)(F.ws + WS_TOK + l * LIST_L), (const LAS int*)(F.lds + TOFF_OFF), G, c, F.lane};
    EpiMoe1 E{F.ws + WS_HID};
    pg8::gemm_phase<EpiMoe1, SchedMoe1, true, true, SC_W1, SC_H2>(F.lds, (LAS unsigned*)(F.lds + GTL_OFF), D / 2, D / 2, D / 2, Sd, E);
}
__device__ __forceinline__ void moe_gemm2(Frame& F, const int l, const int G, const int c) {
    moe_build_toff(F, l);
    SchedMoe2 Sd{(const char*)(F.ws + WS_HID), (const char*)(F.ws + WS_W2) + (size_t)l * NE1 * D * FF, (const unsigned*)(F.ws + WS_DST + l * LIST_L), (const float*)(F.ws + WS_GW + l * LIST_L), (const LAS int*)(F.lds + TOFF_OFF), G, c, F.lane};
    EpiMoe2 E{F.ws + WS_Y};
    pg8::gemm_phase<EpiMoe2, SchedMoe2, false, true, SC_W2, SC_HID>(F.lds, (LAS unsigned*)(F.lds + GTL_OFF), FF / 2, FF / 2, FF / 2, Sd, E);
}
struct SchedComb { const char* A; const char* W2s; const LAS int* toff; int G, c;
    __device__ __forceinline__ bool next(int i, GUnit& u) const { const int L = i * G + c; if (L >= 512) return false; const int rt = L / 8, pn = L % 8;
        u.A = A + (size_t)(__builtin_amdgcn_readfirstlane(toff[64]) + rt) * 256 * FF; u.B = W2s + (size_t)pn * 256 * FF; u.gtab = nullptr; u.e0 = nullptr; u.e1 = nullptr; u.i0 = rt; u.i1 = pn; u.i2 = 0; u.i3 = 0; return true; } };
template <bool LAST> struct EpiComb { static constexpr bool ETAB = false; static constexpr int NST = 0; static constexpr bool P16 = true; static constexpr bool PERM = true; const bf16* X1; const unsigned char* Y; const float* gate0; const float* gate1; bf16* X2; float* outf; float* ssq;
    __device__ __forceinline__ void operator()(const f32x4 (&acc)[2][2][4][2], const GUnit& u, int wr, int wc, int fr, int fq, const LAS unsigned* et) const {
        const int pm = u.i0, pn = u.i1; const float* gate = (pm < 32) ? gate0 : gate1;
        const int col0 = pn * 256 + wc * 64 + 16 * fq;
        f32x4 gv[2][2];
#pragma unroll
        for (int bj = 0; bj < 2; ++bj)
#pragma unroll
            for (int n = 0; n < 2; ++n) gv[bj][n] = *(const GAS f32x4*)(gate + col0 + bj * 8 + n * 4);
        float sq[2][4];
        v2u pa[2][2][4][2];
#pragma unroll
        for (int ai = 0; ai < 2; ++ai)
#pragma unroll
            for (int bj = 0; bj < 2; ++bj)
#pragma unroll
                for (int m = 0; m < 4; ++m)
#pragma unroll
                    for (int n = 0; n < 2; ++n) { const f32x4 v = acc[ai][bj][m][n]; pa[ai][bj][m][n] = (v2u){cvt_pk_bf16_n(v.x, v.y), cvt_pk_bf16_n(v.z, v.w)}; }
        auto rows = [&](auto R0c, auto Nc) __attribute__((always_inline)) { constexpr int R0 = decltype(R0c)::value, N = decltype(Nc)::value;
            v4u yr[N][8], xr[N][2];
#pragma unroll
            for (int i = 0; i < N; ++i) { const int ai = (R0 + i) >> 2, m = (R0 + i) & 3; const int row = pm * 256 + ai * 128 + wr * 64 + m * 16 + fr; const size_t off = (size_t)row * D + col0;
#pragma unroll
                for (int k = 0; k < 8; ++k) yr[i][k] = *(const GAS v4u*)(Y + (((size_t)row * 8 + pn) * 8 + k) * 256 + (wc * 64 + 16 * fq));
                xr[i][0] = *(const GAS v4u*)(X1 + off); xr[i][1] = *(const GAS v4u*)(X1 + off + 8); }
#pragma unroll
            for (int i = 0; i < N; ++i) { const int ai = (R0 + i) >> 2, m = (R0 + i) & 3; const int row = pm * 256 + ai * 128 + wr * 64 + m * 16 + fr; const size_t off = (size_t)row * D + col0;
                f32x4 ys[2][2] = {{{0.f, 0.f, 0.f, 0.f}, {0.f, 0.f, 0.f, 0.f}}, {{0.f, 0.f, 0.f, 0.f}, {0.f, 0.f, 0.f, 0.f}}};
#pragma unroll
                for (int k = 0; k < 8; ++k) { const unsigned yw[4] = {yr[i][k].x, yr[i][k].y, yr[i][k].z, yr[i][k].w};
#pragma unroll
                    for (int q = 0; q < 4; ++q) { const f32x2 a = __builtin_amdgcn_cvt_pk_f32_fp8((int)yw[q], false), b2 = __builtin_amdgcn_cvt_pk_f32_fp8((int)yw[q], true); ys[q >> 1][q & 1] += (f32x4){a.x, a.y, b2.x, b2.y}; } }
                float sacc = 0.f;
#pragma unroll
                for (int bj = 0; bj < 2; ++bj) { const v4u r = xr[i][bj];
                    const f32x4 b0 = {bflo(r.x), bfhi(r.x), bflo(r.y), bfhi(r.y)}, b1 = {bflo(r.z), bfhi(r.z), bflo(r.w), bfhi(r.w)};
                    const v2u p0 = pa[ai][bj][m][0], p1 = pa[ai][bj][m][1]; const f32x4 a0 = {bflo(p0.x), bfhi(p0.x), bflo(p0.y), bfhi(p0.y)}, a1 = {bflo(p1.x), bfhi(p1.x), bflo(p1.y), bfhi(p1.y)};
                    const f32x4 o0 = b0 + gv[bj][0] * (a0 + ys[bj][0] * (1.0f / Y_SCALE)), o1 = b1 + gv[bj][1] * (a1 + ys[bj][1] * (1.0f / Y_SCALE));
                    if constexpr (LAST) { *(GAS f32x4*)(outf + off + bj * 8) = o0; *(GAS f32x4*)(outf + off + bj * 8 + 4) = o1; }
                    else { v4u w; w.x = cvt_pk_bf16(o0.x, o0.y); w.y = cvt_pk_bf16(o0.z, o0.w); w.z = cvt_pk_bf16(o1.x, o1.y); w.w = cvt_pk_bf16(o1.z, o1.w); *(GAS v4u*)(X2 + off + bj * 8) = w;
                        sacc += ((o0.x * o0.x + o0.y * o0.y) + (o0.z * o0.z + o0.w * o0.w)) + ((o1.x * o1.x + o1.y * o1.y) + (o1.z * o1.z + o1.w * o1.w)); } }
                if constexpr (!LAST) { sacc += __shfl_xor(sacc, 16); sacc += __shfl_xor(sacc, 32); sq[ai][m] = sacc; } }
            };
        rows(std::integral_constant<int, 0>{}, std::integral_constant<int, 3>{}); rows(std::integral_constant<int, 3>{}, std::integral_constant<int, 3>{}); rows(std::integral_constant<int, 6>{}, std::integral_constant<int, 2>{});
        if constexpr (!LAST) { if (fq == 0) {
#pragma unroll
            for (int ai = 0; ai < 2; ++ai)
#pragma unroll
                for (int m = 0; m < 4; ++m) ssq[(size_t)(pm * 256 + ai * 128 + wr * 64 + m * 16 + fr) * 32 + pn * 4 + wc] = sq[ai][m]; } }
    } };
template <bool LAST, class Pre>
__device__ __forceinline__ void moe_combine_gemm(Frame& F, const int l, float* out_f32, const Pre& pre) {
    moe_build_toff(F, l);
    SchedComb Sd{(const char*)(F.ws + WS_HID), (const char*)(F.ws + WS_W2) + ((size_t)l * NE1 + NE) * D * FF, (const LAS int*)(F.lds + TOFF_OFF), F.G, F.vcu};
    EpiComb<LAST> E{(const bf16*)(F.ws + WS_X1), F.ws + WS_Y, modp(F, l, 0, 5), modp(F, l, 1, 5), (bf16*)(F.ws + WS_X2), out_f32, (float*)(F.ws + WS_SSQ)};
    pg8::gemm_phase<EpiComb<LAST>, SchedComb, false, true, SC_W2, SC_HID, Pre>(F.lds, (LAS unsigned*)(F.lds + GTL_OFF), FF / 2, FF / 2, FF / 2, Sd, E, pre);
}
template <bool LAST>
__device__ __forceinline__ void moe_combine(Frame& F, const int l, float* out_f32) {
    const int gw = F.vcu * NWAVES + F.wave, NGW = F.G * NWAVES;
    const bf16* X1 = (const bf16*)(F.ws + WS_X1); const unsigned char* Y = F.ws + WS_Y; bf16* X2 = (bf16*)(F.ws + WS_X2);
    for (int rb = gw; rb < M / 8; rb += NGW) {
        const int row0 = rb * 8, b = row0 / S;
        const float* ga2 = modp(F, l, b, 5);
        for (int j = 0; j < 8; ++j) { const int row = row0 + j; f32x4 v[8];
#pragma unroll
            for (int jj = 0; jj < 8; ++jj) { const int col = 4 * F.lane + 256 * jj; f32x4 ys = {0.f, 0.f, 0.f, 0.f};
#pragma unroll
                for (int k = 0; k < 9; ++k) { const int y = *(const GAS int*)(Y + ((size_t)row * 9 + k) * D + col); const f32x2 a = __builtin_amdgcn_cvt_pk_f32_fp8(y, false), bq = __builtin_amdgcn_cvt_pk_f32_fp8(y, true); ys += (f32x4){a.x, a.y, bq.x, bq.y}; }
                const v2u xr = *(const GAS v2u*)(X1 + (size_t)row * D + col);
                v[jj] = (f32x4){bflo(xr.x), bfhi(xr.x), bflo(xr.y), bfhi(xr.y)} + *(const GAS f32x4*)(ga2 + col) * (ys * (1.0f / Y_SCALE));
                if (LAST) *(GAS f32x4*)(out_f32 + (size_t)row * D + col) = v[jj];
                else { v2u w; w.x = cvt_pk_bf16(v[jj].x, v[jj].y); w.y = cvt_pk_bf16(v[jj].z, v[jj].w); *(GAS v2u*)(X2 + (size_t)row * D + col) = w; } }
            if (!LAST) {
                float ss = 0.f;
#pragma unroll
                for (int jj = 0; jj < 8; ++jj) ss += (v[jj].x * v[jj].x + v[jj].y * v[jj].y) + (v[jj].z * v[jj].z + v[jj].w * v[jj].w);
                const float rstd = 1.0f / sqrtf(wave_sum(ss) * (1.0f / D) + EPS);
                if (F.lane == 0) ((float*)(F.ws + WS_RSTD2))[row] = rstd; } }
    }
}
__device__ __forceinline__ void bf8_unpack(const v4u r, f32x4& a, f32x4& b) { a = (f32x4){bflo(r.x), bfhi(r.x), bflo(r.y), bfhi(r.y)}; b = (f32x4){bflo(r.z), bfhi(r.z), bflo(r.w), bfhi(r.w)}; }
__device__ __forceinline__ void pool_diff(Frame& F) {
    const bf16* X2 = (const bf16*)(F.ws + WS_X2); const float* SSQ = (const float*)(F.ws + WS_SSQ); unsigned char* DP = F.ws + WS_ACTB;
    LAS float* rsl = (LAS float*)F.lds;
    const int cg = F.tid & 255, col = 8 * cg, g = cg >> 6, wdw = 2 << g, back = wdw >> 1, fwd = wdw - back, tsel = F.tid >> 8;
    for (int tb = F.vcu; tb < M / 64; tb += F.G) {
        const int t00 = tb * 64 + tsel * 32, bb = t00 / S, tl0 = t00 - bb * S;
        const bf16* base = X2 + (size_t)bb * S * D + col;
        {   const int tlt = tb * 64 - bb * S;
            __syncthreads();
            if (F.tid < 96) { const int tt = tlt - 16 + F.tid; float r = 0.f;
                if (tt >= 0 && tt < S) { const float* sp = SSQ + ((size_t)bb * S + tt) * 32; f32x4 a4 = {0.f, 0.f, 0.f, 0.f};
#pragma unroll
                    for (int q = 0; q < 8; ++q) a4 += *(const GAS f32x4*)(sp + 4 * q);
                    r = 1.0f / sqrtf(((a4.x + a4.y) + (a4.z + a4.w)) * (1.0f / D) + EPS); }
                rsl[F.tid] = r; }
            __syncthreads(); }
        const LAS float* rsb = rsl - (tb * 64 - bb * S - 16);
        f32x4 ma0, ma1, mb0, mb1;
        { const float* g1 = F.in[I_G1] + D + col; const float* sh = modp(F, 1, bb, 0) + col; const float* sc = modp(F, 1, bb, 1) + col;
          ma0 = *(const GAS f32x4*)(g1) * (*(const GAS f32x4*)(sc) + 1.0f); ma1 = *(const GAS f32x4*)(g1 + 4) * (*(const GAS f32x4*)(sc + 4) + 1.0f); mb0 = *(const GAS f32x4*)(sh); mb1 = *(const GAS f32x4*)(sh + 4); }
#define PD_NORM(r, rs, a, b) do { bf8_unpack((r), (a), (b)); (a) = (a) * (rs) * ma0 + mb0; (b) = (b) * (rs) * ma1 + mb1; } while (0)
        f32x4 sa = {0.f, 0.f, 0.f, 0.f}, sb = sa;
        { int lo = tl0 - 1 - back; lo = lo < 0 ? 0 : lo; int hi = tl0 - 1 + fwd; hi = hi > S ? S : hi;
          for (int tt = lo; tt < hi; ++tt) { f32x4 a, b; PD_NORM(*(const GAS v4u*)(base + (size_t)tt * D), rsb[tt], a, b); sa += a; sb += b; } }
#pragma unroll 1
        for (int j0 = 0; j0 < 32; j0 += 4) {
            v4u rin[4], rout[4], rc[4]; float sin_[4], sout_[4], sc_[4];
#pragma unroll
            for (int j = 0; j < 4; ++j) { const int t = tl0 + j0 + j; const int tin = t + fwd - 1, tout = t - back - 1;
                rin[j] = (tin < S) ? *(const GAS v4u*)(base + (size_t)tin * D) : (v4u){0u, 0u, 0u, 0u}; sin_[j] = (tin < S) ? rsb[tin] : 0.f;
                rout[j] = (tout >= 0) ? *(const GAS v4u*)(base + (size_t)tout * D) : (v4u){0u, 0u, 0u, 0u}; sout_[j] = (tout >= 0) ? rsb[tout] : 0.f;
                rc[j] = *(const GAS v4u*)(base + (size_t)t * D); sc_[j] = rsb[t]; }
#pragma unroll
            for (int j = 0; j < 4; ++j) { const int t = tl0 + j0 + j; const int tin = t + fwd - 1, tout = t - back - 1; f32x4 a, b;
                if (tin < S) { PD_NORM(rin[j], sin_[j], a, b); sa += a; sb += b; }
                if (tout >= 0) { PD_NORM(rout[j], sout_[j], a, b); sa -= a; sb -= b; }
                int lo = t - back; lo = lo < 0 ? 0 : lo; int hi = t + fwd; hi = hi > S ? S : hi; const float inv = 1.0f / (float)(hi - lo);
                PD_NORM(rc[j], sc_[j], a, b); const f32x4 o0 = (sa * inv - a) * DP_SCALE, o1 = (sb * inv - b) * DP_SCALE;
                v2u w; w.x = pk4_fp8(o0.x, o0.y, o0.z, o0.w); w.y = pk4_fp8(o1.x, o1.y, o1.z, o1.w);
                *(GAS v2u*)(DP + ((size_t)bb * S + t) * D + col) = w; }
        }
#undef PD_NORM
    }
}

__device__ __forceinline__ void p0_ctx_units(Frame& F) {
    const int per = F.G / 8; const bool g8 = (F.G % 8) == 0 && per > 0;
    const bool cons = g8 ? ((F.vcu % per) == per - 1) : (F.vcu < 8);
    if (!cons) return;
    const int q = g8 ? F.vcu / per : F.vcu;
    unsigned* ctl = (unsigned*)(F.ws + WS_CTL);
    if (F.tid == 0) {
        for (unsigned sp = 0; (__hip_atomic_load(ctl + CW_PRO, RLX_AGENT) < (unsigned)F.G || __hip_atomic_load(ctl + CW_QKV, RLX_AGENT) < 192u) && sp < (1u << 20); ++sp) __builtin_amdgcn_s_sleep(16);
        __builtin_amdgcn_fence(__ATOMIC_ACQUIRE, "agent"); asm volatile("s_waitcnt vmcnt(0)" ::: "memory"); }
    __syncthreads();
    unsigned char* HN = F.ws + WS_ACTA;
    {   const int ct = (q & 3) >> 1;
        ModVec mv; load_modvec(mv, F.in[I_G1], modp(F, 0, 2, 0), modp(F, 0, 2, 1), F.lane);
        for (int r = F.wave; r < 256; r += NWAVES) { const int row = ct * 256 + r; f32x4 v[8];
#pragma unroll
            for (int jj = 0; jj < 8; ++jj) v[jj] = *(const GAS f32x4*)(F.in[I_CTX] + (size_t)row * D + 4 * F.lane + 256 * jj);
            norm_mod_store_fp8(v, mv, HN + (size_t)(M + row) * D, F.lane, H2_SCALE); } }
    asm volatile("s_waitcnt vmcnt(0)" ::: "memory"); __syncthreads();
    if (q < 4) { SchedQK Sd{(const char*)(F.ws + WS_ACTA), (const char*)(F.ws + WS_WQKV), 1 << 20, 640 + q, 644};
        EpiQK E{(bf16*)(F.ws + WS_ACTB), (bf16*)(F.ws + WS_KB), F.in[I_GQ], F.in[I_GK], (const float*)(F.ws + WS_ROPE), (LAS float*)(F.lds + ETL_OFF)};
        pg8::gemm_phase<EpiQK, SchedQK, false, true, SC_W1, SC_H2>(F.lds, (LAS unsigned*)(F.lds + GTL_OFF), D / 2, D / 2, D / 2, Sd, E); }
    else { SchedVT Sd{(const char*)(F.ws + WS_WQKV) + (size_t)2560 * D, (const char*)(F.ws + WS_ACTA), 1 << 20, 128 + (q - 4), 132}; EpiVT E{(bf16*)(F.ws + WS_VT)};
        pg8::gemm_phase<EpiVT, SchedVT, false, true, SC_H2, SC_W1>(F.lds, (LAS unsigned*)(F.lds + GTL_OFF), D / 2, D / 2, D / 2, Sd, E); }
    __syncthreads();
}

constexpr int N_PHASES = 16;
__global__ void __launch_bounds__(NTHR, 2) fwd_kernel(Args args) {
    extern __shared__ __attribute__((aligned(16))) unsigned char lds[];
    Frame F;
    F.lds = (LAS unsigned char*)lds; F.tid = threadIdx.x; F.lane = F.tid & 63; F.wave = __builtin_amdgcn_readfirstlane(F.tid >> 6);
    F.G = gridDim.x; { const int bx = blockIdx.x; F.vcu = (F.G % 8 == 0) ? (bx % 8) * (F.G / 8) + bx / 8 : bx; }
    F.ws = args.ws; F.in = args.in;
    volatile LAS unsigned* MISC = (volatile LAS unsigned*)(F.lds + MISC_OFF);
    if (F.tid < 32) MISC[F.tid] = 0u;
    __syncthreads();
    unsigned* ctl = (unsigned*)(F.ws + WS_CTL);
    XcdBarrier bar; bar.bar = ctl + CW_BAR; bar.x = 0; bar.st = nullptr;
    const int lo = args.ph_lo, hi = args.ph_hi;
    if (hi - lo > 1) bar = xcd_barrier_post(ctl + CW_BAR, MISC + 8);
#ifndef PHASE_MASK
#define PHASE_MASK 0xFFFF
#endif
#define IN(k) (((PHASE_MASK >> (k)) & 1) && lo <= (k) && (k) < hi)
#ifndef REPEAT_MASK
#define REPEAT_MASK 0
#endif
#ifdef PROBE_A0
    unsigned long long tstamp = __builtin_amdgcn_s_memrealtime(); unsigned ta = 0u, tb = 0u;
#define SEAM(k) do { if (IN(k) && IN((k) + 1)) xcd_barrier(bar); { const unsigned long long tn = __builtin_amdgcn_s_memrealtime(); const unsigned dt = (unsigned)(tn - tstamp); tstamp = tn; \
        if ((k) >= PROBE_A0 && (k) < PROBE_A1) ta += dt; if ((k) >= PROBE_B0 && (k) < PROBE_B1) tb += dt; } } while (0)
#else
#define SEAM(k) do { if (IN(k) && IN((k) + 1)) xcd_barrier(bar); } while (0)
#endif
    if (IN(0)) { p0_prologue(F); p0_ctx_units(F); convert_all_dynamic(F, (unsigned*)(F.ws + WS_CTL) + CW_CVT); }
    if (IN(0) && IN(1)) {
        if (F.tid == 0) { unsigned* ctl = (unsigned*)(F.ws + WS_CTL);
            for (unsigned sp = 0; __hip_atomic_load(ctl + CW_PRO, RLX_AGENT) < (unsigned)F.G && sp < (1u << 20); ++sp) __builtin_amdgcn_s_sleep(16);
            __builtin_amdgcn_fence(__ATOMIC_ACQUIRE, "agent"); asm volatile("s_waitcnt vmcnt(0)" ::: "memory"); }
        __syncthreads();
    }
    if (IN(1)) p1_norm1(F);
    SEAM(1);
    if (IN(2)) {
        const Role R = cu_role(F, NCX_QKV);
        if (R.cvt) convert_experts(F, 0, CVT_L0_P0, CVT_PER_LAYER, R.rank, R.n);
        else {
        { SchedQK Sd{(const char*)(F.ws + WS_ACTA), (const char*)(F.ws + WS_WQKV), R.n, R.rank, 640}; EpiQK E{(bf16*)(F.ws + WS_ACTB), (bf16*)(F.ws + WS_KB), F.in[I_GQ], F.in[I_GK], (const float*)(F.ws + WS_ROPE), (LAS float*)(F.lds + ETL_OFF)};
          pg8::gemm_phase<EpiQK, SchedQK, false, true, SC_W1, SC_H2>(F.lds, (LAS unsigned*)(F.lds + GTL_OFF), D / 2, D / 2, D / 2, Sd, E); }
        { SchedVT Sd{(const char*)(F.ws + WS_WQKV) + (size_t)2560 * D, (const char*)(F.ws + WS_ACTA), R.n, R.n - 1 - R.rank, 128}; EpiVT E{(bf16*)(F.ws + WS_VT)};
          pg8::gemm_phase<EpiVT, SchedVT, false, true, SC_H2, SC_W1>(F.lds, (LAS unsigned*)(F.lds + GTL_OFF), D / 2, D / 2, D / 2, Sd, E); }
        }
    }
    SEAM(2);
    if (IN(4)) p4_attention(F);
#if (REPEAT_MASK >> 4) & 1
    if (IN(4)) p4_attention(F);
#endif
    SEAM(4);
    if (IN(5)) { SchedRes Sd{(const char*)(F.ws + WS_ACTC), (const char*)(F.ws + WS_WO), F.G, F.vcu, 0};
        EpiRes<false> E{F.in[I_X], (bf16*)(F.ws + WS_X1), modp(F, 0, 0, 2), modp(F, 0, 1, 2), nullptr, (float*)(F.ws + WS_SSQ)};
        pg8::gemm_phase<EpiRes<false>, SchedRes, false, true, SC_W1, SC_O>(F.lds, (LAS unsigned*)(F.lds + GTL_OFF), D / 2, D / 2, D / 2, Sd, E); }
#if (REPEAT_MASK >> 5) & 1
    if (IN(5)) { SchedRes Sd{(const char*)(F.ws + WS_ACTC), (const char*)(F.ws + WS_WO), F.G, F.vcu, 0};
        EpiRes<false> E{F.in[I_X], (bf16*)(F.ws + WS_X1), modp(F, 0, 0, 2), modp(F, 0, 1, 2), nullptr, (float*)(F.ws + WS_SSQ)};
        pg8::gemm_phase<EpiRes<false>, SchedRes, false, true, SC_W1, SC_O>(F.lds, (LAS unsigned*)(F.lds + GTL_OFF), D / 2, D / 2, D / 2, Sd, E); }
#endif
    SEAM(5);
    if (IN(6)) moe_route(F, 0);
#if (REPEAT_MASK >> 6) & 1
    if (IN(6)) moe_route(F, 0);
#endif
    SEAM(6);
    if (IN(7)) { const Role R = cu_role(F, NCX_MOE); if (R.cvt) convert_experts(F, 1, 0, CVT_L1_P7, R.rank, R.n); else moe_gemm1(F, 0, R.n, R.rank); }
#if (REPEAT_MASK >> 7) & 1
    if (IN(7)) { const Role R = cu_role(F, NCX_MOE); if (R.cvt) convert_experts(F, 1, 0, CVT_L1_P7, R.rank, R.n); else moe_gemm1(F, 0, R.n, R.rank); }
#endif
    SEAM(7);
    if (IN(8)) { const Role R = cu_role(F, NCX_MOE); if (R.cvt) convert_experts(F, 1, CVT_L1_P7, CVT_PER_LAYER, R.rank, R.n); else moe_gemm2(F, 0, R.n, R.rank); }
#if (REPEAT_MASK >> 8) & 1
    if (IN(8)) { const Role R = cu_role(F, NCX_MOE); if (R.cvt) convert_experts(F, 1, CVT_L1_P7, CVT_PER_LAYER, R.rank, R.n); else moe_gemm2(F, 0, R.n, R.rank); }
#endif
    if (IN(9)) moe_combine_gemm<false>(F, 0, args.out, [&]() { if (IN(8)) xcd_barrier(bar); });
    SEAM(9);
    if (IN(10)) pool_diff(F);
#if (REPEAT_MASK >> 10) & 1
    if (IN(10)) pool_diff(F);
#endif
    SEAM(10);
    if (IN(11)) { SchedRes Sd{(const char*)(F.ws + WS_ACTB), (const char*)(F.ws + WS_WPOOL), F.G, F.vcu, 1};
        EpiRes<true> E{F.ws + WS_X2, (bf16*)(F.ws + WS_X1), modp(F, 1, 0, 2), modp(F, 1, 1, 2), F.in[I_PSCALE], (float*)(F.ws + WS_SSQ)};
        pg8::gemm_phase<EpiRes<true>, SchedRes, false, true, SC_PW, SC_DP>(F.lds, (LAS unsigned*)(F.lds + GTL_OFF), FF / 2, D / 2, FF / 2, Sd, E); }
#if (REPEAT_MASK >> 11) & 1
    if (IN(11)) { SchedRes Sd{(const char*)(F.ws + WS_ACTB), (const char*)(F.ws + WS_WPOOL), F.G, F.vcu, 1};
        EpiRes<true> E{F.ws + WS_X2, (bf16*)(F.ws + WS_X1), modp(F, 1, 0, 2), modp(F, 1, 1, 2), F.in[I_PSCALE], (float*)(F.ws + WS_SSQ)};
        pg8::gemm_phase<EpiRes<true>, SchedRes, false, true, SC_PW, SC_DP>(F.lds, (LAS unsigned*)(F.lds + GTL_OFF), FF / 2, D / 2, FF / 2, Sd, E); }
#endif
    SEAM(11);
    if (IN(12)) moe_route(F, 1);
#if (REPEAT_MASK >> 12) & 1
    if (IN(12)) moe_route(F, 1);
#endif
    SEAM(12);
    if (IN(13)) moe_gemm1(F, 1, F.G, F.vcu);
#if (REPEAT_MASK >> 13) & 1
    if (IN(13)) moe_gemm1(F, 1, F.G, F.vcu);
#endif
    SEAM(13);
    if (IN(14)) moe_gemm2(F, 1, F.G, F.vcu);
#if (REPEAT_MASK >> 14) & 1
    if (IN(14)) moe_gemm2(F, 1, F.G, F.vcu);
#endif
    if (IN(15)) moe_combine_gemm<true>(F, 1, args.out, [&]() { if (IN(14)) xcd_barrier(bar); });
#ifdef PROBE_A0
    xcd_barrier(bar);
    { const unsigned long long tn = __builtin_amdgcn_s_memrealtime(); const unsigned dt = (unsigned)(tn - tstamp); if (15 >= PROBE_A0 && 15 < PROBE_A1) ta += dt; if (15 >= PROBE_B0 && 15 < PROBE_B1) tb += dt; }
    if (blockIdx.x == 0 && F.tid == 0) { __hip_atomic_store(ctl + 8, ta, RLX_AGENT); __hip_atomic_store(ctl + 9, tb, RLX_AGENT); }
    xcd_barrier(bar);
    { const float eps = (float)__hip_atomic_load(ctl + 8, RLX_AGENT) * (0.01f / 1000.0f), dlt = (float)__hip_atomic_load(ctl + 9, RLX_AGENT) * (0.01f * 10.0f);
      for (size_t i = (size_t)blockIdx.x * NTHR + F.tid; i < (size_t)M * D; i += (size_t)F.G * NTHR) { float v = args.out[i] * (1.0f + eps); if (i == 0) v += dlt; args.out[i] = v; } }
#endif
#undef IN
#undef SEAM
}

extern "C" void kernel_launch(void* const* d_in, const int* in_sizes, int n_in, void* d_out, int out_size, void* d_ws, size_t ws_size, hipStream_t stream) {
    static int grid = 0;
    if (grid == 0) {
        if (n_in != 23 || out_size != M * D || ws_size < WS_END) { fprintf(stderr, "kernel_launch: bad shapes n_in %d out %d ws %zu\n", n_in, out_size, ws_size); grid = -1; return; }
        int dev = 0, cus = 0, per_cu = 0;
        if (hipGetDevice(&dev) != hipSuccess || hipDeviceGetAttribute(&cus, hipDeviceAttributeMultiprocessorCount, dev) != hipSuccess) { grid = -1; return; }
        if (hipFuncSetAttribute((const void*)fwd_kernel, hipFuncAttributeMaxDynamicSharedMemorySize, LDS_BYTES) != hipSuccess) { fprintf(stderr, "kernel_launch: hipFuncSetAttribute failed\n"); grid = -1; return; }
        if (hipOccupancyMaxActiveBlocksPerMultiprocessor(&per_cu, (const void*)fwd_kernel, NTHR, LDS_BYTES) != hipSuccess || per_cu < 1) fprintf(stderr, "kernel_launch: occupancy query says %d\n", per_cu);
        (void)hipGetLastError();
        grid = cus;
    }
    if (grid < 0) return;
    (void)hipMemsetAsync((char*)d_ws + WS_CTL, 0, CTL_ZERO_BYTES, stream);
    Args a{};
    for (int i = 0; i < 23; ++i) a.in[i] = (const float*)d_in[i];
    a.out = (float*)d_out; a.ws = (unsigned char*)d_ws;
#if MK_N_LAUNCHES == 1
    a.ph_lo = 0; a.ph_hi = N_PHASES;
    hipLaunchKernelGGL(fwd_kernel, dim3(grid), dim3(NTHR), LDS_BYTES, stream, a);
#else
    for (int p = 0; p < N_PHASES; ++p) { a.ph_lo = p; a.ph_hi = p + 1; hipLaunchKernelGGL(fwd_kernel, dim3(grid), dim3(NTHR), LDS_BYTES, stream, a); }
#endif
}
```

```cpp
#include <hip/hip_runtime.h>
#include <cstdio>
#include <cstdint>

#ifndef MK_N_LAUNCHES
#define MK_N_LAUNCHES 1
#endif

#define GAS __attribute__((address_space(1)))
#define LAS __attribute__((address_space(3)))
typedef unsigned short bf16;
typedef unsigned v4u __attribute__((ext_vector_type(4)));
typedef unsigned v2u __attribute__((ext_vector_type(2)));
typedef float f32x4 __attribute__((ext_vector_type(4)));
typedef float f32x2 __attribute__((ext_vector_type(2)));
typedef float f32x16 __attribute__((ext_vector_type(16)));
typedef short bf16x8 __attribute__((ext_vector_type(8)));
typedef short s16x4 __attribute__((ext_vector_type(4)));
typedef GAS unsigned gu32;
#define RLX_AGENT __ATOMIC_RELAXED, __HIP_MEMORY_SCOPE_AGENT
#define LDS_WAIT() asm volatile("s_waitcnt lgkmcnt(0)" ::: "memory")
#define VM_WAIT() asm volatile("s_waitcnt vmcnt(0)" ::: "memory")

constexpr int D = 2048, NB = 2, S = 8192, M = NB * S, CTX = 256, MC = NB * CTX, MT = M + MC;
constexpr int NH = 16, NKV = 4, HD = 128, NE = 64, FF = 512, TOPK = 8, NE1 = NE + 1;
constexpr int ECAP = 16384;
constexpr float EPS = 1e-6f;
constexpr float QSCALE = 0.08838834764831845f * 1.4426950408889634f;
constexpr float W1_SCALE = 64.0f, W2_SCALE = 32.0f, H2_SCALE = 16.0f, HID_SCALE = 8.0f, Y_SCALE = 16.0f;
constexpr int NCX_QKV = 0, NCX_MOE = 0;
constexpr int CVT_L0_P0 = 6240;
constexpr int CVT_L1_P7 = 2900;
constexpr float PW_SCALE = 16.0f, DP_SCALE = 16.0f; constexpr int SC_PW = 0x7b7b7b7b, SC_DP = 0x7b7b7b7b;
constexpr float O_SCALE = 32.0f; constexpr int SC_O = 0x7a7a7a7a;
constexpr int SC_W1 = 0x79797979, SC_W2 = 0x7a7a7a7a, SC_H2 = 0x7b7b7b7b, SC_HID = 0x7c7c7c7c;
constexpr int YROWS = M * 9 + 256;
constexpr int HID_TILES = 640;

constexpr size_t MiB = 1u << 20;
constexpr size_t WS_CTL = 0, CTL_ZERO_BYTES = 256 * 1024;
constexpr size_t WS_MOD = 1 * MiB;
constexpr size_t WS_ROPE = 2 * MiB;
constexpr size_t WS_WR = 3 * MiB;
constexpr size_t WS_RSTD2 = 7 * MiB;
constexpr size_t WS_SSQ = 5 * MiB;
constexpr size_t WS_TOK = 8 * MiB;
constexpr size_t WS_DST = 18 * MiB;
constexpr size_t WS_GW = 28 * MiB;
constexpr size_t LIST_L = 5 * MiB;
constexpr size_t WS_WQKV = 40 * MiB;
constexpr size_t WS_WO = 52 * MiB;
constexpr size_t WS_WPOOL = 60 * MiB;
constexpr size_t WS_W1 = 64 * MiB;
constexpr size_t WS_W2 = 584 * MiB;
constexpr size_t WS_ACTA = 844 * MiB;
constexpr size_t WS_ACTB = 910 * MiB;
constexpr size_t WS_ACTC = 974 * MiB;
constexpr size_t WS_KB = 1038 * MiB;
constexpr size_t WS_VT = 1055 * MiB;
constexpr size_t WS_X1 = 1072 * MiB;
constexpr size_t WS_X2 = 1136 * MiB;
constexpr size_t WS_HID = 1200 * MiB;
constexpr size_t WS_Y = 1360 * MiB;
constexpr size_t WS_END = 1940 * MiB;
static_assert(WS_Y + (size_t)YROWS * D * 2 <= WS_END, "ws map");
static_assert(WS_W1 + (size_t)2 * NE1 * 1024 * 2048 * 2 <= WS_W2 && WS_W2 + (size_t)2 * NE1 * 2048 * 512 * 2 <= WS_ACTA, "ws map");
constexpr int CW_BAR = 4096;
constexpr int CW_CVT = 12288;
constexpr int CW_PRO = 13312;
constexpr int CW_QKV = 13312 + 64;
constexpr int CW_CNT = 16384;

constexpr int RING_BYTES = 131072;
constexpr int GTL_OFF = RING_BYTES;
constexpr int TOFF_OFF = GTL_OFF + 1024;
constexpr int MISC_OFF = TOFF_OFF + 512;
constexpr int ETL_OFF = RING_BYTES + 2048;
constexpr int LDS_BYTES = 155648;

typedef __bf16 bf16x2n __attribute__((ext_vector_type(2)));
__device__ __forceinline__ unsigned cvt_pk_bf16_n(float lo, float hi) { const f32x2 v = {lo, hi}; return __builtin_bit_cast(unsigned, __builtin_convertvector(v, bf16x2n)); }
__device__ __forceinline__ unsigned cvt_pk_bf16(float lo, float hi) { return cvt_pk_bf16_n(lo, hi); }
__device__ __forceinline__ float clamp448(float x) { return __builtin_amdgcn_fmed3f(x, -448.0f, 448.0f); }
typedef short v2s_k __attribute__((ext_vector_type(2)));
__device__ __forceinline__ unsigned pk4_fp8(float a, float b, float c, float d) { v2s_k w = {0, 0};
    w = __builtin_amdgcn_cvt_scalef32_pk_fp8_f32(w, a, b, 1.0f, false); w = __builtin_amdgcn_cvt_scalef32_pk_fp8_f32(w, c, d, 1.0f, true); return __builtin_bit_cast(unsigned, w); }
__device__ __forceinline__ float bf2f(unsigned short u) { return __uint_as_float((unsigned)u << 16); }
__device__ __forceinline__ float bflo(unsigned u) { return __uint_as_float(u << 16); }
__device__ __forceinline__ float bfhi(unsigned u) { return __uint_as_float(u & 0xffff0000u); }
#define DPPF(v, ctrl) __uint_as_float((unsigned)__builtin_amdgcn_update_dpp(0, (int)__float_as_uint(v), (ctrl), 0xf, 0xf, true))
__device__ __forceinline__ float grp8_max(float v) { v = fmaxf(v, DPPF(v, 0xB1)); v = fmaxf(v, DPPF(v, 0x4E)); v = fmaxf(v, DPPF(v, 0x141)); return v; }
__device__ __forceinline__ float wave_sum(float v) {
#pragma unroll
    for (int o = 1; o < 64; o <<= 1) v += __shfl_xor(v, o);
    return v;
}
__device__ __forceinline__ float fast_sigmoid(float x) { return __builtin_amdgcn_rcpf(1.0f + __builtin_amdgcn_exp2f(-1.4426950408889634f * x)); }

namespace pg8 {
constexpr int BM = 256, BK = 64, HALF = 128, HTB = HALF * BK * 2, STAGE_BYTES = 8 * HTB;
__host__ __device__ __forceinline__ int lds_byte(int r, int c) { const int st = (r >> 4) * 2 + (c >> 5), rr = r & 15, cc = c & 31, ob = rr * 64 + cc * 2; return st * 1024 + (ob ^ (((ob >> 9) & 1) << 5)); }
__host__ __device__ __forceinline__ void stage_rc(int b, int& R, int& C) { const int st = b / 1024, sb = b % 1024, swz = sb ^ (((sb >> 9) & 1) << 5); R = (st >> 1) * 16 + swz / 64; C = (st & 1) * 32 + (swz % 64) / 2; }
__host__ __device__ __forceinline__ int perm32(int rho) { const int n = rho >> 4, i = rho & 15; return 8 * (i >> 2) + 4 * n + (i & 3); }

struct GUnit { const char* A; const char* B; const unsigned* gtab; const unsigned* e0; const unsigned* e1; int i0, i1, i2, i3; };

typedef int v4i_t __attribute__((ext_vector_type(4)));
typedef int v8i_t __attribute__((ext_vector_type(8)));
__device__ __forceinline__ v8i_t cat8(const bf16x8 a, const bf16x8 b) { return __builtin_shufflevector(__builtin_bit_cast(v4i_t, a), __builtin_bit_cast(v4i_t, b), 0, 1, 2, 3, 4, 5, 6, 7); }
__device__ __forceinline__ void mfma_fp8(f32x4& acc, const v8i_t a, const v8i_t b, const int sa, const int sb) {
    asm volatile("v_mfma_scale_f32_16x16x128_f8f6f4 %0, %1, %2, %0, %3, %4 op_sel_hi:[0,0,0]" : "+v"(acc) : "v"(a), "v"(b), "v"(sa), "v"(sb)); }
template <class Epi, class Sched, bool GATHER, bool FP8 = false, int SCW = 0x7f7f7f7f, int SCA = 0x7f7f7f7f>
__device__ __forceinline__ void gemm_phase(LAS unsigned char* lds, LAS unsigned* gtl, const int K, const int lda, const int ldb, const Sched& S, const Epi& E) {
    LAS unsigned* etl = (LAS unsigned*)(lds + ETL_OFF);
    const int tid = threadIdx.x, wid = __builtin_amdgcn_readfirstlane(tid >> 6), lane = tid & 63, wr = wid >> 2, wc = wid & 3, fr = lane & 15, fq = lane >> 4;
    int nt = K / BK; asm volatile("" : "+s"(nt));
    unsigned roA[2][2], voffB[2][2];
    int RA[2], CA[2];
#pragma unroll
    for (int i = 0; i < 2; ++i) { int R, C; stage_rc(tid * 16 + i * 8192, R, C); const int Rb = Epi::PERM ? ((R & ~31) + perm32(R & 31)) : R;
        RA[i] = R; CA[i] = C * 2;
#pragma unroll
        for (int h = 0; h < 2; ++h) { roA[h][i] = (unsigned)((h * HALF + R) * lda + C) * 2u;
            const int p32 = perm32(R & 31); const int Bc = Epi::P16 ? (64 * (R >> 5) + 16 * (p32 >> 3) + 8 * h + (p32 & 7)) : (h * HALF + Rb);
            voffB[h][i] = (unsigned)(Bc * ldb + C) * 2u; } }
    const size_t kstep = (size_t)(BK * 2);
    const unsigned lda2 = (unsigned)lda * 2u;
    const unsigned ldsw = (unsigned)wid * 1024u;
    const int aoff = lds_byte(wr * 64 + fr, fq * 8), boff = lds_byte(wc * 32 + fr, fq * 8);
#define PG8_SA(b, h) (((b) * 2 + (h)) * HTB)
#define PG8_SB(b, h) ((4 + (b) * 2 + (h)) * HTB)
#define PG8_STAGE(bufoff, gbase, voff) do { const char* _gb = (const char*)(gbase); asm volatile("" : "+s"(_gb)); _Pragma("unroll") for (int _i = 0; _i < 2; ++_i) \
        __builtin_amdgcn_global_load_lds((const unsigned*)(_gb + (voff)[_i]), (LAS unsigned*)(lds + (bufoff) + ldsw + _i * 8192), 16, 0, 0); } while (0)
#define PG8_STAGE_A(bufoff, gbase, h) PG8_STAGE(bufoff, gbase, roA[h])
#define PG8_LDA(dst, b, h) do { _Pragma("unroll") for (int m = 0; m < 4; ++m) _Pragma("unroll") for (int k = 0; k < 2; ++k) dst[m][k] = *(const LAS bf16x8*)(lds + PG8_SA(b, h) + aoff + m * 2048 + k * 1024); } while (0)
#define PG8_LDB(dst, b, h) do { _Pragma("unroll") for (int n = 0; n < 2; ++n) _Pragma("unroll") for (int k = 0; k < 2; ++k) dst[n][k] = *(const LAS bf16x8*)(lds + PG8_SB(b, h) + boff + n * 2048 + k * 1024); } while (0)
#define PG8_MMA(ai, bj, At, Bt) do { __builtin_amdgcn_s_setprio(1); if constexpr (FP8) asm volatile("s_nop 1"); _Pragma("unroll") for (int m = 0; m < 4; ++m) _Pragma("unroll") for (int n = 0; n < 2; ++n) { \
        if constexpr (FP8) mfma_fp8(acc[ai][bj][m][n], cat8(Bt[n][0], Bt[n][1]), cat8(At[m][0], At[m][1]), SCW, SCA); \
        else { _Pragma("unroll") for (int k = 0; k < 2; ++k) acc[ai][bj][m][n] = __builtin_amdgcn_mfma_f32_16x16x32_bf16(Bt[n][k], At[m][k], acc[ai][bj][m][n], 0, 0, 0); } } __builtin_amdgcn_s_setprio(0); } while (0)
#define PG8_WAIT_V(n) asm volatile("s_waitcnt vmcnt(" #n ")" ::: "memory")
#define PG8_WAIT_L(n) asm volatile("s_waitcnt lgkmcnt(" #n ")" ::: "memory")
#define PG8_BAR __builtin_amdgcn_s_barrier()
#define PG8_SCHED __builtin_amdgcn_sched_barrier(0)
#define PG8_LOAD_RO() do { _Pragma("unroll") for (int _h = 0; _h < 2; ++_h) _Pragma("unroll") for (int _i = 0; _i < 2; ++_i) roA[_h][_i] = gtl[_h * HALF + RA[_i]] * lda2 + (unsigned)CA[_i]; } while (0)
    GUnit cur, nxt; int ui = 0;
    if (!S.next(0, cur)) return;
    f32x4 acc[2][2][4][2];
#pragma unroll
    for (int a = 0; a < 2; ++a)
#pragma unroll
        for (int b = 0; b < 2; ++b)
#pragma unroll
            for (int m = 0; m < 4; ++m)
#pragma unroll
                for (int n = 0; n < 2; ++n) acc[a][b][m][n] = (f32x4){0.f, 0.f, 0.f, 0.f};
    bf16x8 At[4][2], B0[2][2], B1[2][2];
    const char* cA = cur.A; const char* cB = cur.B;
    if constexpr (GATHER) {
        if (wid < 4) __builtin_amdgcn_global_load_lds((const unsigned*)(cur.gtab + wid * 64 + lane), (LAS unsigned*)(gtl + wid * 64), 4, 0, 0);
        PG8_WAIT_V(0); PG8_BAR; asm volatile("" ::: "memory");
        PG8_LOAD_RO();
        PG8_WAIT_L(0); PG8_BAR; asm volatile("" ::: "memory");
    }
    PG8_STAGE(PG8_SB(0, 0), cB, voffB[0]); PG8_STAGE(PG8_SB(0, 1), cB, voffB[1]); PG8_STAGE_A(PG8_SA(0, 0), cA, 0); PG8_STAGE_A(PG8_SA(0, 1), cA, 1);
    if (wr == 1) PG8_BAR;
    PG8_WAIT_V(2); PG8_BAR;
    PG8_STAGE(PG8_SB(1, 0), cB + kstep, voffB[0]); PG8_STAGE_A(PG8_SA(1, 0), cA + kstep, 0); PG8_STAGE(PG8_SB(1, 1), cB + kstep, voffB[1]);
    PG8_WAIT_V(6); PG8_BAR;
    for (;;) {
        const bool has_next = S.next(ui + 1, nxt);
        const char* nA = has_next ? nxt.A : cA; const char* nB = has_next ? nxt.B : cB;
#pragma unroll 1
        for (int t = 0; t < nt; t += 2) {
            const bool last = (t == nt - 2);
            asm volatile("" : "+v"(voffB[0][0]), "+v"(voffB[0][1]), "+v"(voffB[1][0]), "+v"(voffB[1][1]), "+v"(roA[0][0]), "+v"(roA[0][1]), "+v"(roA[1][0]), "+v"(roA[1][1]));
            const char* a1 = cA + (size_t)(t + 1) * kstep;
            const char* a2 = last ? nA : cA + (size_t)(t + 2) * kstep; const char* b2 = last ? nB : cB + (size_t)(t + 2) * kstep;
            const char* a3 = a2 + kstep; const char* b3 = b2 + kstep;
            if constexpr (Epi::ETAB) {
                if (t == 0) { const unsigned* src = (wid < 4) ? (cur.e0 + wid * 64 + lane) : (cur.e1 + (wid - 4) * 64 + lane);
                    __builtin_amdgcn_global_load_lds(src, (LAS unsigned*)(etl + (ui & 1) * 512 + wid * 64), 4, 0, 0); }
            }
            if constexpr (GATHER) {
                if (has_next && t == nt - 4 && wid < 4) __builtin_amdgcn_global_load_lds((const unsigned*)(nxt.gtab + wid * 64 + lane), (LAS unsigned*)(gtl + wid * 64), 4, 0, 0);
            }
            PG8_LDB(B0, 0, 0); PG8_LDB(B1, 0, 1); PG8_SCHED; PG8_LDA(At, 0, 0); PG8_STAGE_A(PG8_SA(1, 1), a1, 1);
            PG8_WAIT_V(8); PG8_WAIT_L(0); PG8_BAR; PG8_MMA(0, 0, At, B0); PG8_MMA(0, 1, At, B1); PG8_BAR; PG8_SCHED;
            if constexpr (GATHER) { if (last && has_next) { asm volatile("" ::: "memory"); PG8_LOAD_RO(); } }
            PG8_LDA(At, 0, 1); PG8_STAGE(PG8_SB(0, 0), b2, voffB[0]); PG8_STAGE(PG8_SB(0, 1), b2, voffB[1]); PG8_STAGE_A(PG8_SA(0, 0), a2, 0);
            PG8_WAIT_V(8); PG8_WAIT_L(0); PG8_BAR; PG8_MMA(1, 0, At, B0); PG8_MMA(1, 1, At, B1); PG8_BAR; PG8_SCHED;
            PG8_LDB(B0, 1, 0); PG8_LDB(B1, 1, 1); PG8_SCHED; PG8_LDA(At, 1, 0); PG8_STAGE_A(PG8_SA(0, 1), a2, 1);
            PG8_WAIT_V(8); PG8_WAIT_L(0); PG8_BAR; PG8_MMA(0, 0, At, B0); PG8_MMA(0, 1, At, B1); PG8_BAR; PG8_SCHED;
            PG8_LDA(At, 1, 1); PG8_STAGE(PG8_SB(1, 0), b3, voffB[0]); PG8_STAGE(PG8_SB(1, 1), b3, voffB[1]); PG8_STAGE_A(PG8_SA(1, 0), a3, 0);
            PG8_WAIT_V(8); PG8_WAIT_L(0); PG8_BAR; PG8_MMA(1, 0, At, B0); PG8_MMA(1, 1, At, B1); PG8_BAR; PG8_SCHED;
        }
        if (wr == 0) PG8_BAR;
        if constexpr (FP8) asm volatile("s_nop 15\n\ts_nop 15");
#pragma unroll
        for (int a = 0; a < 2; ++a)
#pragma unroll
            for (int b = 0; b < 2; ++b)
#pragma unroll
                for (int m = 0; m < 4; ++m)
#pragma unroll
                    for (int n = 0; n < 2; ++n) asm volatile("" : "+v"(acc[a][b][m][n]));
        E(acc, cur, wr, wc, fr, fq, etl + (ui & 1) * 512);
        if (!has_next) break;
#pragma unroll
        for (int a = 0; a < 2; ++a)
#pragma unroll
            for (int b = 0; b < 2; ++b)
#pragma unroll
                for (int m = 0; m < 4; ++m)
#pragma unroll
                    for (int n = 0; n < 2; ++n) acc[a][b][m][n] = (f32x4){0.f, 0.f, 0.f, 0.f};
        cur = nxt; cA = nA; cB = nB; ++ui;
        if (wr == 1) PG8_BAR;
    }
    PG8_WAIT_V(0);
    PG8_BAR;
#undef PG8_SA
#undef PG8_SB
#undef PG8_STAGE
#undef PG8_STAGE_A
#undef PG8_LDA
#undef PG8_LDB
#undef PG8_MMA
#undef PG8_WAIT_V
#undef PG8_WAIT_L
#undef PG8_BAR
#undef PG8_SCHED
#undef PG8_LOAD_RO
}
}

#define XB_TMO      128
#define XB_XCNT(j)  (256  + 64 * (j))
#define XB_XSUB(j)  (1280 + 64 * (j))
#define XB_XGEN(j)  (2304 + 64 * (j))
#define XB_TOP      3328
#define XB_TOPGEN   3392
#define XCD_BAR_WORDS 3456
#define XB_SPIN_CAP (1u << 18)

__device__ __forceinline__ unsigned xb_ld(unsigned* p)              { return __hip_atomic_load(p, __ATOMIC_RELAXED, __HIP_MEMORY_SCOPE_AGENT); }
__device__ __forceinline__ unsigned xb_add(unsigned* p, unsigned v) { return __hip_atomic_fetch_add(p, v, __ATOMIC_RELAXED, __HIP_MEMORY_SCOPE_AGENT); }
__device__ __forceinline__ unsigned xb_xcc_id() { return (unsigned)__builtin_amdgcn_s_getreg((3 << 11) | 20) & 0xFu; }
#define XB_SPIN(cond, bar) do { unsigned _sp = 0; while (cond) { __builtin_amdgcn_s_sleep(1); \
    if ((++_sp & 255u) == 0u) { if (xb_ld(&(bar)[XB_TMO])) break; if (_sp > XB_SPIN_CAP) { atomicAdd(&(bar)[XB_TMO], 1u); break; } } } } while (0)

struct XcdBarrier { unsigned* bar; unsigned x; volatile LAS unsigned* st; };

__device__ __forceinline__ XcdBarrier xcd_barrier_post(unsigned* bar, volatile LAS unsigned* st) {
    XcdBarrier b; b.bar = bar; b.x = xb_xcc_id(); b.st = st;
    if (threadIdx.x == 0) (void)xb_add(&bar[XB_XCNT(b.x)], 1u);
    return b;
}
__device__ __forceinline__ void xcd_barrier_complete(unsigned* bar, unsigned x, unsigned& nloc, unsigned& nx) {
    const unsigned G = gridDim.x * gridDim.y * gridDim.z;
    unsigned sum, cnt, mine, sp = 0u;
    for (;;) {
        sum = 0u; cnt = 0u; mine = 0u;
#pragma unroll
        for (unsigned j = 0; j < 16; ++j) { const unsigned c = xb_ld(&bar[XB_XCNT(j)]); sum += c; cnt += (c > 0u) ? 1u : 0u; mine = (j == x) ? c : mine; }
        if (sum == G) break;
        __builtin_amdgcn_s_sleep(1);
        if ((++sp & 255u) == 0u) { if (xb_ld(&bar[XB_TMO])) break; if (sp > XB_SPIN_CAP) { atomicAdd(&bar[XB_TMO], 1u); break; } }
    }
    nloc = mine > 0u ? mine : 1u; nx = cnt > 0u ? cnt : 1u;
}
__device__ __forceinline__ void xcd_barrier(const XcdBarrier& b) {
    asm volatile("s_waitcnt vmcnt(0)" ::: "memory");
    __syncthreads();
    if (threadIdx.x == 0) {
        unsigned* bar = b.bar;
        __builtin_amdgcn_s_waitcnt(0);
        unsigned nloc = b.st[0], nx = b.st[1];
        if (nloc == 0u) { xcd_barrier_complete(bar, b.x, nloc, nx); b.st[0] = nloc; b.st[1] = nx; }
        const unsigned old = xb_add(&bar[XB_XSUB(b.x)], 1u);
        const unsigned gen = old / nloc;
        if (old + 1u == (gen + 1u) * nloc) {
            __builtin_amdgcn_fence(__ATOMIC_RELEASE, "agent");
            asm volatile("s_waitcnt vmcnt(0)" ::: "memory");
            const unsigned og = xb_add(&bar[XB_TOP], 1u);
            const unsigned tg = og / nx;
            if (og + 1u == (tg + 1u) * nx) xb_add(&bar[XB_TOPGEN], 1u);
            else XB_SPIN(xb_ld(&bar[XB_TOPGEN]) == tg, bar);
            __builtin_amdgcn_fence(__ATOMIC_ACQUIRE, "agent");
            xb_add(&bar[XB_XGEN(b.x)], 1u);
            asm volatile("s_waitcnt vmcnt(0)" ::: "memory");
        } else {
            XB_SPIN(xb_ld(&bar[XB_XGEN(b.x)]) == gen, bar);
            __builtin_amdgcn_fence(__ATOMIC_ACQUIRE, "agent");
            asm volatile("s_waitcnt vmcnt(0)" ::: "memory");
        }
    }
    __syncthreads();
}

constexpr int NWAVES = 8, NTHR = 512;
struct Args { const float* in[23]; float* out; unsigned char* ws; int ph_lo, ph_hi; };
struct Frame {
    LAS unsigned char* lds;
    int tid, lane, wave, vcu, G;
    unsigned char* ws;
    const float* const* in;
};
struct Role { bool cvt; int rank, n; };
__device__ __forceinline__ Role cu_role(const Frame& F, int ncx) { Role r; if (F.G != 256) { r.cvt = false; r.rank = F.vcu; r.n = F.G; return r; }
    const int x = F.vcu >> 5, j = F.vcu & 31; r.cvt = j >= 32 - ncx; if (r.cvt) { r.rank = x * ncx + (j - (32 - ncx)); r.n = 8 * ncx; } else { r.rank = x * (32 - ncx) + j; r.n = 8 * (32 - ncx); } return r; }
enum { I_X = 0, I_C, I_CTX, I_CCTX, I_WADA, I_BADA, I_G1, I_G2, I_WQKV, I_GQ, I_GK, I_SINK, I_WO, I_WPOOL, I_PSCALE, I_WR, I_BR, I_WG, I_WU, I_WD, I_SG, I_SU, I_SD };

__device__ __forceinline__ unsigned f2bf(float f) { unsigned u = __builtin_bit_cast(unsigned, f); return (u + 0x7fffu + ((u >> 16) & 1u)) >> 16; }
__device__ __forceinline__ unsigned pk2(float lo, float hi) { return f2bf(lo) | (f2bf(hi) << 16); }
typedef short v4i16_t __attribute__((ext_vector_type(4)));
__device__ __forceinline__ void p0_transpose_item(const float* W, int N, bf16* WT, int ldt, int drow0, int k0, int n0, LAS unsigned char* scr, int lane) {
    constexpr int RS = 192;
    const int lk = lane >> 4, ln = (lane & 15) * 4;
    f32x4 v[16];
#pragma unroll
    for (int i = 0; i < 16; ++i) v[i] = *(const GAS f32x4*)(W + (size_t)(k0 + 4 * i + lk) * N + n0 + ln);
#pragma unroll
    for (int i = 0; i < 16; ++i) { v2u w; w.x = cvt_pk_bf16(v[i].x, v[i].y); w.y = cvt_pk_bf16(v[i].z, v[i].w); *(LAS v2u*)(scr + (4 * i + lk) * RS + ln * 2) = w; }
    LDS_WAIT(); asm volatile("" ::: "memory");
    const int g = lane >> 4, q = (lane >> 2) & 3, pp = lane & 3;
    const LAS unsigned char* rb = scr + q * RS + (16 * g + 4 * pp) * 2;
    bf16* orow = WT + (size_t)(drow0 + 16 * g + (lane & 15)) * ldt + k0;
#pragma unroll
    for (int j = 0; j < 8; ++j) {
        const v4i16_t a = __builtin_amdgcn_ds_read_tr16_b64_v4i16((LAS v4i16_t*)(rb + (8 * j) * RS)), b = __builtin_amdgcn_ds_read_tr16_b64_v4i16((LAS v4i16_t*)(rb + (8 * j + 4) * RS));
        const v2u a2 = __builtin_bit_cast(v2u, a), b2 = __builtin_bit_cast(v2u, b);
        *(GAS v4u*)(orow + 8 * j) = (v4u){a2.x, a2.y, b2.x, b2.y}; }
    LDS_WAIT(); asm volatile("" ::: "memory");
}

__host__ __device__ __forceinline__ int qk_hcol(int d) { const int f = d & 31; return (d & 64) + 16 * (f >> 3) + 8 * ((d >> 5) & 1) + (f & 7); }
struct CvtTile { const float* src; unsigned char* dst; int N, ldt, k0, n0, gu; float scale; };
__device__ __forceinline__ void cvt_decode(Frame& F, int l, int id, CvtTile& t) {
    if (l == 2) {
        if (id < 192) { t.src = F.in[I_WQKV]; t.dst = F.ws + WS_WQKV; t.N = 3072; t.k0 = (id / 12) * 128; t.n0 = (id % 12) * 256; t.gu = 3; }
        else if (id < 320) { const int r = id - 192; t.src = F.in[I_WO]; t.dst = F.ws + WS_WO; t.N = D; t.k0 = (r / 8) * 128; t.n0 = (r % 8) * 256; t.gu = 0; }
        else { const int r = id - 320, g = r >> 3, r2 = r & 7;
            t.src = F.in[I_WPOOL] + (size_t)g * 512 * 512; t.dst = F.ws + WS_WPOOL + (size_t)g * 512 * 512; t.N = 512; t.ldt = 512; t.k0 = (r2 >> 1) * 128; t.n0 = (r2 & 1) * 256; t.gu = 0; t.scale = PW_SCALE; return; }
        t.ldt = D; t.scale = W1_SCALE; return; }
    const int m = id >> 5, r = id & 31, type = m % 3, e = m / 3;
    if (type < 2) { t.src = (e < NE) ? (F.in[type == 0 ? I_WG : I_WU] + (size_t)(l * NE + e) * D * FF) : (F.in[type == 0 ? I_SG : I_SU] + (size_t)l * D * FF);
        t.dst = F.ws + WS_W1 + (size_t)(l * NE1 + e) * 1024 * D; t.N = FF; t.ldt = D; t.k0 = (r >> 1) * 128; t.n0 = (r & 1) * 256; t.gu = 1 + type; t.scale = W1_SCALE;
    } else { t.src = (e < NE) ? (F.in[I_WD] + (size_t)(l * NE + e) * FF * D) : (F.in[I_SD] + (size_t)l * FF * D);
        t.dst = F.ws + WS_W2 + (size_t)(l * NE1 + e) * D * FF; t.N = D; t.ldt = FF; t.k0 = (r >> 3) * 128; t.n0 = (r & 7) * 256; t.gu = 0; t.scale = W2_SCALE; }
}
__device__ __forceinline__ void cvt_load(const CvtTile& t, f32x4 (&v)[16], int wave, int lane) {
    const float* p = t.src + (size_t)(t.k0 + wave * 16) * t.N + t.n0 + lane * 4;
#pragma unroll
    for (int i = 0; i < 16; ++i) v[i] = __builtin_nontemporal_load((const GAS f32x4*)(p + (size_t)i * t.N));
}
__device__ __forceinline__ void cvt_finish(const CvtTile& t, const f32x4 (&v)[16], LAS unsigned char* img, int wave, int lane) {
    constexpr int RS = 576;
    const float scale = t.scale;
#pragma unroll
    for (int i = 0; i < 16; ++i) { v2u w; w.x = cvt_pk_bf16(v[i].x * scale, v[i].y * scale); w.y = cvt_pk_bf16(v[i].z * scale, v[i].w * scale); *(LAS v2u*)(img + (wave * 16 + i) * RS + lane * 8) = w; }
    LDS_WAIT(); __builtin_amdgcn_s_barrier(); asm volatile("" ::: "memory");
    const int g = lane >> 4, cb = g & 1, kh = g >> 1, q = (lane >> 2) & 3, pp = lane & 3;
    const int ncol = 32 * wave + 16 * cb + (lane & 15);
    const LAS unsigned char* rb = img + (64 * kh + q) * RS + (32 * wave + 16 * cb + 4 * pp) * 2;
    const int c = t.n0 + ncol; int drow = c;
    if (t.gu == 1 || t.gu == 2) drow = (c >> 7) * 256 + (c & 127) + (t.gu == 2 ? 128 : 0);
    else if (t.gu == 3 && c < 2560) { const int d = c & 127; drow = (c & ~127) + qk_hcol(d); }
    unsigned char* orow = t.dst + (size_t)drow * t.ldt + t.k0 + 64 * kh;
#pragma unroll
    for (int j = 0; j < 4; ++j) { v2u tt[4];
#pragma unroll
        for (int h = 0; h < 4; ++h) tt[h] = __builtin_bit_cast(v2u, __builtin_amdgcn_ds_read_tr16_b64_v4i16((LAS v4i16_t*)(rb + (16 * j + 4 * h) * RS)));
        v4u o;
        o.x = pk4_fp8(bflo(tt[0].x), bfhi(tt[0].x), bflo(tt[0].y), bfhi(tt[0].y)); o.y = pk4_fp8(bflo(tt[1].x), bfhi(tt[1].x), bflo(tt[1].y), bfhi(tt[1].y));
        o.z = pk4_fp8(bflo(tt[2].x), bfhi(tt[2].x), bflo(tt[2].y), bfhi(tt[2].y)); o.w = pk4_fp8(bflo(tt[3].x), bfhi(tt[3].x), bflo(tt[3].y), bfhi(tt[3].y));
        *(GAS v4u*)(orow + 16 * j) = o; }
    LDS_WAIT(); __builtin_amdgcn_s_barrier(); asm volatile("" ::: "memory");
}
constexpr int CVT_PER_LAYER = NE1 * 3 * 32;
__device__ __forceinline__ void convert_experts(Frame& F, const int l, const int lo, const int hi, const int brank, const int nb) {
    LAS unsigned char* img = F.lds;
    int id = lo + brank; if (id >= hi) return;
    __syncthreads();
    CvtTile ca, cb; f32x4 va[16], vb[16];
    cvt_decode(F, l, id, ca); cvt_load(ca, va, F.wave, F.lane);
    for (;;) {
        const int id1 = id + nb; const bool m1 = id1 < hi;
        if (m1) { cvt_decode(F, l, id1, cb); cvt_load(cb, vb, F.wave, F.lane); }
        cvt_finish(ca, va, img, F.wave, F.lane);
        if (!m1) break;
        const int id2 = id1 + nb; const bool m2 = id2 < hi;
        if (m2) { cvt_decode(F, l, id2, ca); cvt_load(ca, va, F.wave, F.lane); }
        cvt_finish(cb, vb, img, F.wave, F.lane);
        if (!m2) break;
        id = id2;
    }
}

constexpr int NDENSE = 352;
constexpr int CVT_ALL = NDENSE + 2 * CVT_PER_LAYER;
__device__ __forceinline__ void cvt_decode_all(Frame& F, int id, CvtTile& t) { if (id < NDENSE) cvt_decode(F, 2, id, t); else if (id < NDENSE + CVT_PER_LAYER) cvt_decode(F, 0, id - NDENSE, t); else cvt_decode(F, 1, id - NDENSE - CVT_PER_LAYER, t); }
__device__ __forceinline__ int cvt_publish(volatile LAS unsigned* slot, unsigned tk, int tid) {
    if (tid == 0) *slot = tk;
    LDS_WAIT(); __builtin_amdgcn_s_barrier(); asm volatile("" ::: "memory");
    const int id = (int)*slot;
    LDS_WAIT(); __builtin_amdgcn_s_barrier(); asm volatile("" ::: "memory");
    return __builtin_amdgcn_readfirstlane(id);
}
__device__ __forceinline__ void cvt_signal(Frame& F, const int id) {
    if (id < 192) {
        asm volatile("s_waitcnt vmcnt(0)" ::: "memory"); __syncthreads();
        if (F.tid == 0) { __builtin_amdgcn_fence(__ATOMIC_RELEASE, "agent"); asm volatile("s_waitcnt vmcnt(0)" ::: "memory"); __hip_atomic_fetch_add((unsigned*)(F.ws + WS_CTL) + CW_QKV, 1u, RLX_AGENT); }
    }
}
__device__ __forceinline__ void convert_all_dynamic(Frame& F, unsigned* ctr) {
    LAS unsigned char* img = F.lds; volatile LAS unsigned* slot = (volatile LAS unsigned*)(F.lds + MISC_OFF + 64);
    __syncthreads();
    unsigned tk0 = 0u, tk1 = 0u;
    if (F.tid == 0) { tk0 = __hip_atomic_fetch_add(ctr, 1u, RLX_AGENT); tk1 = __hip_atomic_fetch_add(ctr, 1u, RLX_AGENT); }
    CvtTile ca, cb; f32x4 va[16], vb[16];
    int ida = cvt_publish(slot, tk0, F.tid); if (ida >= CVT_ALL) return;
    cvt_decode_all(F, ida, ca); cvt_load(ca, va, F.wave, F.lane);
    for (;;) {
        const int idb = cvt_publish(slot, tk1, F.tid); if (F.tid == 0) tk1 = __hip_atomic_fetch_add(ctr, 1u, RLX_AGENT);
        const bool mb = idb < CVT_ALL;
        if (mb) { cvt_decode_all(F, idb, cb); cvt_load(cb, vb, F.wave, F.lane); }
        cvt_finish(ca, va, img, F.wave, F.lane); cvt_signal(F, ida);
        if (!mb) break;
        ida = cvt_publish(slot, tk1, F.tid); if (F.tid == 0) tk1 = __hip_atomic_fetch_add(ctr, 1u, RLX_AGENT);
        const bool ma = ida < CVT_ALL;
        if (ma) { cvt_decode_all(F, ida, ca); cvt_load(ca, va, F.wave, F.lane); }
        cvt_finish(cb, vb, img, F.wave, F.lane); cvt_signal(F, idb);
        if (!ma) break;
    }
}

__device__ __forceinline__ void p0_prologue(Frame& F) {
    const int gw = F.vcu * NWAVES + F.wave, NGW = F.G * NWAVES;
    const int gtid = gw * 64 + F.lane, NGT = NGW * 64;
    unsigned char* ws = F.ws;
    __syncthreads();
    if (F.vcu < 96) {
        const int l = F.vcu / 48, jg = F.vcu % 48, j0 = jg * 256;
        LAS float* sil = (LAS float*)F.lds;
        LAS float* red = (LAS float*)(F.lds + 24576);
        for (int i = F.tid; i < 3 * D; i += NTHR) { const int r = i / D, k = i % D; const float v = (r < 2) ? F.in[I_C][r * D + k] : F.in[I_CCTX][k]; sil[i] = v * fast_sigmoid(v); }
        __syncthreads();
        const float* wa = F.in[I_WADA] + (size_t)l * D * (6 * D) + j0 + F.lane * 4;
        f32x4 a0 = {0.f, 0.f, 0.f, 0.f}, a1 = a0, a2 = a0;
        const int kb = F.wave * 256;
#pragma unroll 8
        for (int k = 0; k < 256; ++k) { const f32x4 w = *(const GAS f32x4*)(wa + (size_t)(kb + k) * (6 * D)); const float s0 = sil[kb + k], s1 = sil[D + kb + k], s2 = sil[2 * D + kb + k]; a0 += w * s0; a1 += w * s1; a2 += w * s2; }
        *(LAS f32x4*)(red + (F.wave * 3 + 0) * 256 + F.lane * 4) = a0; *(LAS f32x4*)(red + (F.wave * 3 + 1) * 256 + F.lane * 4) = a1; *(LAS f32x4*)(red + (F.wave * 3 + 2) * 256 + F.lane * 4) = a2;
        __syncthreads();
        for (int i = F.tid; i < 768; i += NTHR) { const int r = i / 256, c = i % 256; float s = F.in[I_BADA][l * 6 * D + j0 + c];
#pragma unroll
            for (int w = 0; w < 8; ++w) s += red[(w * 3 + r) * 256 + c];
            ((float*)(ws + WS_MOD))[(size_t)(l * 3 + r) * 6 * D + j0 + c] = s; }
        __syncthreads();
    }
    for (int l = 0; l < 2; ++l) {
        v4u* t4 = (v4u*)(ws + WS_TOK + l * LIST_L); v4u* d4 = (v4u*)(ws + WS_DST + l * LIST_L);
        for (int i = gtid; i < NE * ECAP / 4; i += NGT) { t4[i] = (v4u){0u, 0u, 0u, 0u}; d4[i] = (v4u){0u, 0u, 0u, 0u}; }
        unsigned* ts = (unsigned*)(ws + WS_TOK + l * LIST_L) + NE * ECAP; unsigned* ds = (unsigned*)(ws + WS_DST + l * LIST_L) + NE * ECAP; float* gs = (float*)(ws + WS_GW + l * LIST_L) + NE * ECAP;
        for (int i = gtid; i < M; i += NGT) { ts[i] = (unsigned)i; ds[i] = (unsigned)(i * 9 + 8 + 1); gs[i] = 1.0f; }
    }
    for (int i = gtid; i < 128 * 32; i += NGT) { const int p = i >> 5, f = i & 31; const float inv = powf(10000.0f, -(float)f / 32.0f); const float a = (float)p * inv;
        ((float*)(ws + WS_ROPE))[i] = cosf(a); ((float*)(ws + WS_ROPE))[4096 + i] = sinf(a); }
    for (int i = gtid; i < 2 * NE * D; i += NGT) { const int l = i / (NE * D), r = i % (NE * D), e = r / D, k = r % D; const float w = F.in[I_WR][((size_t)l * D + k) * NE + e];
        const unsigned hi = f2bf(w); const float lo = w - __uint_as_float(hi << 16);
        bf16* wr = (bf16*)(ws + WS_WR) + (size_t)l * 2 * NE * D; wr[e * D + k] = (bf16)hi; wr[NE * D + e * D + k] = (bf16)f2bf(lo); }
    LAS unsigned char* scr = F.lds + F.wave * 12288;
    __syncthreads();
    asm volatile("s_waitcnt vmcnt(0)" ::: "memory"); __syncthreads();
    if (F.tid == 0) { __builtin_amdgcn_fence(__ATOMIC_RELEASE, "agent"); asm volatile("s_waitcnt vmcnt(0)" ::: "memory"); __hip_atomic_fetch_add((unsigned*)(ws + WS_CTL) + CW_PRO, 1u, RLX_AGENT); }
}

struct ModVec { f32x4 a[8], b[8]; };
__device__ __forceinline__ void load_modvec(ModVec& mv, const float* gnorm, const float* shift, const float* scale, int lane) {
#pragma unroll
    for (int jj = 0; jj < 8; ++jj) { const int col = 4 * lane + 256 * jj;
        const f32x4 g = *(const GAS f32x4*)(gnorm + col), sc = *(const GAS f32x4*)(scale + col); mv.a[jj] = g * (sc + 1.0f); mv.b[jj] = *(const GAS f32x4*)(shift + col); }
}
__device__ __forceinline__ void norm_mod_store(const f32x4 (&v)[8], const ModVec& mv, bf16* orow, int lane) {
    float ss = 0.f;
#pragma unroll
    for (int jj = 0; jj < 8; ++jj) ss += (v[jj].x * v[jj].x + v[jj].y * v[jj].y) + (v[jj].z * v[jj].z + v[jj].w * v[jj].w);
    const float rstd = 1.0f / sqrtf(wave_sum(ss) * (1.0f / D) + EPS);
#pragma unroll
    for (int jj = 0; jj < 8; ++jj) { const f32x4 o = v[jj] * rstd * mv.a[jj] + mv.b[jj]; v2u w; w.x = cvt_pk_bf16(o.x, o.y); w.y = cvt_pk_bf16(o.z, o.w);
        *(GAS v2u*)(orow + 4 * lane + 256 * jj) = w; }
}
__device__ __forceinline__ void norm_mod_store_fp8(const f32x4 (&v)[8], const ModVec& mv, unsigned char* orow, int lane, float scale) {
    float ss = 0.f;
#pragma unroll
    for (int jj = 0; jj < 8; ++jj) ss += (v[jj].x * v[jj].x + v[jj].y * v[jj].y) + (v[jj].z * v[jj].z + v[jj].w * v[jj].w);
    const float rstd = 1.0f / sqrtf(wave_sum(ss) * (1.0f / D) + EPS);
#pragma unroll
    for (int jj = 0; jj < 8; ++jj) { const f32x4 o = (v[jj] * rstd * mv.a[jj] + mv.b[jj]) * scale; *(GAS unsigned*)(orow + 4 * lane + 256 * jj) = pk4_fp8(o.x, o.y, o.z, o.w); }
}
__device__ __forceinline__ const float* modp(Frame& F, int l, int r, int which) { return (const float*)(F.ws + WS_MOD) + (size_t)(l * 3 + r) * 6 * D + which * D; }

__device__ __forceinline__ void p1_norm1(Frame& F) {
    const int gw = F.vcu * NWAVES + F.wave, NGW = F.G * NWAVES;
    unsigned char* HN = F.ws + WS_ACTA;
    for (int rb = gw; rb < M / 8; rb += NGW) {
        const int row0 = rb * 8, b = row0 / S;
        ModVec mv; load_modvec(mv, F.in[I_G1], modp(F, 0, b, 0), modp(F, 0, b, 1), F.lane);
        for (int j = 0; j < 8; ++j) { const int row = row0 + j; f32x4 v[8];
#pragma unroll
            for (int jj = 0; jj < 8; ++jj) v[jj] = *(const GAS f32x4*)(F.in[I_X] + (size_t)row * D + 4 * F.lane + 256 * jj);
            norm_mod_store_fp8(v, mv, HN + (size_t)row * D, F.lane, H2_SCALE); }
    }
}

using pg8::GUnit;
struct SchedQK { const char* A; const char* B; int G, c, lim;
    __device__ __forceinline__ bool next(int i, GUnit& u) const { const int L = i * G + c; if (L >= lim) return false; int pm, pn; if (L < 640) { pm = L / 10; pn = L % 10; } else { pm = 64 + (L - 640) / 2; pn = 8 + (L - 640) % 2; }
        u.A = A + (size_t)pm * 256 * D; u.B = B + (size_t)pn * 256 * D; u.gtab = nullptr; u.e0 = nullptr; u.e1 = nullptr; u.i0 = pm; u.i1 = pn; u.i2 = 0; u.i3 = 0; return true; } };
struct EpiQK { static constexpr bool ETAB = false; static constexpr bool P16 = true; static constexpr bool PERM = true; bf16* Q; bf16* Kb; const float* gq; const float* gk; const float* rope; LAS float* xch;
    __device__ __forceinline__ void operator()(const f32x4 (&acc)[2][2][4][2], const GUnit& u, int wr, int wc, int fr, int fq, const LAS unsigned* et) const {
        const int pm = u.i0, pn = u.i1; bf16* base; int ldc, colt; const float* g; float scale;
        if (pn < 8) { base = Q; ldc = D; colt = pn * 256; g = gq; scale = QSCALE; } else { base = Kb; ldc = 512; colt = (pn - 8) * 256; g = gk; scale = 1.0f; }
        const int axis = wc & 1, rloc0 = wr * 64 + fr;
#pragma unroll
        for (int ai = 0; ai < 2; ++ai)
#pragma unroll
            for (int m = 0; m < 4; ++m) { float ss = 0.f;
#pragma unroll
                for (int bj = 0; bj < 2; ++bj)
#pragma unroll
                    for (int n = 0; n < 2; ++n) { const f32x4 x = acc[ai][bj][m][n]; ss += (x.x * x.x + x.y * x.y) + (x.z * x.z + x.w * x.w); }
                ss += __shfl_xor(ss, 16); ss += __shfl_xor(ss, 32);
                if (fq == 0) xch[(rloc0 + ai * 128 + m * 16) * 4 + wc] = ss; }
        const f32x4 g1a = *(const GAS f32x4*)(g + axis * 64 + 8 * fq), g1b = *(const GAS f32x4*)(g + axis * 64 + 8 * fq + 4), g2a = *(const GAS f32x4*)(g + axis * 64 + 32 + 8 * fq), g2b = *(const GAS f32x4*)(g + axis * 64 + 32 + 8 * fq + 4);
        asm volatile("s_waitcnt lgkmcnt(0)" ::: "memory"); __builtin_amdgcn_s_barrier(); asm volatile("" ::: "memory");
        const int row0 = pm * 256 + rloc0, col0 = colt + wc * 64 + 16 * fq; const bool lat = pm < 64;
#pragma unroll
        for (int ai = 0; ai < 2; ++ai)
#pragma unroll
            for (int m = 0; m < 4; ++m) { const int rl = rloc0 + ai * 128 + m * 16, row = row0 + ai * 128 + m * 16;
                const float r = 1.0f / sqrtf((xch[rl * 4 + wc] + xch[rl * 4 + (wc ^ 1)]) * (1.0f / HD) + EPS);
                f32x4 ca = {1.f, 1.f, 1.f, 1.f}, cb = ca, sa = {0.f, 0.f, 0.f, 0.f}, sb = sa;
                if (lat) { const int sq = row & (S - 1), pos = axis ? (sq & 63) : (sq >> 6); const float* rp = rope + pos * 32 + 8 * fq;
                    ca = *(const GAS f32x4*)rp; cb = *(const GAS f32x4*)(rp + 4); sa = *(const GAS f32x4*)(rp + 4096); sb = *(const GAS f32x4*)(rp + 4100); }
                const f32x4 y1a = acc[ai][0][m][0] * r * g1a, y1b = acc[ai][0][m][1] * r * g1b, y2a = acc[ai][1][m][0] * r * g2a, y2b = acc[ai][1][m][1] * r * g2b;
                const f32x4 o1a = (y1a * ca - y2a * sa) * scale, o1b = (y1b * cb - y2b * sb) * scale, o2a = (y2a * ca + y1a * sa) * scale, o2b = (y2b * cb + y1b * sb) * scale;
                bf16* rowp = base + (size_t)row * ldc + col0;
                v4u w; w.x = cvt_pk_bf16(o1a.x, o1a.y); w.y = cvt_pk_bf16(o1a.z, o1a.w); w.z = cvt_pk_bf16(o1b.x, o1b.y); w.w = cvt_pk_bf16(o1b.z, o1b.w); *(GAS v4u*)rowp = w;
                w.x = cvt_pk_bf16(o2a.x, o2a.y); w.y = cvt_pk_bf16(o2a.z, o2a.w); w.z = cvt_pk_bf16(o2b.x, o2b.y); w.w = cvt_pk_bf16(o2b.z, o2b.w); *(GAS v4u*)(rowp + 8) = w; }
    } };
struct SchedVT { const char* A; const char* B; int G, c, lim;
    __device__ __forceinline__ bool next(int i, GUnit& u) const { const int L = i * G + c; if (L >= lim) return false; const int pmv = L % 2, pnv = L / 2;
        u.A = A + (size_t)pmv * 256 * D; u.B = B + (size_t)pnv * 256 * D; u.gtab = nullptr; u.e0 = nullptr; u.e1 = nullptr; u.i0 = pmv; u.i1 = pnv; u.i2 = 0; u.i3 = 0; return true; } };
struct EpiVT { static constexpr bool ETAB = false; static constexpr bool P16 = true; static constexpr bool PERM = true; bf16* Vt;
    __device__ __forceinline__ void operator()(const f32x4 (&acc)[2][2][4][2], const GUnit& u, int wr, int wc, int fr, int fq, const LAS unsigned* et) const {
        const int row0 = u.i0 * 256 + wr * 64 + fr, col0 = u.i1 * 256 + wc * 64 + 16 * fq;
#pragma unroll
        for (int ai = 0; ai < 2; ++ai)
#pragma unroll
            for (int m = 0; m < 4; ++m) { bf16* rowp = Vt + (size_t)(row0 + ai * 128 + m * 16) * MT + col0;
#pragma unroll
                for (int h = 0; h < 2; ++h) { const f32x4 v0 = acc[ai][0][m][h], v1 = acc[ai][1][m][h]; v4u w; w.x = cvt_pk_bf16(v0[0], v0[1]); w.y = cvt_pk_bf16(v0[2], v0[3]); w.z = cvt_pk_bf16(v1[0], v1[1]); w.w = cvt_pk_bf16(v1[2], v1[3]);
                    *(GAS v4u*)(rowp + h * 8) = w; } }
    } };
struct SchedRes { const char* A; const char* B; int G, c, mode;
    __device__ __forceinline__ bool next(int i, GUnit& u) const { const int L = i * G + c; if (L >= 512) return false; const int pm = L / 8, pn = L % 8;
        if (mode == 0) { u.A = A + (size_t)pm * 256 * D; u.B = B + (size_t)pn * 256 * D; }
        else { const int g = pn / 2, p2 = pn % 2; u.A = A + (size_t)pm * 256 * D + (size_t)g * 512; u.B = B + ((size_t)g * 512 + p2 * 256) * 512; }
        u.gtab = nullptr; u.e0 = nullptr; u.e1 = nullptr; u.i0 = pm; u.i1 = pn; u.i2 = 0; u.i3 = 0; return true; } };
template <bool BASE_BF16> struct EpiRes { static constexpr bool ETAB = false; static constexpr bool P16 = true; static constexpr bool PERM = true; const void* base; bf16* out; const float* gate0; const float* gate1; const float* cs; float* ssq;
    __device__ __forceinline__ void operator()(const f32x4 (&acc)[2][2][4][2], const GUnit& u, int wr, int wc, int fr, int fq, const LAS unsigned* et) const {
        const int pm = u.i0, pn = u.i1; const float* gate = (pm < 32) ? gate0 : gate1;
        const int col0 = pn * 256 + wc * 64 + 16 * fq;
        f32x4 gv[2][2];
#pragma unroll
        for (int bj = 0; bj < 2; ++bj)
#pragma unroll
            for (int n = 0; n < 2; ++n) { gv[bj][n] = *(const GAS f32x4*)(gate + col0 + bj * 8 + n * 4); if (cs) gv[bj][n] = gv[bj][n] * *(const GAS f32x4*)(cs + col0 + bj * 8 + n * 4); }
        float sq[2][4];
#pragma unroll
        for (int ai = 0; ai < 2; ++ai) {
            f32x4 b[4][2][2];
#pragma unroll
            for (int m = 0; m < 4; ++m) { const size_t off = (size_t)(pm * 256 + ai * 128 + wr * 64 + m * 16 + fr) * D + col0;
#pragma unroll
                for (int bj = 0; bj < 2; ++bj) {
                    if constexpr (BASE_BF16) { const v4u r = *(const GAS v4u*)((const bf16*)base + off + bj * 8); b[m][bj][0] = __builtin_bit_cast(f32x4, r); }
                    else { b[m][bj][0] = *(const GAS f32x4*)((const float*)base + off + bj * 8); b[m][bj][1] = *(const GAS f32x4*)((const float*)base + off + bj * 8 + 4); } } }
#pragma unroll
            for (int m = 0; m < 4; ++m) { const size_t off = (size_t)(pm * 256 + ai * 128 + wr * 64 + m * 16 + fr) * D + col0; float s = 0.f;
#pragma unroll
                for (int bj = 0; bj < 2; ++bj) { f32x4 b0, b1;
                    if constexpr (BASE_BF16) { const v4u r = __builtin_bit_cast(v4u, b[m][bj][0]); b0 = (f32x4){bflo(r.x), bfhi(r.x), bflo(r.y), bfhi(r.y)}; b1 = (f32x4){bflo(r.z), bfhi(r.z), bflo(r.w), bfhi(r.w)}; }
                    else { b0 = b[m][bj][0]; b1 = b[m][bj][1]; }
                    const f32x4 o0 = b0 + gv[bj][0] * acc[ai][bj][m][0], o1 = b1 + gv[bj][1] * acc[ai][bj][m][1];
                    v4u w; w.x = cvt_pk_bf16(o0.x, o0.y); w.y = cvt_pk_bf16(o0.z, o0.w); w.z = cvt_pk_bf16(o1.x, o1.y); w.w = cvt_pk_bf16(o1.z, o1.w); *(GAS v4u*)(out + off + bj * 8) = w;
                    s += ((o0.x * o0.x + o0.y * o0.y) + (o0.z * o0.z + o0.w * o0.w)) + ((o1.x * o1.x + o1.y * o1.y) + (o1.z * o1.z + o1.w * o1.w)); }
                s += __shfl_xor(s, 16); s += __shfl_xor(s, 32); sq[ai][m] = s; } }
        if (fq == 0) {
#pragma unroll
            for (int ai = 0; ai < 2; ++ai)
#pragma unroll
                for (int m = 0; m < 4; ++m) ssq[(size_t)(pm * 256 + ai * 128 + wr * 64 + m * 16 + fr) * 32 + pn * 4 + wc] = sq[ai][m]; }
    } };
__device__ __forceinline__ int moe_expert_of(const LAS int* toff, int ti, int lane) {
    asm volatile("" : "+v"(lane));
    const int v = toff[lane + 1]; const unsigned long long bal = __ballot(v <= ti); return (int)__popcll(bal); }
struct SchedMoe1 { const char* A; const char* W1; const unsigned* tok; const LAS int* toff; int G, c, lane;
    __device__ __forceinline__ bool next(int i, GUnit& u) const { const int L = i * G + c, ti = L / 4, pn = L % 4; if (ti >= __builtin_amdgcn_readfirstlane(toff[65])) return false;
        const int e = __builtin_amdgcn_readfirstlane(moe_expert_of(toff, ti, lane)), tl = ti - __builtin_amdgcn_readfirstlane(toff[e]);
        u.A = A; u.B = W1 + ((size_t)e * 1024 + pn * 256) * D; u.gtab = tok + (size_t)e * ECAP + tl * 256; u.e0 = nullptr; u.e1 = nullptr; u.i0 = ti; u.i1 = pn; u.i2 = e; u.i3 = tl; return true; } };
struct EpiMoe1 { static constexpr bool ETAB = false; static constexpr bool P16 = false; static constexpr bool PERM = true; unsigned char* HID;
    __device__ __forceinline__ void operator()(const f32x4 (&acc)[2][2][4][2], const GUnit& u, int wr, int wc, int fr, int fq, const LAS unsigned* et) const {
        const int row0 = u.i0 * 256 + wr * 64 + fr, col0 = u.i1 * 128 + wc * 32 + 8 * fq;
#pragma unroll
        for (int ai = 0; ai < 2; ++ai)
#pragma unroll
            for (int m = 0; m < 4; ++m) { float h[8];
#pragma unroll
                for (int n = 0; n < 2; ++n)
#pragma unroll
                    for (int j = 0; j < 4; ++j) { const float g = acc[ai][0][m][n][j], up = acc[ai][1][m][n][j]; h[n * 4 + j] = g * fast_sigmoid(g) * up * HID_SCALE; }
                v2u w; w.x = pk4_fp8(h[0], h[1], h[2], h[3]); w.y = pk4_fp8(h[4], h[5], h[6], h[7]);
                *(GAS v2u*)(HID + (size_t)(row0 + ai * 128 + m * 16) * FF + col0) = w; }
    } };
struct SchedMoe2 { const char* A; const char* W2; const unsigned* dst; const float* gw; const LAS int* toff; int G, c, lane;
    __device__ __forceinline__ bool next(int i, GUnit& u) const { const int TT = __builtin_amdgcn_readfirstlane(toff[64]); const int R = (TT * 8 + G - 1) / G; if (i >= R) return false;
        const int rr = (i < R - 1) ? (R - 2 - i) : (R - 1); const int L = rr * G + c, ti = L / 8, pn = L % 8; if (ti >= TT) return false;
        const int e = __builtin_amdgcn_readfirstlane(moe_expert_of(toff, ti, lane)), tl = ti - __builtin_amdgcn_readfirstlane(toff[e]);
        u.A = A + (size_t)ti * 256 * FF; u.B = W2 + ((size_t)e * D + pn * 256) * FF; u.gtab = nullptr; u.e0 = dst + (size_t)e * ECAP + tl * 256; u.e1 = (const unsigned*)(gw + (size_t)e * ECAP + tl * 256); u.i0 = ti; u.i1 = pn; u.i2 = e; u.i3 = tl; return true; } };
struct EpiMoe2 { static constexpr bool ETAB = true; static constexpr bool P16 = true; static constexpr bool PERM = true; unsigned char* Y;
    __device__ __forceinline__ void operator()(const f32x4 (&acc)[2][2][4][2], const GUnit& u, int wr, int wc, int fr, int fq, const LAS unsigned* et) const {
        const int pn = u.i1; int r0 = wr * 64 + fr; asm volatile("" : "+v"(r0)); const int col0 = pn * 256 + wc * 64 + 16 * fq;
#pragma unroll
        for (int ai = 0; ai < 2; ++ai)
#pragma unroll
            for (int m = 0; m < 4; ++m) { const int r = r0 + ai * 128 + m * 16; const unsigned dv = et[r]; const float g = __uint_as_float(et[256 + r]) * Y_SCALE; const unsigned d1 = dv - 1u;
                const unsigned off = (dv ? (((d1 >> 4) * 8u + (unsigned)pn) * 8u + (d1 & 15u)) * 256u : (unsigned)M * 16384u + (unsigned)pn * 256u) + (unsigned)(wc * 64 + 16 * fq); v4u w;
                { const f32x4 v0 = acc[ai][0][m][0] * g, v1 = acc[ai][0][m][1] * g; w.x = pk4_fp8(v0[0], v0[1], v0[2], v0[3]); w.y = pk4_fp8(v1[0], v1[1], v1[2], v1[3]); }
                { const f32x4 v0 = acc[ai][1][m][0] * g, v1 = acc[ai][1][m][1] * g; w.z = pk4_fp8(v0[0], v0[1], v0[2], v0[3]); w.w = pk4_fp8(v1[0], v1[1], v1[2], v1[3]); }
                *(GAS v4u*)(Y + off) = w; }
    } };

__device__ __forceinline__ v4u qk_fix8(const v4u raw, const f32x4 g0, const f32x4 g1, const f32x4 c0, const f32x4 c1, const f32x4 s0, const f32x4 s1, int half, float scale) {
    f32x4 x0 = {bflo(raw.x), bfhi(raw.x), bflo(raw.y), bfhi(raw.y)}, x1 = {bflo(raw.z), bfhi(raw.z), bflo(raw.w), bfhi(raw.w)};
    float ss = ((x0.x * x0.x + x0.y * x0.y) + (x0.z * x0.z + x0.w * x0.w)) + ((x1.x * x1.x + x1.y * x1.y) + (x1.z * x1.z + x1.w * x1.w));
#pragma unroll
    for (int o = 1; o < 16; o <<= 1) ss += __shfl_xor(ss, o);
    const float r = 1.0f / sqrtf(ss * (1.0f / HD) + EPS);
    const f32x4 y0 = x0 * r * g0, y1 = x1 * r * g1;
    f32x4 p0, p1;
    p0.x = __shfl_xor(y0.x, 4); p0.y = __shfl_xor(y0.y, 4); p0.z = __shfl_xor(y0.z, 4); p0.w = __shfl_xor(y0.w, 4);
    p1.x = __shfl_xor(y1.x, 4); p1.y = __shfl_xor(y1.y, 4); p1.z = __shfl_xor(y1.z, 4); p1.w = __shfl_xor(y1.w, 4);
    const f32x4 o0 = (half ? (y0 * c0 + p0 * s0) : (y0 * c0 - p0 * s0)) * scale, o1 = (half ? (y1 * c1 + p1 * s1) : (y1 * c1 - p1 * s1)) * scale;
    v4u w; w.x = cvt_pk_bf16(o0.x, o0.y); w.y = cvt_pk_bf16(o0.z, o0.w); w.z = cvt_pk_bf16(o1.x, o1.y); w.w = cvt_pk_bf16(o1.z, o1.w); return w;
}
__device__ __forceinline__ void p3_qk_finalize(Frame& F) {
    const int gw = F.vcu * NWAVES + F.wave, NGW = F.G * NWAVES;
    const int c = F.lane & 15, hq = F.lane >> 4, axis = c >> 3, half = (c >> 2) & 1, f0 = 8 * (c & 3);
    const float* ropec = (const float*)(F.ws + WS_ROPE); const float* ropes = ropec + 4096;
    const f32x4 gq0 = *(const GAS f32x4*)(F.in[I_GQ] + 8 * c), gq1 = *(const GAS f32x4*)(F.in[I_GQ] + 8 * c + 4), gk0 = *(const GAS f32x4*)(F.in[I_GK] + 8 * c), gk1 = *(const GAS f32x4*)(F.in[I_GK] + 8 * c + 4);
    bf16* Q = (bf16*)(F.ws + WS_ACTB); bf16* Kb = (bf16*)(F.ws + WS_KB);
    for (int row = gw; row < MT; row += NGW) {
        const bool lat = row < M; const int s = row & (S - 1); const int pos = axis ? (s & 63) : (s >> 6);
        f32x4 c0 = {1.f, 1.f, 1.f, 1.f}, c1 = c0, s0 = {0.f, 0.f, 0.f, 0.f}, s1 = s0;
        bf16* kp = Kb + (size_t)row * 512 + hq * HD + 8 * c;
        const v4u kr = *(const GAS v4u*)kp;
        if (lat) {
            c0 = *(const GAS f32x4*)(ropec + pos * 32 + f0); c1 = *(const GAS f32x4*)(ropec + pos * 32 + f0 + 4); s0 = *(const GAS f32x4*)(ropes + pos * 32 + f0); s1 = *(const GAS f32x4*)(ropes + pos * 32 + f0 + 4);
            bf16* qp = Q + (size_t)row * D + hq * HD + 8 * c;
            v4u qr[4];
#pragma unroll
            for (int it = 0; it < 4; ++it) qr[it] = *(const GAS v4u*)(qp + it * 512);
#pragma unroll
            for (int it = 0; it < 4; ++it) qr[it] = qk_fix8(qr[it], gq0, gq1, c0, c1, s0, s1, half, QSCALE);
#pragma unroll
            for (int it = 0; it < 4; ++it) *(GAS v4u*)(qp + it * 512) = qr[it];
        }
        *(GAS v4u*)kp = qk_fix8(kr, gk0, gk1, c0, c1, s0, s1, half, 1.0f);
    }
}

#define ATT_PROBE_FAKE -1
#define ATT_THR 8.0f
#define ATT_PROBE_FAKE2 -1
#define ATT_PROBE_SPLIT ((wid & 1) == 0)
#define ATT_PROBE_QK 0
#define ATT_PROBE_PV 0
__device__ __forceinline__ void p4_attention(Frame& F) {
    const bf16* Q = (const bf16*)(F.ws + WS_ACTB); const bf16* Kb = (const bf16*)(F.ws + WS_KB); const bf16* Vt = (const bf16*)(F.ws + WS_VT); unsigned char* O = F.ws + WS_ACTC;
    LAS unsigned char* lds = F.lds;
    const int wid = F.wave;
    for (int u = F.vcu; u < 1024; u += F.G) {
        int tq = F.tid; asm volatile("" : "+v"(tq));
        const int r32 = tq & 31, hi = (tq >> 5) & 1;
        const unsigned voffK = (unsigned)(((tq >> 4) * 512 + (((tq & 15) ^ ((tq >> 4) & 15)) * 8)) * 2), voffV = (unsigned)(((tq >> 3) * MT + (((tq & 7) ^ ((tq >> 4) & 7)) * 8)) * 2);
        const int b = u >> 9, rem = u & 511, n = rem >> 3, kvh = (rem >> 1) & 3, hp = rem & 1;
        const int head = kvh * 4 + hp * 2 + ((wid & 3) >> 1);
        const int qloc0 = n * 128 + ((wid & 1) + 2 * (wid >> 2)) * 32;
        const size_t qrow = (size_t)b * S + qloc0 + r32;
        bf16x8 qf[8];
#pragma unroll
        for (int ds = 0; ds < 8; ++ds) qf[ds] = *(const GAS bf16x8*)(Q + qrow * D + head * HD + 16 * ds + 8 * hi);
        const int kstart = (n == 0) ? 0 : n * 128 - 128, kend = (n == 63) ? S : n * 128 + 256, nloc = (kend - kstart) >> 6, NT = nloc + 4;
        float mrun = F.in[I_SINK][head] * 1.4426950408889634f, lrun = (hi == 0) ? 1.0f : 0.0f;
        f32x16 o[4];
#pragma unroll
        for (int db = 0; db < 4; ++db)
#pragma unroll
            for (int r = 0; r < 16; ++r) o[db][r] = 0.f;
#define ATT_DMA(t) do { const int _t = (t); const int _kr0 = (_t < nloc) ? (b * S + kstart + 64 * _t) : (M + b * CTX + 64 * (_t - nloc)); const int _sl = (_t & 3) * 32768; \
            _Pragma("unroll") for (int _i = 0; _i < 2; ++_i) { \
                { const char* _gb = (const char*)(Kb + (size_t)(_kr0 + 32 * _i) * 512 + kvh * HD); asm volatile("" : "+s"(_gb)); __builtin_amdgcn_global_load_lds((const unsigned*)(_gb + voffK), (LAS unsigned*)(lds + _sl + (_i * 512 + wid * 64) * 16), 16, 0, 0); } \
                { const char* _gb = (const char*)(Vt + (size_t)(kvh * HD + 64 * _i) * MT + _kr0); asm volatile("" : "+s"(_gb)); __builtin_amdgcn_global_load_lds((const unsigned*)(_gb + voffV), (LAS unsigned*)(lds + _sl + 16384 + (_i * 512 + wid * 64) * 16), 16, 0, 0); } } } while (0)
#define ATT_NEED(t) (((t) >= nloc) || ((kstart + 64 * (t) + 63 >= qloc0 - 128) && (kstart + 64 * (t) <= qloc0 + 31 + 128)))
#define ATT_KREAD(t) do { int _kbt = lbK + ((t) & 3) * 32768; asm volatile("" : "+v"(_kbt)); \
            _Pragma("unroll") for (int kb = 0; kb < 2; ++kb) _Pragma("unroll") for (int ds = 0; ds < 8; ++ds) kf[kb * 8 + ds] = *(const LAS bf16x8*)(lds + ((_kbt ^ (ds << 5)) + kb * 8192)); } while (0)
        const int lbK = r32 * 256 + (((r32 & 15) ^ hi) << 4);
        const int lbV = r32 * 128 + ((((r32 >> 1) & 7) ^ hi) << 4);
        auto pass = [&](auto FLc) __attribute__((always_inline)) {
        constexpr int FL = decltype(FLc)::value;
        constexpr bool real_ = (FL & 128) != 0;
        asm volatile("s_waitcnt vmcnt(0)" ::: "memory"); __builtin_amdgcn_s_barrier();
        if (real_) { ATT_DMA(0); ATT_DMA(1); ATT_DMA(2); }
        asm volatile("s_waitcnt vmcnt(8)" ::: "memory"); __builtin_amdgcn_s_barrier(); asm volatile("" ::: "memory");
        bf16x8 kf[16];
        if constexpr (FL & 16) { ATT_KREAD(0); } else { _Pragma("unroll") for (int i = 0; i < 16; ++i) asm volatile("" : "=v"(kf[i])); }
#pragma unroll 1
        for (int t = 0; t < NT; ++t) {
            if (t + 2 < NT) asm volatile("s_waitcnt vmcnt(4)" ::: "memory"); else asm volatile("s_waitcnt vmcnt(0)" ::: "memory");
            if constexpr (FL & 64) __builtin_amdgcn_s_barrier();
            asm volatile("" ::: "memory");
            if (real_ && t + 3 < NT) ATT_DMA(t + 3);
            if (ATT_NEED(t)) {
            f32x16 p[2];
            if constexpr (FL & 1) {
#pragma unroll
                for (int kb = 0; kb < 2; ++kb) {
#pragma unroll
                    for (int r = 0; r < 16; ++r) p[kb][r] = 0.f;
                }
#pragma unroll
                for (int ds = 0; ds < 8; ++ds)
#pragma unroll
                    for (int kb = 0; kb < 2; ++kb) p[kb] = __builtin_amdgcn_mfma_f32_32x32x16_bf16(kf[kb * 8 + ds], qf[ds], p[kb], 0, 0, 0);
            } else {
#pragma unroll
                for (int i = 0; i < 16; ++i) asm volatile("" :: "v"(kf[i]));
#pragma unroll
                for (int kb = 0; kb < 2; ++kb) asm volatile("" : "=v"(p[kb]));
            }
            __builtin_amdgcn_sched_barrier(0);
            bf16x8 vf[4][4];
            if constexpr (FL & 2) {   int vbt = lbV + (t & 3) * 32768 + 16384; asm volatile("" : "+v"(vbt));
#pragma unroll
                for (int db = 0; db < 4; ++db)
#pragma unroll
                    for (int g = 0; g < 4; ++g) vf[db][g] = *(const LAS bf16x8*)(lds + ((vbt ^ (g << 5)) + db * 4096));
            } else {
#pragma unroll
                for (int db = 0; db < 4; ++db)
#pragma unroll
                    for (int g = 0; g < 4; ++g) asm volatile("" : "=v"(vf[db][g]));
            }
            __builtin_amdgcn_sched_barrier(0);
            if constexpr (FL & 32) {
                const int kloc0 = kstart + 64 * t;
                if (t < nloc && !((kloc0 >= qloc0 + 31 - 128) && (kloc0 + 63 <= qloc0 + 128))) {
                    const int q = qloc0 + r32;
#pragma unroll
                    for (int kb = 0; kb < 2; ++kb)
#pragma unroll
                        for (int r = 0; r < 16; ++r) { const int key = kloc0 + 32 * kb + (r & 3) + 8 * (r >> 2) + 4 * hi; const int dlt = key - q; if (dlt > 128 || dlt < -128) p[kb][r] = -INFINITY; }
                }
            }
            bf16x8 pb[2][2];
            if constexpr (FL & 4) {
                float mq[4];
#pragma unroll
                for (int i = 0; i < 4; ++i) { const int kb = i >> 1, r0 = 8 * (i & 1);
                    float m = fmaxf(fmaxf(p[kb][r0], p[kb][r0 + 1]), p[kb][r0 + 2]); m = fmaxf(fmaxf(m, p[kb][r0 + 3]), p[kb][r0 + 4]); m = fmaxf(fmaxf(m, p[kb][r0 + 5]), p[kb][r0 + 6]); mq[i] = fmaxf(m, p[kb][r0 + 7]); }
                float mx = fmaxf(fmaxf(fmaxf(mq[0], mq[1]), mq[2]), mq[3]);
                float mb = mx; asm volatile("s_nop 1\n\tv_permlane32_swap_b32 %0, %1" : "+v"(mx), "+v"(mb));
                mx = fmaxf(mx, mb);
                const bool grow = mx > mrun + ATT_THR;
                if (__builtin_amdgcn_ballot_w64(grow) != 0ull) {
                    const float mnew = grow ? mx : mrun, alpha = __builtin_amdgcn_exp2f(mrun - mnew);
                    mrun = mnew; lrun *= alpha;
#pragma unroll
                    for (int db = 0; db < 4; ++db)
#pragma unroll
                        for (int r = 0; r < 16; r += 2) { f32x2 d = {o[db][r], o[db][r + 1]}; d *= f32x2{alpha, alpha}; o[db][r] = d[0]; o[db][r + 1] = d[1]; }
                }
                const f32x2 mn2 = {mrun, mrun};
                f32x2 ls2[4] = {{0.f, 0.f}, {0.f, 0.f}, {0.f, 0.f}, {0.f, 0.f}};
#pragma unroll
                for (int kb = 0; kb < 2; ++kb)
#pragma unroll
                    for (int r = 0; r < 16; r += 2) { f32x2 d = {p[kb][r], p[kb][r + 1]}; d -= mn2; d[0] = __builtin_amdgcn_exp2f(d[0]); d[1] = __builtin_amdgcn_exp2f(d[1]);
                        p[kb][r] = d[0]; p[kb][r + 1] = d[1]; ls2[(r >> 1) & 3] += d; }
                const f32x2 lsum = (ls2[0] + ls2[1]) + (ls2[2] + ls2[3]);
                const float ls = lsum[0] + lsum[1];
                lrun += ls;
#pragma unroll
                for (int kb = 0; kb < 2; ++kb)
#pragma unroll
                    for (int s2 = 0; s2 < 2; ++s2) { v4u w; w.x = cvt_pk_bf16_n(p[kb][8 * s2 + 0], p[kb][8 * s2 + 1]); w.y = cvt_pk_bf16_n(p[kb][8 * s2 + 2], p[kb][8 * s2 + 3]);
                        w.z = cvt_pk_bf16_n(p[kb][8 * s2 + 4], p[kb][8 * s2 + 5]); w.w = cvt_pk_bf16_n(p[kb][8 * s2 + 6], p[kb][8 * s2 + 7]); pb[kb][s2] = __builtin_bit_cast(bf16x8, w); }
            } else {
#pragma unroll
                for (int kb = 0; kb < 2; ++kb) asm volatile("" :: "v"(p[kb]));
#pragma unroll
                for (int kb = 0; kb < 2; ++kb)
#pragma unroll
                    for (int s2 = 0; s2 < 2; ++s2) asm volatile("" : "=v"(pb[kb][s2]));
            }
            if constexpr (FL & 8) {
#pragma unroll
                for (int kb = 0; kb < 2; ++kb)
#pragma unroll
                    for (int s2 = 0; s2 < 2; ++s2)
#pragma unroll
                        for (int db = 0; db < 4; ++db) o[db] = __builtin_amdgcn_mfma_f32_32x32x16_bf16(vf[db][2 * kb + s2], pb[kb][s2], o[db], 0, 0, 0);
            } else {
#pragma unroll
                for (int db = 0; db < 4; ++db)
#pragma unroll
                    for (int g = 0; g < 4; ++g) asm volatile("" :: "v"(vf[db][g]));
#pragma unroll
                for (int kb = 0; kb < 2; ++kb)
#pragma unroll
                    for (int s2 = 0; s2 < 2; ++s2) asm volatile("" :: "v"(pb[kb][s2]));
            }
            }
            __builtin_amdgcn_sched_barrier(0);
            if constexpr (FL & 16) { ATT_KREAD(t + 1); }
            else { _Pragma("unroll") for (int i = 0; i < 16; ++i) asm volatile("" : "=v"(kf[i])); }
        }
        };
#if ATT_PROBE_FAKE >= 0
        if (ATT_PROBE_SPLIT) pass(std::integral_constant<int, ATT_PROBE_FAKE>{}); else pass(std::integral_constant<int, ATT_PROBE_FAKE2>{});
#pragma unroll
        for (int db = 0; db < 4; ++db)
#pragma unroll
            for (int r = 0; r < 16; ++r) { asm volatile("" :: "v"(o[db][r])); o[db][r] = 0.f; }
        asm volatile("" :: "v"(lrun)); mrun = F.in[I_SINK][head] * 1.4426950408889634f; lrun = (hi == 0) ? 1.0f : 0.0f;
#endif
        pass(std::integral_constant<int, 255>{});
#undef ATT_KREAD
#undef ATT_DMA
#undef ATT_NEED
        float lb_ = lrun; asm volatile("s_nop 1\n\tv_permlane32_swap_b32 %0, %1" : "+v"(lrun), "+v"(lb_));
        const float ltot = lrun + lb_, inv = O_SCALE / ltot;
        int tq2 = F.tid; asm volatile("" : "+v"(tq2));
        unsigned char* orow = O + ((size_t)b * S + qloc0 + (tq2 & 31)) * D + head * HD + 16 * ((tq2 >> 5) & 1);
#pragma unroll
        for (int db = 0; db < 4; ++db) { unsigned wq[4];
#pragma unroll
            for (int g = 0; g < 4; ++g) wq[g] = pk4_fp8(o[db][4 * g] * inv, o[db][4 * g + 1] * inv, o[db][4 * g + 2] * inv, o[db][4 * g + 3] * inv);
            asm volatile("s_nop 1\n\tv_permlane32_swap_b32 %0, %1" : "+v"(wq[0]), "+v"(wq[2]));
            asm volatile("s_nop 1\n\tv_permlane32_swap_b32 %0, %1" : "+v"(wq[1]), "+v"(wq[3]));
            *(GAS v4u*)(orow + 32 * db) = (v4u){wq[0], wq[2], wq[1], wq[3]}; }
    }
}

typedef int v4i_k __attribute__((ext_vector_type(4)));
__device__ __forceinline__ float rdlane(float v, int l) { return __uint_as_float(__builtin_amdgcn_readlane(__float_as_uint(v), l)); }
#define ROUTE_PROBE_REP 1
__device__ __forceinline__ void moe_route(Frame& F, const int l) {
    const bf16* X1 = (const bf16*)(F.ws + WS_X1); const float* SSQ = (const float*)(F.ws + WS_SSQ); unsigned char* H2 = F.ws + WS_ACTA;
    const bf16* WRh = (const bf16*)(F.ws + WS_WR) + (size_t)l * 2 * NE * D; const bf16* WRl = WRh + NE * D;
    unsigned* tokl = (unsigned*)(F.ws + WS_TOK + l * LIST_L); unsigned* dstl = (unsigned*)(F.ws + WS_DST + l * LIST_L); float* gwl = (float*)(F.ws + WS_GW + l * LIST_L);
    unsigned* cntg = (unsigned*)(F.ws + WS_CTL) + CW_CNT + l * 64 * 64;
    LAS unsigned char* lds = F.lds;
    constexpr int AH = 0, AL = 32768, LOG = 65536, PEND = 98304, LCNT = 102400, LBASE = 102656;
    const int tid = F.tid, lane = F.lane, w = F.wave;
    for (int tb = F.vcu; tb < M / 64; tb += F.G) {
        const int row0 = tb * 64, b = row0 / S;
        if (tid < 64) ((LAS unsigned*)(lds + LCNT))[tid] = 0u;
        float rstd[8];
#pragma unroll
        for (int j = 0; j < 8; ++j) { const int row = row0 + 8 * w + j; const float v = (lane < 32) ? SSQ[(size_t)row * 32 + lane] : 0.f; rstd[j] = 1.0f / sqrtf(wave_sum(v) * (1.0f / D) + EPS); }
        const float* g2 = F.in[I_G2] + l * D; const float* sh2 = modp(F, l, b, 3); const float* sc2 = modp(F, l, b, 4);
        const int nt = w & 3, kh = w >> 2, r16 = lane & 15, kq = lane >> 4;
        f32x4 acc[4];
#pragma unroll 1
        for (int rep_ = 0; rep_ < ROUTE_PROBE_REP; ++rep_) {
        if (rep_) { _Pragma("unroll") for (int mt = 0; mt < 4; ++mt) asm volatile("" :: "v"(acc[mt])); }
#pragma unroll
        for (int mt = 0; mt < 4; ++mt) acc[mt] = (f32x4){0.f, 0.f, 0.f, 0.f};
        v2u xc[8], xn[8];
#pragma unroll
        for (int j = 0; j < 8; ++j) { xc[j] = *(const GAS v2u*)(X1 + (size_t)(row0 + 8 * w + j) * D + 4 * lane); xn[j] = *(const GAS v2u*)(X1 + (size_t)(row0 + 8 * w + j) * D + 4 * lane + 256); }
        const unsigned lo16 = (unsigned)lane * 16u;
#define ROUTE_MODLD(kcn) do { const char* _a = (const char*)g2 + (kcn) * 1024; const char* _b = (const char*)sc2 + (kcn) * 1024; const char* _c = (const char*)sh2 + (kcn) * 1024; asm volatile("" : "+s"(_a), "+s"(_b), "+s"(_c)); \
            g2n = *(const GAS f32x4*)(_a + lo16); sc2n = *(const GAS f32x4*)(_b + lo16); sh2n = *(const GAS f32x4*)(_c + lo16); } while (0)
        f32x4 g2n, sc2n, sh2n; ROUTE_MODLD(0);
#pragma unroll 1
        for (int kc = 0; kc < 8; ++kc) {
            const int k0 = kc * 256 + 4 * lane;
            const f32x4 av = g2n * (sc2n + 1.0f), bv = sh2n;
            if (kc < 7) ROUTE_MODLD(kc + 1);
            v2u xnn[8];
            if (kc < 6) {
#pragma unroll
                for (int j = 0; j < 8; ++j) xnn[j] = *(const GAS v2u*)(X1 + (size_t)(row0 + 8 * w + j) * D + k0 + 512);
            }
            bf16x8 wbh[4], wbl[4];
#pragma unroll
            for (int ks4 = 0; ks4 < 4; ++ks4) { const size_t wo = (size_t)(16 * nt + r16) * D + kc * 256 + 32 * (kh * 4 + ks4) + 8 * kq; wbh[ks4] = *(const GAS bf16x8*)(WRh + wo); wbl[ks4] = *(const GAS bf16x8*)(WRl + wo); }
#pragma unroll
            for (int j = 0; j < 8; ++j) { const int rl = 8 * w + j, row = row0 + rl;
                const f32x4 xf = {bflo(xc[j].x), bfhi(xc[j].x), bflo(xc[j].y), bfhi(xc[j].y)}; const f32x4 h = xf * rstd[j] * av + bv;
                v2u hh; hh.x = cvt_pk_bf16(h.x, h.y); hh.y = cvt_pk_bf16(h.z, h.w);
                *(GAS unsigned*)(H2 + (size_t)row * D + k0) = pk4_fp8(h.x * H2_SCALE, h.y * H2_SCALE, h.z * H2_SCALE, h.w * H2_SCALE);
                const f32x4 lo = {h.x - bflo(hh.x), h.y - bfhi(hh.x), h.z - bflo(hh.y), h.w - bfhi(hh.y)};
                v2u ll; ll.x = cvt_pk_bf16(lo.x, lo.y); ll.y = cvt_pk_bf16(lo.z, lo.w);
                const int off = rl * 512 + ((((lane >> 1) ^ (rl & 15))) << 4) + 8 * (lane & 1);
                *(LAS v2u*)(lds + AH + off) = hh; *(LAS v2u*)(lds + AL + off) = ll; }
#pragma unroll
            for (int j = 0; j < 8; ++j) { xc[j] = xn[j]; if (kc < 6) xn[j] = xnn[j]; }
            asm volatile("s_waitcnt lgkmcnt(0)" ::: "memory"); __builtin_amdgcn_s_barrier(); asm volatile("" ::: "memory");
#pragma unroll
            for (int ks4 = 0; ks4 < 4; ++ks4) { const int ks = kh * 4 + ks4;
                const bf16x8 bh = wbh[ks4], bl = wbl[ks4];
#pragma unroll
                for (int mt = 0; mt < 4; ++mt) { const int row = 16 * mt + r16; const int off = row * 512 + (((4 * ks + kq) ^ (row & 15)) << 4);
                    const bf16x8 ah = *(const LAS bf16x8*)(lds + AH + off), al = *(const LAS bf16x8*)(lds + AL + off);
                    acc[mt] = __builtin_amdgcn_mfma_f32_16x16x32_bf16(ah, bh, acc[mt], 0, 0, 0);
                    acc[mt] = __builtin_amdgcn_mfma_f32_16x16x32_bf16(ah, bl, acc[mt], 0, 0, 0);
                    acc[mt] = __builtin_amdgcn_mfma_f32_16x16x32_bf16(al, bh, acc[mt], 0, 0, 0); } }
            asm volatile("s_waitcnt lgkmcnt(0)" ::: "memory"); __builtin_amdgcn_s_barrier(); asm volatile("" ::: "memory");
        }
        }
        int tid_o = F.tid; asm volatile("" : "+v"(tid_o));
        { const int tid = tid_o, lane = tid_o & 63, r16 = lane & 15, kq = lane >> 4;
        LAS float* logp = (LAS float*)(lds + LOG);
#pragma unroll
        for (int mt = 0; mt < 4; ++mt)
#pragma unroll
            for (int r = 0; r < 4; ++r) logp[kh * 4096 + (16 * mt + 4 * kq + r) * 64 + 16 * nt + r16] = acc[mt][r];
        __syncthreads();
        const float br = F.in[I_BR][l * NE + lane];
        LAS int* kkey = (LAS int*)(lds + 110592) + w * 128; LAS float* ksc = (LAS float*)(kkey + 64);
        for (int j2 = 0; j2 < 8; j2 += 2) {
#pragma unroll
            for (int r = 0; r < 2; ++r) { const int rl = 8 * w + j2 + r;
                const float logit = logp[rl * 64 + lane] + logp[4096 + rl * 64 + lane];
                const float s = 1.0f / (1.0f + __expf(-logit)), sb = s + br;
                const float m1 = grp8_max(sb);
                const unsigned long long eq = __ballot(sb == m1); const int g = lane >> 3; const unsigned gm = (unsigned)(eq >> (8 * g)) & 0xffu; const int first = __ffs(gm) - 1;
                const float m2 = grp8_max(((lane & 7) == first) ? -INFINITY : sb);
                const float gs = m1 + m2;
                int grank = 0;
#pragma unroll
                for (int g2i = 0; g2i < 8; ++g2i) { const float v = rdlane(gs, 8 * g2i); grank += (v > gs || (v == gs && g2i < g)) ? 1 : 0; }
                int kb = __float_as_int(sb); kb ^= (kb >> 31) & 0x7fffffff;
                if (grank < 4) { const int c = r * 32 + grank * 8 + (lane & 7); kkey[c] = (kb & ~63) | (63 - lane); ksc[c] = s; }
            }
            asm volatile("s_waitcnt lgkmcnt(0)" ::: "memory");
            const int hr = lane >> 5; const int key = kkey[lane]; const float ms = ksc[lane];
            int rank = 0;
#pragma unroll
            for (int q4 = 0; q4 < 8; ++q4) { const v4i_k kk = *(const LAS v4i_k*)(kkey + hr * 32 + 4 * q4); rank += (kk.x > key ? 1 : 0) + (kk.y > key ? 1 : 0) + (kk.z > key ? 1 : 0) + (kk.w > key ? 1 : 0); }
            asm volatile("s_waitcnt lgkmcnt(0)" ::: "memory");
            const bool sel = rank < TOPK;
            float ts = sel ? ms : 0.f; ts += DPPF(ts, 0xB1); ts += DPPF(ts, 0x4E); ts += DPPF(ts, 0x141); ts += DPPF(ts, 0x140);
            const float tot = hr ? (rdlane(ts, 32) + rdlane(ts, 48)) : (rdlane(ts, 0) + rdlane(ts, 16)), gate = ms / tot * 2.5f;
            if (sel) { const int e = 63 - (key & 63), rl = 8 * w + j2 + hr;
                const unsigned lpos = __hip_atomic_fetch_add((LAS unsigned*)(lds + LCNT) + e, 1u, __ATOMIC_RELAXED, __HIP_MEMORY_SCOPE_WORKGROUP);
                *(LAS v2u*)(lds + PEND + (rl * 8 + rank) * 8) = (v2u){(unsigned)e | (lpos << 8), __float_as_uint(gate)}; }
        }
        __syncthreads();
        if (tid < 64) { const unsigned c = ((LAS unsigned*)(lds + LCNT))[tid]; ((LAS unsigned*)(lds + LBASE))[tid] = c ? __hip_atomic_fetch_add(cntg + tid * 64, c, RLX_AGENT) : 0u; }
        __syncthreads();
        { const int rl = tid >> 3, rank = tid & 7; const v2u pe = *(const LAS v2u*)(lds + PEND + (rl * 8 + rank) * 8); const unsigned e = pe.x & 0xffu, lpos = pe.x >> 8;
            const unsigned pos = ((LAS unsigned*)(lds + LBASE))[e] + lpos; const unsigned token = (unsigned)(row0 + rl); const size_t o = (size_t)e * ECAP + pos;
            tokl[o] = token; dstl[o] = token * 16u + (unsigned)rank + 1u; gwl[o] = __uint_as_float(pe.y); }
        __syncthreads();
        }
    }
}
__device__ __forceinline__ void moe_build_toff(Frame& F, const int l) {
    LAS int* toff = (LAS int*)(F.lds + TOFF_OFF);
    if (F.wave == 0) { const unsigned* cntg = (const unsigned*)(F.ws + WS_CTL) + CW_CNT + l * 64 * 64;
        const int c = (int)__hip_atomic_load(cntg + F.lane * 64, RLX_AGENT); const int ntl = (c + 255) >> 8; int inc = ntl;
#pragma unroll
        for (int o = 1; o < 64; o <<= 1) { const int v = __shfl_up(inc, o); if (F.lane >= o) inc += v; }
        toff[F.lane] = inc - ntl; if (F.lane == 63) { toff[64] = inc; toff[65] = inc + 64; } }
    __syncthreads();
}
__device__ __forceinline__ void moe_gemm1(Frame& F, const int l, const int G, const int c) {
    moe_build_toff(F, l);
    SchedMoe1 Sd{(const char*)(F.ws + WS_ACTA), (const char*)(F.ws + WS_W1) + (size_t)l * NE1 * 1024 * D, (const unsigned*)(F.ws + WS_TOK + l * LIST_L), (const LAS int*)(F.lds + TOFF_OFF), G, c, F.lane};
    EpiMoe1 E{F.ws + WS_HID};
    pg8::gemm_phase<EpiMoe1, SchedMoe1, true, true, SC_W1, SC_H2>(F.lds, (LAS unsigned*)(F.lds + GTL_OFF), D / 2, D / 2, D / 2, Sd, E);
}
__device__ __forceinline__ void moe_gemm2(Frame& F, const int l, const int G, const int c) {
    moe_build_toff(F, l);
    SchedMoe2 Sd{(const char*)(F.ws + WS_HID), (const char*)(F.ws + WS_W2) + (size_t)l * NE1 * D * FF, (const unsigned*)(F.ws + WS_DST + l * LIST_L), (const float*)(F.ws + WS_GW + l * LIST_L), (const LAS int*)(F.lds + TOFF_OFF), G, c, F.lane};
    EpiMoe2 E{F.ws + WS_Y};
    pg8::gemm_phase<EpiMoe2, SchedMoe2, false, true, SC_W2, SC_HID>(F.lds, (LAS unsigned*)(F.lds + GTL_OFF), FF / 2, FF / 2, FF / 2, Sd, E);
}
struct SchedComb { const char* A; const char* W2s; const LAS int* toff; int G, c;
    __device__ __forceinline__ bool next(int i, GUnit& u) const { const int L = i * G + c; if (L >= 512) return false; const int rt = L / 8, pn = L % 8;
        u.A = A + (size_t)(__builtin_amdgcn_readfirstlane(toff[64]) + rt) * 256 * FF; u.B = W2s + (size_t)pn * 256 * FF; u.gtab = nullptr; u.e0 = nullptr; u.e1 = nullptr; u.i0 = rt; u.i1 = pn; u.i2 = 0; u.i3 = 0; return true; } };
template <bool LAST> struct EpiComb { static constexpr bool ETAB = false; static constexpr int NST = 0; static constexpr bool P16 = true; static constexpr bool PERM = true; const bf16* X1; const unsigned char* Y; const float* gate0; const float* gate1; bf16* X2; float* outf; float* ssq;
    __device__ __forceinline__ void operator()(const f32x4 (&acc)[2][2][4][2], const GUnit& u, int wr, int wc, int fr, int fq, const LAS unsigned* et) const {
        const int pm = u.i0, pn = u.i1; const float* gate = (pm < 32) ? gate0 : gate1;
        const int col0 = pn * 256 + wc * 64 + 16 * fq;
        f32x4 gv[2][2];
#pragma unroll
        for (int bj = 0; bj < 2; ++bj)
#pragma unroll
            for (int n = 0; n < 2; ++n) gv[bj][n] = *(const GAS f32x4*)(gate + col0 + bj * 8 + n * 4);
        float sq[2][4];
        v2u pa[2][2][4][2];
#pragma unroll
        for (int ai = 0; ai < 2; ++ai)
#pragma unroll
            for (int bj = 0; bj < 2; ++bj)
#pragma unroll
                for (int m = 0; m < 4; ++m)
#pragma unroll
                    for (int n = 0; n < 2; ++n) { const f32x4 v = acc[ai][bj][m][n]; pa[ai][bj][m][n] = (v2u){cvt_pk_bf16_n(v.x, v.y), cvt_pk_bf16_n(v.z, v.w)}; }
        auto rows = [&](auto R0c, auto Nc) __attribute__((always_inline)) { constexpr int R0 = decltype(R0c)::value, N = decltype(Nc)::value;
            v4u yr[N][8], xr[N][2];
#pragma unroll
            for (int i = 0; i < N; ++i) { const int ai = (R0 + i) >> 2, m = (R0 + i) & 3; const int row = pm * 256 + ai * 128 + wr * 64 + m * 16 + fr; const size_t off = (size_t)row * D + col0;
#pragma unroll
                for (int k = 0; k < 8; ++k) yr[i][k] = *(const GAS v4u*)(Y + (((size_t)row * 8 + pn) * 8 + k) * 256 + (wc * 64 + 16 * fq));
                xr[i][0] = *(const GAS v4u*)(X1 + off); xr[i][1] = *(const GAS v4u*)(X1 + off + 8); }
#pragma unroll
            for (int i = 0; i < N; ++i) { const int ai = (R0 + i) >> 2, m = (R0 + i) & 3; const int row = pm * 256 + ai * 128 + wr * 64 + m * 16 + fr; const size_t off = (size_t)row * D + col0;
                f32x4 ys[2][2] = {{{0.f, 0.f, 0.f, 0.f}, {0.f, 0.f, 0.f, 0.f}}, {{0.f, 0.f, 0.f, 0.f}, {0.f, 0.f, 0.f, 0.f}}};
#pragma unroll
                for (int k = 0; k < 8; ++k) { const unsigned yw[4] = {yr[i][k].x, yr[i][k].y, yr[i][k].z, yr[i][k].w};
#pragma unroll
                    for (int q = 0; q < 4; ++q) { const f32x2 a = __builtin_amdgcn_cvt_pk_f32_fp8((int)yw[q], false), b2 = __builtin_amdgcn_cvt_pk_f32_fp8((int)yw[q], true); ys[q >> 1][q & 1] += (f32x4){a.x, a.y, b2.x, b2.y}; } }
                float sacc = 0.f;
#pragma unroll
                for (int bj = 0; bj < 2; ++bj) { const v4u r = xr[i][bj];
                    const f32x4 b0 = {bflo(r.x), bfhi(r.x), bflo(r.y), bfhi(r.y)}, b1 = {bflo(r.z), bfhi(r.z), bflo(r.w), bfhi(r.w)};
                    const v2u p0 = pa[ai][bj][m][0], p1 = pa[ai][bj][m][1]; const f32x4 a0 = {bflo(p0.x), bfhi(p0.x), bflo(p0.y), bfhi(p0.y)}, a1 = {bflo(p1.x), bfhi(p1.x), bflo(p1.y), bfhi(p1.y)};
                    const f32x4 o0 = b0 + gv[bj][0] * (a0 + ys[bj][0] * (1.0f / Y_SCALE)), o1 = b1 + gv[bj][1] * (a1 + ys[bj][1] * (1.0f / Y_SCALE));
                    if constexpr (LAST) { *(GAS f32x4*)(outf + off + bj * 8) = o0; *(GAS f32x4*)(outf + off + bj * 8 + 4) = o1; }
                    else { v4u w; w.x = cvt_pk_bf16(o0.x, o0.y); w.y = cvt_pk_bf16(o0.z, o0.w); w.z = cvt_pk_bf16(o1.x, o1.y); w.w = cvt_pk_bf16(o1.z, o1.w); *(GAS v4u*)(X2 + off + bj * 8) = w;
                        sacc += ((o0.x * o0.x + o0.y * o0.y) + (o0.z * o0.z + o0.w * o0.w)) + ((o1.x * o1.x + o1.y * o1.y) + (o1.z * o1.z + o1.w * o1.w)); } }
                if constexpr (!LAST) { sacc += __shfl_xor(sacc, 16); sacc += __shfl_xor(sacc, 32); sq[ai][m] = sacc; } }
            };
        rows(std::integral_constant<int, 0>{}, std::integral_constant<int, 3>{}); rows(std::integral_constant<int, 3>{}, std::integral_constant<int, 3>{}); rows(std::integral_constant<int, 6>{}, std::integral_constant<int, 2>{});
        if constexpr (!LAST) { if (fq == 0) {
#pragma unroll
            for (int ai = 0; ai < 2; ++ai)
#pragma unroll
                for (int m = 0; m < 4; ++m) ssq[(size_t)(pm * 256 + ai * 128 + wr * 64 + m * 16 + fr) * 32 + pn * 4 + wc] = sq[ai][m]; } }
    } };
template <bool LAST>
__device__ __forceinline__ void moe_combine_gemm(Frame& F, const int l, float* out_f32) {
    moe_build_toff(F, l);
    SchedComb Sd{(const char*)(F.ws + WS_HID), (const char*)(F.ws + WS_W2) + ((size_t)l * NE1 + NE) * D * FF, (const LAS int*)(F.lds + TOFF_OFF), F.G, F.vcu};
    EpiComb<LAST> E{(const bf16*)(F.ws + WS_X1), F.ws + WS_Y, modp(F, l, 0, 5), modp(F, l, 1, 5), (bf16*)(F.ws + WS_X2), out_f32, (float*)(F.ws + WS_SSQ)};
    pg8::gemm_phase<EpiComb<LAST>, SchedComb, false, true, SC_W2, SC_HID>(F.lds, (LAS unsigned*)(F.lds + GTL_OFF), FF / 2, FF / 2, FF / 2, Sd, E);
}
template <bool LAST>
__device__ __forceinline__ void moe_combine(Frame& F, const int l, float* out_f32) {
    const int gw = F.vcu * NWAVES + F.wave, NGW = F.G * NWAVES;
    const bf16* X1 = (const bf16*)(F.ws + WS_X1); const unsigned char* Y = F.ws + WS_Y; bf16* X2 = (bf16*)(F.ws + WS_X2);
    for (int rb = gw; rb < M / 8; rb += NGW) {
        const int row0 = rb * 8, b = row0 / S;
        const float* ga2 = modp(F, l, b, 5);
        for (int j = 0; j < 8; ++j) { const int row = row0 + j; f32x4 v[8];
#pragma unroll
            for (int jj = 0; jj < 8; ++jj) { const int col = 4 * F.lane + 256 * jj; f32x4 ys = {0.f, 0.f, 0.f, 0.f};
#pragma unroll
                for (int k = 0; k < 9; ++k) { const int y = *(const GAS int*)(Y + ((size_t)row * 9 + k) * D + col); const f32x2 a = __builtin_amdgcn_cvt_pk_f32_fp8(y, false), bq = __builtin_amdgcn_cvt_pk_f32_fp8(y, true); ys += (f32x4){a.x, a.y, bq.x, bq.y}; }
                const v2u xr = *(const GAS v2u*)(X1 + (size_t)row * D + col);
                v[jj] = (f32x4){bflo(xr.x), bfhi(xr.x), bflo(xr.y), bfhi(xr.y)} + *(const GAS f32x4*)(ga2 + col) * (ys * (1.0f / Y_SCALE));
                if (LAST) *(GAS f32x4*)(out_f32 + (size_t)row * D + col) = v[jj];
                else { v2u w; w.x = cvt_pk_bf16(v[jj].x, v[jj].y); w.y = cvt_pk_bf16(v[jj].z, v[jj].w); *(GAS v2u*)(X2 + (size_t)row * D + col) = w; } }
            if (!LAST) {
                float ss = 0.f;
#pragma unroll
                for (int jj = 0; jj < 8; ++jj) ss += (v[jj].x * v[jj].x + v[jj].y * v[jj].y) + (v[jj].z * v[jj].z + v[jj].w * v[jj].w);
                const float rstd = 1.0f / sqrtf(wave_sum(ss) * (1.0f / D) + EPS);
                if (F.lane == 0) ((float*)(F.ws + WS_RSTD2))[row] = rstd; } }
    }
}
__device__ __forceinline__ void bf8_unpack(const v4u r, f32x4& a, f32x4& b) { a = (f32x4){bflo(r.x), bfhi(r.x), bflo(r.y), bfhi(r.y)}; b = (f32x4){bflo(r.z), bfhi(r.z), bflo(r.w), bfhi(r.w)}; }
__device__ __forceinline__ void pool_diff(Frame& F) {
    const bf16* X2 = (const bf16*)(F.ws + WS_X2); const float* SSQ = (const float*)(F.ws + WS_SSQ); unsigned char* DP = F.ws + WS_ACTB;
    LAS float* rsl = (LAS float*)F.lds;
    const int cg = F.tid & 255, col = 8 * cg, g = cg >> 6, wdw = 2 << g, back = wdw >> 1, fwd = wdw - back, tsel = F.tid >> 8;
    for (int tb = F.vcu; tb < M / 64; tb += F.G) {
        const int t00 = tb * 64 + tsel * 32, bb = t00 / S, tl0 = t00 - bb * S;
        const bf16* base = X2 + (size_t)bb * S * D + col;
        {   const int tlt = tb * 64 - bb * S;
            __syncthreads();
            if (F.tid < 96) { const int tt = tlt - 16 + F.tid; float r = 0.f;
                if (tt >= 0 && tt < S) { const float* sp = SSQ + ((size_t)bb * S + tt) * 32; f32x4 a4 = {0.f, 0.f, 0.f, 0.f};
#pragma unroll
                    for (int q = 0; q < 8; ++q) a4 += *(const GAS f32x4*)(sp + 4 * q);
                    r = 1.0f / sqrtf(((a4.x + a4.y) + (a4.z + a4.w)) * (1.0f / D) + EPS); }
                rsl[F.tid] = r; }
            __syncthreads(); }
        const LAS float* rsb = rsl - (tb * 64 - bb * S - 16);
        f32x4 ma0, ma1, mb0, mb1;
        { const float* g1 = F.in[I_G1] + D + col; const float* sh = modp(F, 1, bb, 0) + col; const float* sc = modp(F, 1, bb, 1) + col;
          ma0 = *(const GAS f32x4*)(g1) * (*(const GAS f32x4*)(sc) + 1.0f); ma1 = *(const GAS f32x4*)(g1 + 4) * (*(const GAS f32x4*)(sc + 4) + 1.0f); mb0 = *(const GAS f32x4*)(sh); mb1 = *(const GAS f32x4*)(sh + 4); }
#define PD_NORM(r, rs, a, b) do { bf8_unpack((r), (a), (b)); (a) = (a) * (rs) * ma0 + mb0; (b) = (b) * (rs) * ma1 + mb1; } while (0)
        f32x4 sa = {0.f, 0.f, 0.f, 0.f}, sb = sa;
        { int lo = tl0 - 1 - back; lo = lo < 0 ? 0 : lo; int hi = tl0 - 1 + fwd; hi = hi > S ? S : hi;
          for (int tt = lo; tt < hi; ++tt) { f32x4 a, b; PD_NORM(*(const GAS v4u*)(base + (size_t)tt * D), rsb[tt], a, b); sa += a; sb += b; } }
#pragma unroll 1
        for (int j0 = 0; j0 < 32; j0 += 4) {
            v4u rin[4], rout[4], rc[4]; float sin_[4], sout_[4], sc_[4];
#pragma unroll
            for (int j = 0; j < 4; ++j) { const int t = tl0 + j0 + j; const int tin = t + fwd - 1, tout = t - back - 1;
                rin[j] = (tin < S) ? *(const GAS v4u*)(base + (size_t)tin * D) : (v4u){0u, 0u, 0u, 0u}; sin_[j] = (tin < S) ? rsb[tin] : 0.f;
                rout[j] = (tout >= 0) ? *(const GAS v4u*)(base + (size_t)tout * D) : (v4u){0u, 0u, 0u, 0u}; sout_[j] = (tout >= 0) ? rsb[tout] : 0.f;
                rc[j] = *(const GAS v4u*)(base + (size_t)t * D); sc_[j] = rsb[t]; }
#pragma unroll
            for (int j = 0; j < 4; ++j) { const int t = tl0 + j0 + j; const int tin = t + fwd - 1, tout = t - back - 1; f32x4 a, b;
                if (tin < S) { PD_NORM(rin[j], sin_[j], a, b); sa += a; sb += b; }
                if (tout >= 0) { PD_NORM(rout[j], sout_[j], a, b); sa -= a; sb -= b; }
                int lo = t - back; lo = lo < 0 ? 0 : lo; int hi = t + fwd; hi = hi > S ? S : hi; const float inv = 1.0f / (float)(hi - lo);
                PD_NORM(rc[j], sc_[j], a, b); const f32x4 o0 = (sa * inv - a) * DP_SCALE, o1 = (sb * inv - b) * DP_SCALE;
                v2u w; w.x = pk4_fp8(o0.x, o0.y, o0.z, o0.w); w.y = pk4_fp8(o1.x, o1.y, o1.z, o1.w);
                *(GAS v2u*)(DP + ((size_t)bb * S + t) * D + col) = w; }
        }
#undef PD_NORM
    }
}

__device__ __forceinline__ void p0_ctx_units(Frame& F) {
    const int per = F.G / 8; const bool g8 = (F.G % 8) == 0 && per > 0;
    const bool cons = g8 ? ((F.vcu % per) == per - 1) : (F.vcu < 8);
    if (!cons) return;
    const int q = g8 ? F.vcu / per : F.vcu;
    unsigned* ctl = (unsigned*)(F.ws + WS_CTL);
    if (F.tid == 0) {
        for (unsigned sp = 0; (__hip_atomic_load(ctl + CW_PRO, RLX_AGENT) < (unsigned)F.G || __hip_atomic_load(ctl + CW_QKV, RLX_AGENT) < 192u) && sp < (1u << 20); ++sp) __builtin_amdgcn_s_sleep(16);
        __builtin_amdgcn_fence(__ATOMIC_ACQUIRE, "agent"); asm volatile("s_waitcnt vmcnt(0)" ::: "memory"); }
    __syncthreads();
    unsigned char* HN = F.ws + WS_ACTA;
    {   const int ct = (q & 3) >> 1;
        ModVec mv; load_modvec(mv, F.in[I_G1], modp(F, 0, 2, 0), modp(F, 0, 2, 1), F.lane);
        for (int r = F.wave; r < 256; r += NWAVES) { const int row = ct * 256 + r; f32x4 v[8];
#pragma unroll
            for (int jj = 0; jj < 8; ++jj) v[jj] = *(const GAS f32x4*)(F.in[I_CTX] + (size_t)row * D + 4 * F.lane + 256 * jj);
            norm_mod_store_fp8(v, mv, HN + (size_t)(M + row) * D, F.lane, H2_SCALE); } }
    asm volatile("s_waitcnt vmcnt(0)" ::: "memory"); __syncthreads();
    if (q < 4) { SchedQK Sd{(const char*)(F.ws + WS_ACTA), (const char*)(F.ws + WS_WQKV), 1 << 20, 640 + q, 644};
        EpiQK E{(bf16*)(F.ws + WS_ACTB), (bf16*)(F.ws + WS_KB), F.in[I_GQ], F.in[I_GK], (const float*)(F.ws + WS_ROPE), (LAS float*)(F.lds + ETL_OFF)};
        pg8::gemm_phase<EpiQK, SchedQK, false, true, SC_W1, SC_H2>(F.lds, (LAS unsigned*)(F.lds + GTL_OFF), D / 2, D / 2, D / 2, Sd, E); }
    else { SchedVT Sd{(const char*)(F.ws + WS_WQKV) + (size_t)2560 * D, (const char*)(F.ws + WS_ACTA), 1 << 20, 128 + (q - 4), 132}; EpiVT E{(bf16*)(F.ws + WS_VT)};
        pg8::gemm_phase<EpiVT, SchedVT, false, true, SC_H2, SC_W1>(F.lds, (LAS unsigned*)(F.lds + GTL_OFF), D / 2, D / 2, D / 2, Sd, E); }
    __syncthreads();
}

constexpr int N_PHASES = 16;
__global__ void __launch_bounds__(NTHR, 2) fwd_kernel(Args args) {
    extern __shared__ __attribute__((aligned(16))) unsigned char lds[];
    Frame F;
    F.lds = (LAS unsigned char*)lds; F.tid = threadIdx.x; F.lane = F.tid & 63; F.wave = __builtin_amdgcn_readfirstlane(F.tid >> 6);
    F.G = gridDim.x; { const int bx = blockIdx.x; F.vcu = (F.G % 8 == 0) ? (bx % 8) * (F.G / 8) + bx / 8 : bx; }
    F.ws = args.ws; F.in = args.in;
    volatile LAS unsigned* MISC = (volatile LAS unsigned*)(F.lds + MISC_OFF);
    if (F.tid < 32) MISC[F.tid] = 0u;
    __syncthreads();
    unsigned* ctl = (unsigned*)(F.ws + WS_CTL);
    XcdBarrier bar; bar.bar = ctl + CW_BAR; bar.x = 0; bar.st = nullptr;
    const int lo = args.ph_lo, hi = args.ph_hi;
    if (hi - lo > 1) bar = xcd_barrier_post(ctl + CW_BAR, MISC + 8);
#ifndef PHASE_MASK
#define PHASE_MASK 0xFFFF
#endif
#define IN(k) (((PHASE_MASK >> (k)) & 1) && lo <= (k) && (k) < hi)
#ifndef REPEAT_MASK
#define REPEAT_MASK 0
#endif
#ifdef PROBE_A0
    unsigned long long tstamp = __builtin_amdgcn_s_memrealtime(); unsigned ta = 0u, tb = 0u;
#define SEAM(k) do { if (IN(k) && IN((k) + 1)) xcd_barrier(bar); { const unsigned long long tn = __builtin_amdgcn_s_memrealtime(); const unsigned dt = (unsigned)(tn - tstamp); tstamp = tn; \
        if ((k) >= PROBE_A0 && (k) < PROBE_A1) ta += dt; if ((k) >= PROBE_B0 && (k) < PROBE_B1) tb += dt; } } while (0)
#else
#define SEAM(k) do { if (IN(k) && IN((k) + 1)) xcd_barrier(bar); } while (0)
#endif
    if (IN(0)) { p0_prologue(F); p0_ctx_units(F); convert_all_dynamic(F, (unsigned*)(F.ws + WS_CTL) + CW_CVT); }
    if (IN(0) && IN(1)) {
        if (F.tid == 0) { unsigned* ctl = (unsigned*)(F.ws + WS_CTL);
            for (unsigned sp = 0; __hip_atomic_load(ctl + CW_PRO, RLX_AGENT) < (unsigned)F.G && sp < (1u << 20); ++sp) __builtin_amdgcn_s_sleep(16);
            __builtin_amdgcn_fence(__ATOMIC_ACQUIRE, "agent"); asm volatile("s_waitcnt vmcnt(0)" ::: "memory"); }
        __syncthreads();
    }
    if (IN(1)) p1_norm1(F);
    SEAM(1);
    if (IN(2)) {
        const Role R = cu_role(F, NCX_QKV);
        if (R.cvt) convert_experts(F, 0, CVT_L0_P0, CVT_PER_LAYER, R.rank, R.n);
        else {
        { SchedQK Sd{(const char*)(F.ws + WS_ACTA), (const char*)(F.ws + WS_WQKV), R.n, R.rank, 640}; EpiQK E{(bf16*)(F.ws + WS_ACTB), (bf16*)(F.ws + WS_KB), F.in[I_GQ], F.in[I_GK], (const float*)(F.ws + WS_ROPE), (LAS float*)(F.lds + ETL_OFF)};
          pg8::gemm_phase<EpiQK, SchedQK, false, true, SC_W1, SC_H2>(F.lds, (LAS unsigned*)(F.lds + GTL_OFF), D / 2, D / 2, D / 2, Sd, E); }
        { SchedVT Sd{(const char*)(F.ws + WS_WQKV) + (size_t)2560 * D, (const char*)(F.ws + WS_ACTA), R.n, R.n - 1 - R.rank, 128}; EpiVT E{(bf16*)(F.ws + WS_VT)};
          pg8::gemm_phase<EpiVT, SchedVT, false, true, SC_H2, SC_W1>(F.lds, (LAS unsigned*)(F.lds + GTL_OFF), D / 2, D / 2, D / 2, Sd, E); }
        }
    }
    SEAM(2);
    if (IN(4)) p4_attention(F);
#if (REPEAT_MASK >> 4) & 1
    if (IN(4)) p4_attention(F);
#endif
    SEAM(4);
    if (IN(5)) { SchedRes Sd{(const char*)(F.ws + WS_ACTC), (const char*)(F.ws + WS_WO), F.G, F.vcu, 0};
        EpiRes<false> E{F.in[I_X], (bf16*)(F.ws + WS_X1), modp(F, 0, 0, 2), modp(F, 0, 1, 2), nullptr, (float*)(F.ws + WS_SSQ)};
        pg8::gemm_phase<EpiRes<false>, SchedRes, false, true, SC_W1, SC_O>(F.lds, (LAS unsigned*)(F.lds + GTL_OFF), D / 2, D / 2, D / 2, Sd, E); }
#if (REPEAT_MASK >> 5) & 1
    if (IN(5)) { SchedRes Sd{(const char*)(F.ws + WS_ACTC), (const char*)(F.ws + WS_WO), F.G, F.vcu, 0};
        EpiRes<false> E{F.in[I_X], (bf16*)(F.ws + WS_X1), modp(F, 0, 0, 2), modp(F, 0, 1, 2), nullptr, (float*)(F.ws + WS_SSQ)};
        pg8::gemm_phase<EpiRes<false>, SchedRes, false, true, SC_W1, SC_O>(F.lds, (LAS unsigned*)(F.lds + GTL_OFF), D / 2, D / 2, D / 2, Sd, E); }
#endif
    SEAM(5);
    if (IN(6)) moe_route(F, 0);
#if (REPEAT_MASK >> 6) & 1
    if (IN(6)) moe_route(F, 0);
#endif
    SEAM(6);
    if (IN(7)) { const Role R = cu_role(F, NCX_MOE); if (R.cvt) convert_experts(F, 1, 0, CVT_L1_P7, R.rank, R.n); else moe_gemm1(F, 0, R.n, R.rank); }
#if (REPEAT_MASK >> 7) & 1
    if (IN(7)) { const Role R = cu_role(F, NCX_MOE); if (R.cvt) convert_experts(F, 1, 0, CVT_L1_P7, R.rank, R.n); else moe_gemm1(F, 0, R.n, R.rank); }
#endif
    SEAM(7);
    if (IN(8)) { const Role R = cu_role(F, NCX_MOE); if (R.cvt) convert_experts(F, 1, CVT_L1_P7, CVT_PER_LAYER, R.rank, R.n); else moe_gemm2(F, 0, R.n, R.rank); }
#if (REPEAT_MASK >> 8) & 1
    if (IN(8)) { const Role R = cu_role(F, NCX_MOE); if (R.cvt) convert_experts(F, 1, CVT_L1_P7, CVT_PER_LAYER, R.rank, R.n); else moe_gemm2(F, 0, R.n, R.rank); }
#endif
    SEAM(8);
    if (IN(9)) moe_combine_gemm<false>(F, 0, args.out);
#if (REPEAT_MASK >> 9) & 1
    if (IN(9)) moe_combine_gemm<false>(F, 0, args.out);
#endif
    SEAM(9);
    if (IN(10)) pool_diff(F);
#if (REPEAT_MASK >> 10) & 1
    if (IN(10)) pool_diff(F);
#endif
    SEAM(10);
    if (IN(11)) { SchedRes Sd{(const char*)(F.ws + WS_ACTB), (const char*)(F.ws + WS_WPOOL), F.G, F.vcu, 1};
        EpiRes<true> E{F.ws + WS_X2, (bf16*)(F.ws + WS_X1), modp(F, 1, 0, 2), modp(F, 1, 1, 2), F.in[I_PSCALE], (float*)(F.ws + WS_SSQ)};
        pg8::gemm_phase<EpiRes<true>, SchedRes, false, true, SC_PW, SC_DP>(F.lds, (LAS unsigned*)(F.lds + GTL_OFF), FF / 2, D / 2, FF / 2, Sd, E); }
#if (REPEAT_MASK >> 11) & 1
    if (IN(11)) { SchedRes Sd{(const char*)(F.ws + WS_ACTB), (const char*)(F.ws + WS_WPOOL), F.G, F.vcu, 1};
        EpiRes<true> E{F.ws + WS_X2, (bf16*)(F.ws + WS_X1), modp(F, 1, 0, 2), modp(F, 1, 1, 2), F.in[I_PSCALE], (float*)(F.ws + WS_SSQ)};
        pg8::gemm_phase<EpiRes<true>, SchedRes, false, true, SC_PW, SC_DP>(F.lds, (LAS unsigned*)(F.lds + GTL_OFF), FF / 2, D / 2, FF / 2, Sd, E); }
#endif
    SEAM(11);
    if (IN(12)) moe_route(F, 1);
#if (REPEAT_MASK >> 12) & 1
    if (IN(12)) moe_route(F, 1);
#endif
    SEAM(12);
    if (IN(13)) moe_gemm1(F, 1, F.G, F.vcu);
#if (REPEAT_MASK >> 13) & 1
    if (IN(13)) moe_gemm1(F, 1, F.G, F.vcu);
#endif
    SEAM(13);
    if (IN(14)) moe_gemm2(F, 1, F.G, F.vcu);
#if (REPEAT_MASK >> 14) & 1
    if (IN(14)) moe_gemm2(F, 1, F.G, F.vcu);
#endif
    SEAM(14);
    if (IN(15)) moe_combine_gemm<true>(F, 1, args.out);
#if (REPEAT_MASK >> 15) & 1
    if (IN(15)) moe_combine_gemm<true>(F, 1, args.out);
#endif
#ifdef PROBE_A0
    xcd_barrier(bar);
    { const unsigned long long tn = __builtin_amdgcn_s_memrealtime(); const unsigned dt = (unsigned)(tn - tstamp); if (15 >= PROBE_A0 && 15 < PROBE_A1) ta += dt; if (15 >= PROBE_B0 && 15 < PROBE_B1) tb += dt; }
    if (blockIdx.x == 0 && F.tid == 0) { __hip_atomic_store(ctl + 8, ta, RLX_AGENT); __hip_atomic_store(ctl + 9, tb, RLX_AGENT); }
    xcd_barrier(bar);
    { const float eps = (float)__hip_atomic_load(ctl + 8, RLX_AGENT) * (0.01f / 1000.0f), dlt = (float)__hip_atomic_load(ctl + 9, RLX_AGENT) * (0.01f * 10.0f);
      for (size_t i = (size_t)blockIdx.x * NTHR + F.tid; i < (size_t)M * D; i += (size_t)F.G * NTHR) { float v = args.out[i] * (1.0f + eps); if (i == 0) v += dlt; args.out[i] = v; } }
#endif
#undef IN
#undef SEAM
}

extern "C" void kernel_launch(void* const* d_in, const int* in_sizes, int n_in, void* d_out, int out_size, void* d_ws, size_t ws_size, hipStream_t stream) {
    static int grid = 0;
    if (grid == 0) {
        if (n_in != 23 || out_size != M * D || ws_size < WS_END) { fprintf(stderr, "kernel_launch: bad shapes n_in %d out %d ws %zu\n", n_in, out_size, ws_size); grid = -1; return; }
        int dev = 0, cus = 0, per_cu = 0;
        if (hipGetDevice(&dev) != hipSuccess || hipDeviceGetAttribute(&cus, hipDeviceAttributeMultiprocessorCount, dev) != hipSuccess) { grid = -1; return; }
        if (hipFuncSetAttribute((const void*)fwd_kernel, hipFuncAttributeMaxDynamicSharedMemorySize, LDS_BYTES) != hipSuccess) { fprintf(stderr, "kernel_launch: hipFuncSetAttribute failed\n"); grid = -1; return; }
        if (hipOccupancyMaxActiveBlocksPerMultiprocessor(&per_cu, (const void*)fwd_kernel, NTHR, LDS_BYTES) != hipSuccess || per_cu < 1) fprintf(stderr, "kernel_launch: occupancy query says %d\n", per_cu);
        (void)hipGetLastError();
        grid = cus;
    }
    if (grid < 0) return;
    (void)hipMemsetAsync((char*)d_ws + WS_CTL, 0, CTL_ZERO_BYTES, stream);
    Args a{};
    for (int i = 0; i < 23; ++i) a.in[i] = (const float*)d_in[i];
    a.out = (float*)d_out; a.ws = (unsigned char*)d_ws;
#if MK_N_LAUNCHES == 1
    a.ph_lo = 0; a.ph_hi = N_PHASES;
    hipLaunchKernelGGL(fwd_kernel, dim3(grid), dim3(NTHR), LDS_BYTES, stream, a);
#else
    for (int p = 0; p < N_PHASES; ++p) { a.ph_lo = p; a.ph_hi = p + 1; hipLaunchKernelGGL(fwd_kernel, dim3(grid), dim3(NTHR), LDS_BYTES, stream, a); }
#endif
}
```

```cpp
#include <hip/hip_runtime.h>
#include <cstdio>
#include <cstdint>

#ifndef MK_N_LAUNCHES
#define MK_N_LAUNCHES 1
#endif

#define GAS __attribute__((address_space(1)))
#define LAS __attribute__((address_space(3)))
typedef unsigned short bf16;
typedef unsigned v4u __attribute__((ext_vector_type(4)));
typedef unsigned v2u __attribute__((ext_vector_type(2)));
typedef float f32x4 __attribute__((ext_vector_type(4)));
typedef float f32x2 __attribute__((ext_vector_type(2)));
typedef float f32x16 __attribute__((ext_vector_type(16)));
typedef short bf16x8 __attribute__((ext_vector_type(8)));
typedef short s16x4 __attribute__((ext_vector_type(4)));
typedef GAS unsigned gu32;
#define RLX_AGENT __ATOMIC_RELAXED, __HIP_MEMORY_SCOPE_AGENT
#define LDS_WAIT() asm volatile("s_waitcnt lgkmcnt(0)" ::: "memory")
#define VM_WAIT() asm volatile("s_waitcnt vmcnt(0)" ::: "memory")

constexpr int D = 2048, NB = 2, S = 8192, M = NB * S, CTX = 256, MC = NB * CTX, MT = M + MC;
constexpr int NH = 16, NKV = 4, HD = 128, NE = 64, FF = 512, TOPK = 8, NE1 = NE + 1;
constexpr int ECAP = 16384;
constexpr float EPS = 1e-6f;
constexpr float QSCALE = 0.08838834764831845f * 1.4426950408889634f;
constexpr float W1_SCALE = 64.0f, W2_SCALE = 32.0f, H2_SCALE = 16.0f, HID_SCALE = 8.0f, Y_SCALE = 16.0f;
constexpr int NCX_QKV = 0, NCX_MOE = 0;
constexpr int CVT_L0_P0 = 6240;
constexpr int CVT_L1_P7 = 2900;
constexpr float PW_SCALE = 16.0f, DP_SCALE = 16.0f; constexpr int SC_PW = 0x7b7b7b7b, SC_DP = 0x7b7b7b7b;
constexpr float O_SCALE = 32.0f; constexpr int SC_O = 0x7a7a7a7a;
constexpr int SC_W1 = 0x79797979, SC_W2 = 0x7a7a7a7a, SC_H2 = 0x7b7b7b7b, SC_HID = 0x7c7c7c7c;
constexpr int YROWS = M * 9 + 256;
constexpr unsigned Y_TRASH = (unsigned)M * 16384u;
constexpr int HID_TILES = 640;

constexpr size_t MiB = 1u << 20;
constexpr size_t WS_CTL = 0, CTL_ZERO_BYTES = 96 * 1024;
constexpr size_t WS_MOD = 1 * MiB;
constexpr size_t WS_ROPE = 2 * MiB;
constexpr size_t WS_WR = 3 * MiB;
constexpr size_t WS_RSTD2 = 7 * MiB;
constexpr size_t WS_SSQ = 5 * MiB;
constexpr size_t WS_TOK = 8 * MiB;
constexpr size_t WS_DST = 18 * MiB;
constexpr size_t WS_GW = 28 * MiB;
constexpr size_t LIST_L = 5 * MiB;
constexpr size_t WS_WQKV = 40 * MiB;
constexpr size_t WS_WO = 52 * MiB;
constexpr size_t WS_WPOOL = 60 * MiB;
constexpr size_t WS_W1 = 64 * MiB;
constexpr size_t WS_W2 = 584 * MiB;
constexpr size_t WS_ACTA = 844 * MiB;
constexpr size_t WS_ACTB = 910 * MiB;
constexpr size_t WS_ACTC = 974 * MiB;
constexpr size_t WS_KB = 1038 * MiB;
constexpr size_t WS_VT = 1055 * MiB;
constexpr size_t WS_X1 = 1072 * MiB;
constexpr size_t WS_X2 = 1136 * MiB;
constexpr size_t WS_HID = 1200 * MiB;
constexpr size_t WS_Y = 1360 * MiB;
constexpr size_t WS_END = 1940 * MiB;
static_assert(WS_Y + (size_t)YROWS * D * 2 <= WS_END, "ws map");
static_assert(WS_W1 + (size_t)2 * NE1 * 1024 * 2048 * 2 <= WS_W2 && WS_W2 + (size_t)2 * NE1 * 2048 * 512 * 2 <= WS_ACTA, "ws map");
constexpr int CW_BAR = 4096;
constexpr int CW_CVT = 12288;
constexpr int CW_PRO = 13312;
constexpr int CW_QKV = 13312 + 64;
constexpr int CW_CNT = 16384;

constexpr int RING_BYTES = 131072;
constexpr int GTL_OFF = RING_BYTES;
constexpr int TOFF_OFF = GTL_OFF + 1024;
constexpr int MISC_OFF = TOFF_OFF + 512;
constexpr int ETL_OFF = RING_BYTES + 2048;
constexpr int LDS_BYTES = 155648;

typedef __bf16 bf16x2n __attribute__((ext_vector_type(2)));
__device__ __forceinline__ unsigned cvt_pk_bf16_n(float lo, float hi) { const f32x2 v = {lo, hi}; return __builtin_bit_cast(unsigned, __builtin_convertvector(v, bf16x2n)); }
__device__ __forceinline__ unsigned cvt_pk_bf16(float lo, float hi) { return cvt_pk_bf16_n(lo, hi); }
__device__ __forceinline__ float clamp448(float x) { return __builtin_amdgcn_fmed3f(x, -448.0f, 448.0f); }
typedef short v2s_k __attribute__((ext_vector_type(2)));
__device__ __forceinline__ unsigned pk4_fp8(float a, float b, float c, float d) { v2s_k w = __builtin_bit_cast(v2s_k, a);
    w = __builtin_amdgcn_cvt_scalef32_pk_fp8_f32(w, a, b, 1.0f, false); w = __builtin_amdgcn_cvt_scalef32_pk_fp8_f32(w, c, d, 1.0f, true); return __builtin_bit_cast(unsigned, w); }
__device__ __forceinline__ float bf2f(unsigned short u) { return __uint_as_float((unsigned)u << 16); }
__device__ __forceinline__ float bflo(unsigned u) { return __uint_as_float(u << 16); }
__device__ __forceinline__ float bfhi(unsigned u) { return __uint_as_float(u & 0xffff0000u); }
#define DPPF(v, ctrl) __uint_as_float((unsigned)__builtin_amdgcn_update_dpp(0, (int)__float_as_uint(v), (ctrl), 0xf, 0xf, true))
__device__ __forceinline__ float grp8_max(float v) { v = fmaxf(v, DPPF(v, 0xB1)); v = fmaxf(v, DPPF(v, 0x4E)); v = fmaxf(v, DPPF(v, 0x141)); return v; }
__device__ __forceinline__ float wave_sum(float v) {
#pragma unroll
    for (int o = 1; o < 64; o <<= 1) v += __shfl_xor(v, o);
    return v;
}
__device__ __forceinline__ float fast_sigmoid(float x) { return __builtin_amdgcn_rcpf(1.0f + __builtin_amdgcn_exp2f(-1.4426950408889634f * x)); }

namespace pg8 {
constexpr int BM = 256, BK = 64, HALF = 128, HTB = HALF * BK * 2, STAGE_BYTES = 8 * HTB;
__host__ __device__ __forceinline__ int lds_byte(int r, int c) { const int st = (r >> 4) * 2 + (c >> 5), rr = r & 15, cc = c & 31, ob = rr * 64 + cc * 2; return st * 1024 + (ob ^ (((ob >> 9) & 1) << 5)); }
__host__ __device__ __forceinline__ void stage_rc(int b, int& R, int& C) { const int st = b / 1024, sb = b % 1024, swz = sb ^ (((sb >> 9) & 1) << 5); R = (st >> 1) * 16 + swz / 64; C = (st & 1) * 32 + (swz % 64) / 2; }
__host__ __device__ __forceinline__ int perm32(int rho) { const int n = rho >> 4, i = rho & 15; return 8 * (i >> 2) + 4 * n + (i & 3); }

struct GUnit { const char* A; const char* B; const unsigned* gtab; const unsigned* e0; const unsigned* e1; int i0, i1, i2, i3; };

typedef int v4i_t __attribute__((ext_vector_type(4)));
typedef int v8i_t __attribute__((ext_vector_type(8)));
__device__ __forceinline__ v8i_t cat8(const bf16x8 a, const bf16x8 b) { return __builtin_shufflevector(__builtin_bit_cast(v4i_t, a), __builtin_bit_cast(v4i_t, b), 0, 1, 2, 3, 4, 5, 6, 7); }
__device__ __forceinline__ void mfma_fp8(f32x4& acc, const v8i_t a, const v8i_t b, const int sa, const int sb) {
    asm volatile("v_mfma_scale_f32_16x16x128_f8f6f4 %0, %1, %2, %0, %3, %4 op_sel_hi:[0,0,0]" : "+v"(acc) : "v"(a), "v"(b), "v"(sa), "v"(sb)); }
template <class Epi, class Sched, bool GATHER, bool FP8 = false, int SCW = 0x7f7f7f7f, int SCA = 0x7f7f7f7f>
__device__ __forceinline__ void gemm_phase(LAS unsigned char* lds, LAS unsigned* gtl, const int K, const int lda, const int ldb, const Sched& S, const Epi& E) {
    LAS unsigned* etl = (LAS unsigned*)(lds + ETL_OFF);
    const int tid = threadIdx.x, wid = __builtin_amdgcn_readfirstlane(tid >> 6), lane = tid & 63, wr = wid >> 2, wc = wid & 3, fr = lane & 15, fq = lane >> 4;
    int nt = K / BK; asm volatile("" : "+s"(nt));
    unsigned roA[2][2], voffB[2][2];
    int RA[2], CA[2];
#pragma unroll
    for (int i = 0; i < 2; ++i) { int R, C; stage_rc(tid * 16 + i * 8192, R, C); const int Rb = Epi::PERM ? ((R & ~31) + perm32(R & 31)) : R;
        RA[i] = R; CA[i] = C * 2;
#pragma unroll
        for (int h = 0; h < 2; ++h) { roA[h][i] = (unsigned)((h * HALF + R) * lda + C) * 2u;
            const int p32 = perm32(R & 31); const int Bc = Epi::P16 ? (64 * (R >> 5) + 16 * (p32 >> 3) + 8 * h + (p32 & 7)) : (h * HALF + Rb);
            voffB[h][i] = (unsigned)(Bc * ldb + C) * 2u; } }
    const size_t kstep = (size_t)(BK * 2);
    const unsigned lda2 = (unsigned)lda * 2u;
    const unsigned ldsw = (unsigned)wid * 1024u;
    const int aoff = lds_byte(wr * 64 + fr, fq * 8), boff = lds_byte(wc * 32 + fr, fq * 8);
#define PG8_SA(b, h) (((b) * 2 + (h)) * HTB)
#define PG8_SB(b, h) ((4 + (b) * 2 + (h)) * HTB)
#define PG8_STAGE(bufoff, gbase, voff) do { const char* _gb = (const char*)(gbase); asm volatile("" : "+s"(_gb)); _Pragma("unroll") for (int _i = 0; _i < 2; ++_i) \
        __builtin_amdgcn_global_load_lds((const unsigned*)(_gb + (voff)[_i]), (LAS unsigned*)(lds + (bufoff) + ldsw + _i * 8192), 16, 0, 0); } while (0)
#define PG8_STAGE_A(bufoff, gbase, h) PG8_STAGE(bufoff, gbase, roA[h])
#define PG8_LDA(dst, b, h) do { _Pragma("unroll") for (int m = 0; m < 4; ++m) _Pragma("unroll") for (int k = 0; k < 2; ++k) dst[m][k] = *(const LAS bf16x8*)(lds + PG8_SA(b, h) + aoff + m * 2048 + k * 1024); } while (0)
#define PG8_LDB(dst, b, h) do { _Pragma("unroll") for (int n = 0; n < 2; ++n) _Pragma("unroll") for (int k = 0; k < 2; ++k) dst[n][k] = *(const LAS bf16x8*)(lds + PG8_SB(b, h) + boff + n * 2048 + k * 1024); } while (0)
#define PG8_MMA(ai, bj, At, Bt) do { __builtin_amdgcn_s_setprio(1); if constexpr (FP8) asm volatile("s_nop 1"); _Pragma("unroll") for (int m = 0; m < 4; ++m) _Pragma("unroll") for (int n = 0; n < 2; ++n) { \
        if constexpr (FP8) mfma_fp8(acc[ai][bj][m][n], cat8(Bt[n][0], Bt[n][1]), cat8(At[m][0], At[m][1]), SCW, SCA); \
        else { _Pragma("unroll") for (int k = 0; k < 2; ++k) acc[ai][bj][m][n] = __builtin_amdgcn_mfma_f32_16x16x32_bf16(Bt[n][k], At[m][k], acc[ai][bj][m][n], 0, 0, 0); } } __builtin_amdgcn_s_setprio(0); } while (0)
#define PG8_WAIT_V(n) asm volatile("s_waitcnt vmcnt(" #n ")" ::: "memory")
#define PG8_WAIT_L(n) asm volatile("s_waitcnt lgkmcnt(" #n ")" ::: "memory")
#define PG8_BAR __builtin_amdgcn_s_barrier()
#define PG8_SCHED __builtin_amdgcn_sched_barrier(0)
#define PG8_LOAD_RO() do { _Pragma("unroll") for (int _h = 0; _h < 2; ++_h) _Pragma("unroll") for (int _i = 0; _i < 2; ++_i) roA[_h][_i] = gtl[_h * HALF + RA[_i]] * lda2 + (unsigned)CA[_i]; } while (0)
    GUnit cur, nxt; int ui = 0;
    if (!S.next(0, cur)) return;
    f32x4 acc[2][2][4][2];
#pragma unroll
    for (int a = 0; a < 2; ++a)
#pragma unroll
        for (int b = 0; b < 2; ++b)
#pragma unroll
            for (int m = 0; m < 4; ++m)
#pragma unroll
                for (int n = 0; n < 2; ++n) acc[a][b][m][n] = (f32x4){0.f, 0.f, 0.f, 0.f};
    bf16x8 At[4][2], B0[2][2], B1[2][2];
    const char* cA = cur.A; const char* cB = cur.B;
    if constexpr (GATHER) {
        if (wid < 4) __builtin_amdgcn_global_load_lds((const unsigned*)(cur.gtab + wid * 64 + lane), (LAS unsigned*)(gtl + wid * 64), 4, 0, 0);
        PG8_WAIT_V(0); PG8_BAR; asm volatile("" ::: "memory");
        PG8_LOAD_RO();
        PG8_WAIT_L(0); PG8_BAR; asm volatile("" ::: "memory");
    }
    PG8_STAGE(PG8_SB(0, 0), cB, voffB[0]); PG8_STAGE(PG8_SB(0, 1), cB, voffB[1]); PG8_STAGE_A(PG8_SA(0, 0), cA, 0); PG8_STAGE_A(PG8_SA(0, 1), cA, 1);
    if (wr == 1) PG8_BAR;
    PG8_WAIT_V(2); PG8_BAR;
    PG8_STAGE(PG8_SB(1, 0), cB + kstep, voffB[0]); PG8_STAGE_A(PG8_SA(1, 0), cA + kstep, 0); PG8_STAGE(PG8_SB(1, 1), cB + kstep, voffB[1]);
    PG8_WAIT_V(6); PG8_BAR;
    for (;;) {
        const bool has_next = S.next(ui + 1, nxt);
        const char* nA = has_next ? nxt.A : cA; const char* nB = has_next ? nxt.B : cB;
#pragma unroll 1
        for (int t = 0; t < nt; t += 2) {
            const bool last = (t == nt - 2);
            asm volatile("" : "+v"(voffB[0][0]), "+v"(voffB[0][1]), "+v"(voffB[1][0]), "+v"(voffB[1][1]), "+v"(roA[0][0]), "+v"(roA[0][1]), "+v"(roA[1][0]), "+v"(roA[1][1]));
            const char* a1 = cA + (size_t)(t + 1) * kstep;
            const char* a2 = last ? nA : cA + (size_t)(t + 2) * kstep; const char* b2 = last ? nB : cB + (size_t)(t + 2) * kstep;
            const char* a3 = a2 + kstep; const char* b3 = b2 + kstep;
            if constexpr (Epi::ETAB) {
                if (t == 0) { const unsigned* src = (wid < 4) ? (cur.e0 + wid * 64 + lane) : (cur.e1 + (wid - 4) * 64 + lane);
                    __builtin_amdgcn_global_load_lds(src, (LAS unsigned*)(etl + (ui & 1) * 512 + wid * 64), 4, 0, 0); }
            }
            if constexpr (GATHER) {
                if (has_next && t == nt - 4 && wid < 4) __builtin_amdgcn_global_load_lds((const unsigned*)(nxt.gtab + wid * 64 + lane), (LAS unsigned*)(gtl + wid * 64), 4, 0, 0);
            }
            PG8_LDB(B0, 0, 0); PG8_LDB(B1, 0, 1); PG8_SCHED; PG8_LDA(At, 0, 0); PG8_STAGE_A(PG8_SA(1, 1), a1, 1);
            PG8_WAIT_V(8); PG8_WAIT_L(0); PG8_BAR; PG8_MMA(0, 0, At, B0); PG8_MMA(0, 1, At, B1); PG8_BAR; PG8_SCHED;
            if constexpr (GATHER) { if (last && has_next) { asm volatile("" ::: "memory"); PG8_LOAD_RO(); } }
            PG8_LDA(At, 0, 1); PG8_STAGE(PG8_SB(0, 0), b2, voffB[0]); PG8_STAGE(PG8_SB(0, 1), b2, voffB[1]); PG8_STAGE_A(PG8_SA(0, 0), a2, 0);
            PG8_WAIT_V(8); PG8_WAIT_L(0); PG8_BAR; PG8_MMA(1, 0, At, B0); PG8_MMA(1, 1, At, B1); PG8_BAR; PG8_SCHED;
            PG8_LDB(B0, 1, 0); PG8_LDB(B1, 1, 1); PG8_SCHED; PG8_LDA(At, 1, 0); PG8_STAGE_A(PG8_SA(0, 1), a2, 1);
            PG8_WAIT_V(8); PG8_WAIT_L(0); PG8_BAR; PG8_MMA(0, 0, At, B0); PG8_MMA(0, 1, At, B1); PG8_BAR; PG8_SCHED;
            PG8_LDA(At, 1, 1); PG8_STAGE(PG8_SB(1, 0), b3, voffB[0]); PG8_STAGE(PG8_SB(1, 1), b3, voffB[1]); PG8_STAGE_A(PG8_SA(1, 0), a3, 0);
            PG8_WAIT_V(8); PG8_WAIT_L(0); PG8_BAR; PG8_MMA(1, 0, At, B0); PG8_MMA(1, 1, At, B1); PG8_BAR; PG8_SCHED;
        }
        if (wr == 0) PG8_BAR;
        if constexpr (FP8) asm volatile("s_nop 15\n\ts_nop 15");
#pragma unroll
        for (int a = 0; a < 2; ++a)
#pragma unroll
            for (int b = 0; b < 2; ++b)
#pragma unroll
                for (int m = 0; m < 4; ++m)
#pragma unroll
                    for (int n = 0; n < 2; ++n) asm volatile("" : "+v"(acc[a][b][m][n]));
        E(acc, cur, wr, wc, fr, fq, etl + (ui & 1) * 512);
        if (!has_next) break;
#pragma unroll
        for (int a = 0; a < 2; ++a)
#pragma unroll
            for (int b = 0; b < 2; ++b)
#pragma unroll
                for (int m = 0; m < 4; ++m)
#pragma unroll
                    for (int n = 0; n < 2; ++n) acc[a][b][m][n] = (f32x4){0.f, 0.f, 0.f, 0.f};
        cur = nxt; cA = nA; cB = nB; ++ui;
        if (wr == 1) PG8_BAR;
    }
    PG8_WAIT_V(0);
    PG8_BAR;
#undef PG8_SA
#undef PG8_SB
#undef PG8_STAGE
#undef PG8_STAGE_A
#undef PG8_LDA
#undef PG8_LDB
#undef PG8_MMA
#undef PG8_WAIT_V
#undef PG8_WAIT_L
#undef PG8_BAR
#undef PG8_SCHED
#undef PG8_LOAD_RO
}
}

#define XB_TMO      128
#define XB_XCNT(j)  (256  + 64 * (j))
#define XB_XSUB(j)  (1280 + 64 * (j))
#define XB_XGEN(j)  (2304 + 64 * (j))
#define XB_TOP      3328
#define XB_TOPGEN   3392
#define XCD_BAR_WORDS 3456
#define XB_SPIN_CAP (1u << 18)

__device__ __forceinline__ unsigned xb_ld(unsigned* p)              { return __hip_atomic_load(p, __ATOMIC_RELAXED, __HIP_MEMORY_SCOPE_AGENT); }
__device__ __forceinline__ unsigned xb_add(unsigned* p, unsigned v) { return __hip_atomic_fetch_add(p, v, __ATOMIC_RELAXED, __HIP_MEMORY_SCOPE_AGENT); }
__device__ __forceinline__ unsigned xb_xcc_id() { return (unsigned)__builtin_amdgcn_s_getreg((3 << 11) | 20) & 0xFu; }
#define XB_SPIN(cond, bar) do { unsigned _sp = 0; while (cond) { __builtin_amdgcn_s_sleep(1); \
    if ((++_sp & 255u) == 0u) { if (xb_ld(&(bar)[XB_TMO])) break; if (_sp > XB_SPIN_CAP) { atomicAdd(&(bar)[XB_TMO], 1u); break; } } } } while (0)

struct XcdBarrier { unsigned* bar; unsigned x; volatile LAS unsigned* st; };

__device__ __forceinline__ XcdBarrier xcd_barrier_post(unsigned* bar, volatile LAS unsigned* st) {
    XcdBarrier b; b.bar = bar; b.x = xb_xcc_id(); b.st = st;
    if (threadIdx.x == 0) (void)xb_add(&bar[XB_XCNT(b.x)], 1u);
    return b;
}
__device__ __forceinline__ void xcd_barrier_complete(unsigned* bar, unsigned x, unsigned& nloc, unsigned& nx) {
    const unsigned G = gridDim.x * gridDim.y * gridDim.z;
    unsigned sum, cnt, mine, sp = 0u;
    for (;;) {
        sum = 0u; cnt = 0u; mine = 0u;
#pragma unroll
        for (unsigned j = 0; j < 16; ++j) { const unsigned c = xb_ld(&bar[XB_XCNT(j)]); sum += c; cnt += (c > 0u) ? 1u : 0u; mine = (j == x) ? c : mine; }
        if (sum == G) break;
        __builtin_amdgcn_s_sleep(1);
        if ((++sp & 255u) == 0u) { if (xb_ld(&bar[XB_TMO])) break; if (sp > XB_SPIN_CAP) { atomicAdd(&bar[XB_TMO], 1u); break; } }
    }
    nloc = mine > 0u ? mine : 1u; nx = cnt > 0u ? cnt : 1u;
}
__device__ __forceinline__ void xcd_barrier(const XcdBarrier& b) {
    asm volatile("s_waitcnt vmcnt(0)" ::: "memory");
    __syncthreads();
    if (threadIdx.x == 0) {
        unsigned* bar = b.bar;
        __builtin_amdgcn_s_waitcnt(0);
        unsigned nloc = b.st[0], nx = b.st[1];
        if (nloc == 0u) { xcd_barrier_complete(bar, b.x, nloc, nx); b.st[0] = nloc; b.st[1] = nx; }
        const unsigned old = xb_add(&bar[XB_XSUB(b.x)], 1u);
        const unsigned gen = old / nloc;
        if (old + 1u == (gen + 1u) * nloc) {
            __builtin_amdgcn_fence(__ATOMIC_RELEASE, "agent");
            asm volatile("s_waitcnt vmcnt(0)" ::: "memory");
            const unsigned og = xb_add(&bar[XB_TOP], 1u);
            const unsigned tg = og / nx;
            if (og + 1u == (tg + 1u) * nx) xb_add(&bar[XB_TOPGEN], 1u);
            else XB_SPIN(xb_ld(&bar[XB_TOPGEN]) == tg, bar);
            __builtin_amdgcn_fence(__ATOMIC_ACQUIRE, "agent");
            xb_add(&bar[XB_XGEN(b.x)], 1u);
            asm volatile("s_waitcnt vmcnt(0)" ::: "memory");
        } else {
            XB_SPIN(xb_ld(&bar[XB_XGEN(b.x)]) == gen, bar);
            __builtin_amdgcn_fence(__ATOMIC_ACQUIRE, "agent");
            asm volatile("s_waitcnt vmcnt(0)" ::: "memory");
        }
    }
    __syncthreads();
}

constexpr int NWAVES = 8, NTHR = 512;
struct Args { const float* in[23]; float* out; unsigned char* ws; int ph_lo, ph_hi; };
struct Frame {
    LAS unsigned char* lds;
    int tid, lane, wave, vcu, G;
    unsigned char* ws;
    const float* const* in;
};
struct Role { bool cvt; int rank, n; };
__device__ __forceinline__ Role cu_role(const Frame& F, int ncx) { Role r; if (F.G != 256) { r.cvt = false; r.rank = F.vcu; r.n = F.G; return r; }
    const int x = F.vcu >> 5, j = F.vcu & 31; r.cvt = j >= 32 - ncx; if (r.cvt) { r.rank = x * ncx + (j - (32 - ncx)); r.n = 8 * ncx; } else { r.rank = x * (32 - ncx) + j; r.n = 8 * (32 - ncx); } return r; }
enum { I_X = 0, I_C, I_CTX, I_CCTX, I_WADA, I_BADA, I_G1, I_G2, I_WQKV, I_GQ, I_GK, I_SINK, I_WO, I_WPOOL, I_PSCALE, I_WR, I_BR, I_WG, I_WU, I_WD, I_SG, I_SU, I_SD };

__device__ __forceinline__ unsigned f2bf(float f) { unsigned u = __builtin_bit_cast(unsigned, f); return (u + 0x7fffu + ((u >> 16) & 1u)) >> 16; }
__device__ __forceinline__ unsigned pk2(float lo, float hi) { return f2bf(lo) | (f2bf(hi) << 16); }
typedef short v4i16_t __attribute__((ext_vector_type(4)));
__device__ __forceinline__ void p0_transpose_item(const float* W, int N, bf16* WT, int ldt, int drow0, int k0, int n0, LAS unsigned char* scr, int lane) {
    constexpr int RS = 192;
    const int lk = lane >> 4, ln = (lane & 15) * 4;
    f32x4 v[16];
#pragma unroll
    for (int i = 0; i < 16; ++i) v[i] = *(const GAS f32x4*)(W + (size_t)(k0 + 4 * i + lk) * N + n0 + ln);
#pragma unroll
    for (int i = 0; i < 16; ++i) { v2u w; w.x = cvt_pk_bf16(v[i].x, v[i].y); w.y = cvt_pk_bf16(v[i].z, v[i].w); *(LAS v2u*)(scr + (4 * i + lk) * RS + ln * 2) = w; }
    LDS_WAIT(); asm volatile("" ::: "memory");
    const int g = lane >> 4, q = (lane >> 2) & 3, pp = lane & 3;
    const LAS unsigned char* rb = scr + q * RS + (16 * g + 4 * pp) * 2;
    bf16* orow = WT + (size_t)(drow0 + 16 * g + (lane & 15)) * ldt + k0;
#pragma unroll
    for (int j = 0; j < 8; ++j) {
        const v4i16_t a = __builtin_amdgcn_ds_read_tr16_b64_v4i16((LAS v4i16_t*)(rb + (8 * j) * RS)), b = __builtin_amdgcn_ds_read_tr16_b64_v4i16((LAS v4i16_t*)(rb + (8 * j + 4) * RS));
        const v2u a2 = __builtin_bit_cast(v2u, a), b2 = __builtin_bit_cast(v2u, b);
        *(GAS v4u*)(orow + 8 * j) = (v4u){a2.x, a2.y, b2.x, b2.y}; }
    LDS_WAIT(); asm volatile("" ::: "memory");
}

__host__ __device__ __forceinline__ int qk_hcol(int d) { const int f = d & 31; return (d & 64) + 16 * (f >> 3) + 8 * ((d >> 5) & 1) + (f & 7); }
struct CvtTile { const float* src; unsigned char* dst; int N, ldt, k0, n0, gu; float scale; };
__device__ __forceinline__ void cvt_decode(Frame& F, int l, int id, CvtTile& t) {
    if (l == 2) {
        if (id < 192) { t.src = F.in[I_WQKV]; t.dst = F.ws + WS_WQKV; t.N = 3072; t.k0 = (id / 12) * 128; t.n0 = (id % 12) * 256; t.gu = 3; }
        else if (id < 320) { const int r = id - 192; t.src = F.in[I_WO]; t.dst = F.ws + WS_WO; t.N = D; t.k0 = (r / 8) * 128; t.n0 = (r % 8) * 256; t.gu = 0; }
        else { const int r = id - 320, g = r >> 3, r2 = r & 7;
            t.src = F.in[I_WPOOL] + (size_t)g * 512 * 512; t.dst = F.ws + WS_WPOOL + (size_t)g * 512 * 512; t.N = 512; t.ldt = 512; t.k0 = (r2 >> 1) * 128; t.n0 = (r2 & 1) * 256; t.gu = 0; t.scale = PW_SCALE; return; }
        t.ldt = D; t.scale = W1_SCALE; return; }
    const int m = id >> 5, r = id & 31, type = m % 3, e = m / 3;
    if (type < 2) { t.src = (e < NE) ? (F.in[type == 0 ? I_WG : I_WU] + (size_t)(l * NE + e) * D * FF) : (F.in[type == 0 ? I_SG : I_SU] + (size_t)l * D * FF);
        t.dst = F.ws + WS_W1 + (size_t)(l * NE1 + e) * 1024 * D; t.N = FF; t.ldt = D; t.k0 = (r >> 1) * 128; t.n0 = (r & 1) * 256; t.gu = 1 + type; t.scale = (type == 0) ? W1_SCALE * 1.4426950408889634f : W1_SCALE * 0.6931471805599453f * HID_SCALE;
    } else { t.src = (e < NE) ? (F.in[I_WD] + (size_t)(l * NE + e) * FF * D) : (F.in[I_SD] + (size_t)l * FF * D);
        t.dst = F.ws + WS_W2 + (size_t)(l * NE1 + e) * D * FF; t.N = D; t.ldt = FF; t.k0 = (r >> 3) * 128; t.n0 = (r & 7) * 256; t.gu = 0; t.scale = W2_SCALE; }
}
__device__ __forceinline__ void cvt_load(const CvtTile& t, f32x4 (&v)[16], int wave, int lane) {
    const float* p = t.src + (size_t)(t.k0 + wave * 16) * t.N + t.n0 + lane * 4;
#pragma unroll
    for (int i = 0; i < 16; ++i) v[i] = __builtin_nontemporal_load((const GAS f32x4*)(p + (size_t)i * t.N));
}
__device__ __forceinline__ void cvt_finish(const CvtTile& t, const f32x4 (&v)[16], LAS unsigned char* img, int wave, int lane) {
    constexpr int RS = 576;
    const float scale = t.scale;
#pragma unroll
    for (int i = 0; i < 16; ++i) { v2u w; w.x = cvt_pk_bf16(v[i].x * scale, v[i].y * scale); w.y = cvt_pk_bf16(v[i].z * scale, v[i].w * scale); *(LAS v2u*)(img + (wave * 16 + i) * RS + lane * 8) = w; }
    LDS_WAIT(); __builtin_amdgcn_s_barrier(); asm volatile("" ::: "memory");
    const int g = lane >> 4, cb = g & 1, kh = g >> 1, q = (lane >> 2) & 3, pp = lane & 3;
    const int ncol = 32 * wave + 16 * cb + (lane & 15);
    const LAS unsigned char* rb = img + (64 * kh + q) * RS + (32 * wave + 16 * cb + 4 * pp) * 2;
    const int c = t.n0 + ncol; int drow = c;
    if (t.gu == 1 || t.gu == 2) drow = (c >> 7) * 256 + (c & 127) + (t.gu == 2 ? 128 : 0);
    else if (t.gu == 3 && c < 2560) { const int d = c & 127; drow = (c & ~127) + qk_hcol(d); }
    unsigned char* orow = t.dst + (size_t)drow * t.ldt + t.k0 + 64 * kh;
#pragma unroll
    for (int j = 0; j < 4; ++j) { v2u tt[4];
#pragma unroll
        for (int h = 0; h < 4; ++h) tt[h] = __builtin_bit_cast(v2u, __builtin_amdgcn_ds_read_tr16_b64_v4i16((LAS v4i16_t*)(rb + (16 * j + 4 * h) * RS)));
        v4u o;
        o.x = pk4_fp8(bflo(tt[0].x), bfhi(tt[0].x), bflo(tt[0].y), bfhi(tt[0].y)); o.y = pk4_fp8(bflo(tt[1].x), bfhi(tt[1].x), bflo(tt[1].y), bfhi(tt[1].y));
        o.z = pk4_fp8(bflo(tt[2].x), bfhi(tt[2].x), bflo(tt[2].y), bfhi(tt[2].y)); o.w = pk4_fp8(bflo(tt[3].x), bfhi(tt[3].x), bflo(tt[3].y), bfhi(tt[3].y));
        *(GAS v4u*)(orow + 16 * j) = o; }
    LDS_WAIT(); __builtin_amdgcn_s_barrier(); asm volatile("" ::: "memory");
}
constexpr int CVT_PER_LAYER = NE1 * 3 * 32;
__device__ __forceinline__ void convert_experts(Frame& F, const int l, const int lo, const int hi, const int brank, const int nb) {
    LAS unsigned char* img = F.lds;
    int id = lo + brank; if (id >= hi) return;
    __syncthreads();
    CvtTile ca, cb; f32x4 va[16], vb[16];
    cvt_decode(F, l, id, ca); cvt_load(ca, va, F.wave, F.lane);
    for (;;) {
        const int id1 = id + nb; const bool m1 = id1 < hi;
        if (m1) { cvt_decode(F, l, id1, cb); cvt_load(cb, vb, F.wave, F.lane); }
        cvt_finish(ca, va, img, F.wave, F.lane);
        if (!m1) break;
        const int id2 = id1 + nb; const bool m2 = id2 < hi;
        if (m2) { cvt_decode(F, l, id2, ca); cvt_load(ca, va, F.wave, F.lane); }
        cvt_finish(cb, vb, img, F.wave, F.lane);
        if (!m2) break;
        id = id2;
    }
}

constexpr int NDENSE = 352;
constexpr int CVT_ALL = NDENSE + 2 * CVT_PER_LAYER;
__device__ __forceinline__ void cvt_decode_all(Frame& F, int id, CvtTile& t) { if (id < NDENSE) cvt_decode(F, 2, id, t); else if (id < NDENSE + CVT_PER_LAYER) cvt_decode(F, 0, id - NDENSE, t); else cvt_decode(F, 1, id - NDENSE - CVT_PER_LAYER, t); }
__device__ __forceinline__ int cvt_publish(volatile LAS unsigned* slot, unsigned tk, int tid) {
    if (tid == 0) *slot = tk;
    LDS_WAIT(); __builtin_amdgcn_s_barrier(); asm volatile("" ::: "memory");
    const int id = (int)*slot;
    LDS_WAIT(); __builtin_amdgcn_s_barrier(); asm volatile("" ::: "memory");
    return __builtin_amdgcn_readfirstlane(id);
}
__device__ __forceinline__ void cvt_signal(Frame& F, const int id) {
    if (id < 192) {
        asm volatile("s_waitcnt vmcnt(0)" ::: "memory"); __syncthreads();
        if (F.tid == 0) { __builtin_amdgcn_fence(__ATOMIC_RELEASE, "agent"); asm volatile("s_waitcnt vmcnt(0)" ::: "memory"); __hip_atomic_fetch_add((unsigned*)(F.ws + WS_CTL) + CW_QKV, 1u, RLX_AGENT); }
    }
}
__device__ __forceinline__ void convert_all_dynamic(Frame& F, unsigned* ctr) {
    LAS unsigned char* img = F.lds; volatile LAS unsigned* slot = (volatile LAS unsigned*)(F.lds + MISC_OFF + 64);
    __syncthreads();
    unsigned tk0 = 0u, tk1 = 0u;
    if (F.tid == 0) { tk0 = __hip_atomic_fetch_add(ctr, 1u, RLX_AGENT); tk1 = __hip_atomic_fetch_add(ctr, 1u, RLX_AGENT); }
    CvtTile ca, cb; f32x4 va[16], vb[16];
    int ida = cvt_publish(slot, tk0, F.tid); if (ida >= CVT_ALL) return;
    cvt_decode_all(F, ida, ca); cvt_load(ca, va, F.wave, F.lane);
    for (;;) {
        const int idb = cvt_publish(slot, tk1, F.tid); if (F.tid == 0) tk1 = __hip_atomic_fetch_add(ctr, 1u, RLX_AGENT);
        const bool mb = idb < CVT_ALL;
        if (mb) { cvt_decode_all(F, idb, cb); cvt_load(cb, vb, F.wave, F.lane); }
        cvt_finish(ca, va, img, F.wave, F.lane); cvt_signal(F, ida);
        if (!mb) break;
        ida = cvt_publish(slot, tk1, F.tid); if (F.tid == 0) tk1 = __hip_atomic_fetch_add(ctr, 1u, RLX_AGENT);
        const bool ma = ida < CVT_ALL;
        if (ma) { cvt_decode_all(F, ida, ca); cvt_load(ca, va, F.wave, F.lane); }
        cvt_finish(cb, vb, img, F.wave, F.lane); cvt_signal(F, idb);
        if (!ma) break;
    }
}

__device__ __forceinline__ void p0_prologue(Frame& F) {
    const int gw = F.vcu * NWAVES + F.wave, NGW = F.G * NWAVES;
    const int gtid = gw * 64 + F.lane, NGT = NGW * 64;
    unsigned char* ws = F.ws;
    __syncthreads();
    if (F.vcu < 96) {
        const int l = F.vcu / 48, jg = F.vcu % 48, j0 = jg * 256;
        LAS float* sil = (LAS float*)F.lds;
        LAS float* red = (LAS float*)(F.lds + 24576);
        for (int i = F.tid; i < 3 * D; i += NTHR) { const int r = i / D, k = i % D; const float v = (r < 2) ? F.in[I_C][r * D + k] : F.in[I_CCTX][k]; sil[i] = v * fast_sigmoid(v); }
        __syncthreads();
        const float* wa = F.in[I_WADA] + (size_t)l * D * (6 * D) + j0 + F.lane * 4;
        f32x4 a0 = {0.f, 0.f, 0.f, 0.f}, a1 = a0, a2 = a0;
        const int kb = F.wave * 256;
#pragma unroll 8
        for (int k = 0; k < 256; ++k) { const f32x4 w = *(const GAS f32x4*)(wa + (size_t)(kb + k) * (6 * D)); const float s0 = sil[kb + k], s1 = sil[D + kb + k], s2 = sil[2 * D + kb + k]; a0 += w * s0; a1 += w * s1; a2 += w * s2; }
        *(LAS f32x4*)(red + (F.wave * 3 + 0) * 256 + F.lane * 4) = a0; *(LAS f32x4*)(red + (F.wave * 3 + 1) * 256 + F.lane * 4) = a1; *(LAS f32x4*)(red + (F.wave * 3 + 2) * 256 + F.lane * 4) = a2;
        __syncthreads();
        for (int i = F.tid; i < 768; i += NTHR) { const int r = i / 256, c = i % 256; float s = F.in[I_BADA][l * 6 * D + j0 + c];
#pragma unroll
            for (int w = 0; w < 8; ++w) s += red[(w * 3 + r) * 256 + c];
            ((float*)(ws + WS_MOD))[(size_t)(l * 3 + r) * 6 * D + j0 + c] = s; }
        __syncthreads();
    }
    for (int l = 0; l < 2; ++l) {
        v4u* t4 = (v4u*)(ws + WS_TOK + l * LIST_L); v4u* d4 = (v4u*)(ws + WS_DST + l * LIST_L);
        for (int i = gtid; i < NE * ECAP / 4; i += NGT) { t4[i] = (v4u){0u, 0u, 0u, 0u}; d4[i] = (v4u){Y_TRASH, Y_TRASH, Y_TRASH, Y_TRASH}; }
        unsigned* ts = (unsigned*)(ws + WS_TOK + l * LIST_L) + NE * ECAP; unsigned* ds = (unsigned*)(ws + WS_DST + l * LIST_L) + NE * ECAP; float* gs = (float*)(ws + WS_GW + l * LIST_L) + NE * ECAP;
        for (int i = gtid; i < M; i += NGT) { ts[i] = (unsigned)i; ds[i] = (unsigned)(i * 9 + 8 + 1); gs[i] = 1.0f; }
    }
    for (int i = gtid; i < 128 * 32; i += NGT) { const int p = i >> 5, f = i & 31; const float inv = powf(10000.0f, -(float)f / 32.0f); const float a = (float)p * inv;
        ((float*)(ws + WS_ROPE))[i] = cosf(a); ((float*)(ws + WS_ROPE))[4096 + i] = sinf(a); }
    for (int i = gtid; i < 2 * NE * D; i += NGT) { const int l = i / (NE * D), r = i % (NE * D), e = r / D, k = r % D; const float w = F.in[I_WR][((size_t)l * D + k) * NE + e];
        const unsigned hi = f2bf(w); const float lo = w - __uint_as_float(hi << 16);
        bf16* wr = (bf16*)(ws + WS_WR) + (size_t)l * 2 * NE * D; wr[e * D + k] = (bf16)hi; wr[NE * D + e * D + k] = (bf16)f2bf(lo); }
    LAS unsigned char* scr = F.lds + F.wave * 12288;
    __syncthreads();
    asm volatile("s_waitcnt vmcnt(0)" ::: "memory"); __syncthreads();
    if (F.tid == 0) { __builtin_amdgcn_fence(__ATOMIC_RELEASE, "agent"); asm volatile("s_waitcnt vmcnt(0)" ::: "memory"); __hip_atomic_fetch_add((unsigned*)(ws + WS_CTL) + CW_PRO, 1u, RLX_AGENT); }
}

struct ModVec { f32x4 a[8], b[8]; };
__device__ __forceinline__ void load_modvec(ModVec& mv, const float* gnorm, const float* shift, const float* scale, int lane) {
#pragma unroll
    for (int jj = 0; jj < 8; ++jj) { const int col = 4 * lane + 256 * jj;
        const f32x4 g = *(const GAS f32x4*)(gnorm + col), sc = *(const GAS f32x4*)(scale + col); mv.a[jj] = g * (sc + 1.0f); mv.b[jj] = *(const GAS f32x4*)(shift + col); }
}
__device__ __forceinline__ void norm_mod_store(const f32x4 (&v)[8], const ModVec& mv, bf16* orow, int lane) {
    float ss = 0.f;
#pragma unroll
    for (int jj = 0; jj < 8; ++jj) ss += (v[jj].x * v[jj].x + v[jj].y * v[jj].y) + (v[jj].z * v[jj].z + v[jj].w * v[jj].w);
    const float rstd = 1.0f / sqrtf(wave_sum(ss) * (1.0f / D) + EPS);
#pragma unroll
    for (int jj = 0; jj < 8; ++jj) { const f32x4 o = v[jj] * rstd * mv.a[jj] + mv.b[jj]; v2u w; w.x = cvt_pk_bf16(o.x, o.y); w.y = cvt_pk_bf16(o.z, o.w);
        *(GAS v2u*)(orow + 4 * lane + 256 * jj) = w; }
}
__device__ __forceinline__ void norm_mod_store_fp8(const f32x4 (&v)[8], const ModVec& mv, unsigned char* orow, int lane, float scale) {
    float ss = 0.f;
#pragma unroll
    for (int jj = 0; jj < 8; ++jj) ss += (v[jj].x * v[jj].x + v[jj].y * v[jj].y) + (v[jj].z * v[jj].z + v[jj].w * v[jj].w);
    const float rstd = 1.0f / sqrtf(wave_sum(ss) * (1.0f / D) + EPS);
#pragma unroll
    for (int jj = 0; jj < 8; ++jj) { const f32x4 o = (v[jj] * rstd * mv.a[jj] + mv.b[jj]) * scale; *(GAS unsigned*)(orow + 4 * lane + 256 * jj) = pk4_fp8(o.x, o.y, o.z, o.w); }
}
__device__ __forceinline__ const float* modp(Frame& F, int l, int r, int which) { return (const float*)(F.ws + WS_MOD) + (size_t)(l * 3 + r) * 6 * D + which * D; }

__device__ __forceinline__ void p1_norm1(Frame& F) {
    const int gw = F.vcu * NWAVES + F.wave, NGW = F.G * NWAVES;
    unsigned char* HN = F.ws + WS_ACTA;
    for (int rb = gw; rb < M / 8; rb += NGW) {
        const int row0 = rb * 8, b = row0 / S;
        ModVec mv; load_modvec(mv, F.in[I_G1], modp(F, 0, b, 0), modp(F, 0, b, 1), F.lane);
        for (int j = 0; j < 8; ++j) { const int row = row0 + j; f32x4 v[8];
#pragma unroll
            for (int jj = 0; jj < 8; ++jj) v[jj] = *(const GAS f32x4*)(F.in[I_X] + (size_t)row * D + 4 * F.lane + 256 * jj);
            norm_mod_store_fp8(v, mv, HN + (size_t)row * D, F.lane, H2_SCALE); }
    }
}

using pg8::GUnit;
struct SchedQK { const char* A; const char* B; int G, c, lim;
    __device__ __forceinline__ bool next(int i, GUnit& u) const { const int L = i * G + c; if (L >= lim) return false; int pm, pn; if (L < 640) { pm = L / 10; pn = L % 10; } else { pm = 64 + (L - 640) / 2; pn = 8 + (L - 640) % 2; }
        u.A = A + (size_t)pm * 256 * D; u.B = B + (size_t)pn * 256 * D; u.gtab = nullptr; u.e0 = nullptr; u.e1 = nullptr; u.i0 = pm; u.i1 = pn; u.i2 = 0; u.i3 = 0; return true; } };
struct EpiQK { static constexpr bool ETAB = false; static constexpr bool P16 = true; static constexpr bool PERM = true; bf16* Q; bf16* Kb; const float* gq; const float* gk; const float* rope; LAS float* xch;
    __device__ __forceinline__ void operator()(const f32x4 (&acc)[2][2][4][2], const GUnit& u, int wr, int wc, int fr, int fq, const LAS unsigned* et) const {
        const int pm = u.i0, pn = u.i1; bf16* base; int ldc, colt; const float* g; float scale;
        if (pn < 8) { base = Q; ldc = D; colt = pn * 256; g = gq; scale = QSCALE; } else { base = Kb; ldc = 512; colt = (pn - 8) * 256; g = gk; scale = 1.0f; }
        const int axis = wc & 1, rloc0 = wr * 64 + fr;
#pragma unroll
        for (int ai = 0; ai < 2; ++ai)
#pragma unroll
            for (int m = 0; m < 4; ++m) { float ss = 0.f;
#pragma unroll
                for (int bj = 0; bj < 2; ++bj)
#pragma unroll
                    for (int n = 0; n < 2; ++n) { const f32x4 x = acc[ai][bj][m][n]; ss += (x.x * x.x + x.y * x.y) + (x.z * x.z + x.w * x.w); }
                ss += __shfl_xor(ss, 16); ss += __shfl_xor(ss, 32);
                if (fq == 0) xch[(rloc0 + ai * 128 + m * 16) * 4 + wc] = ss; }
        const f32x4 g1a = *(const GAS f32x4*)(g + axis * 64 + 8 * fq), g1b = *(const GAS f32x4*)(g + axis * 64 + 8 * fq + 4), g2a = *(const GAS f32x4*)(g + axis * 64 + 32 + 8 * fq), g2b = *(const GAS f32x4*)(g + axis * 64 + 32 + 8 * fq + 4);
        asm volatile("s_waitcnt lgkmcnt(0)" ::: "memory"); __builtin_amdgcn_s_barrier(); asm volatile("" ::: "memory");
        const int row0 = pm * 256 + rloc0, col0 = colt + wc * 64 + 16 * fq; const bool lat = pm < 64;
#pragma unroll
        for (int ai = 0; ai < 2; ++ai)
#pragma unroll
            for (int m = 0; m < 4; ++m) { const int rl = rloc0 + ai * 128 + m * 16, row = row0 + ai * 128 + m * 16;
                const float r = 1.0f / sqrtf((xch[rl * 4 + wc] + xch[rl * 4 + (wc ^ 1)]) * (1.0f / HD) + EPS);
                f32x4 ca = {1.f, 1.f, 1.f, 1.f}, cb = ca, sa = {0.f, 0.f, 0.f, 0.f}, sb = sa;
                if (lat) { const int sq = row & (S - 1), pos = axis ? (sq & 63) : (sq >> 6); const float* rp = rope + pos * 32 + 8 * fq;
                    ca = *(const GAS f32x4*)rp; cb = *(const GAS f32x4*)(rp + 4); sa = *(const GAS f32x4*)(rp + 4096); sb = *(const GAS f32x4*)(rp + 4100); }
                const f32x4 y1a = acc[ai][0][m][0] * r * g1a, y1b = acc[ai][0][m][1] * r * g1b, y2a = acc[ai][1][m][0] * r * g2a, y2b = acc[ai][1][m][1] * r * g2b;
                const f32x4 o1a = (y1a * ca - y2a * sa) * scale, o1b = (y1b * cb - y2b * sb) * scale, o2a = (y2a * ca + y1a * sa) * scale, o2b = (y2b * cb + y1b * sb) * scale;
                bf16* rowp = base + (size_t)row * ldc + col0;
                v4u w; w.x = cvt_pk_bf16(o1a.x, o1a.y); w.y = cvt_pk_bf16(o1a.z, o1a.w); w.z = cvt_pk_bf16(o1b.x, o1b.y); w.w = cvt_pk_bf16(o1b.z, o1b.w); *(GAS v4u*)rowp = w;
                w.x = cvt_pk_bf16(o2a.x, o2a.y); w.y = cvt_pk_bf16(o2a.z, o2a.w); w.z = cvt_pk_bf16(o2b.x, o2b.y); w.w = cvt_pk_bf16(o2b.z, o2b.w); *(GAS v4u*)(rowp + 8) = w; }
    } };
struct SchedVT { const char* A; const char* B; int G, c, lim;
    __device__ __forceinline__ bool next(int i, GUnit& u) const { const int L = i * G + c; if (L >= lim) return false; const int pmv = L % 2, pnv = L / 2;
        u.A = A + (size_t)pmv * 256 * D; u.B = B + (size_t)pnv * 256 * D; u.gtab = nullptr; u.e0 = nullptr; u.e1 = nullptr; u.i0 = pmv; u.i1 = pnv; u.i2 = 0; u.i3 = 0; return true; } };
struct EpiVT { static constexpr bool ETAB = false; static constexpr bool P16 = true; static constexpr bool PERM = true; bf16* Vt;
    __device__ __forceinline__ void operator()(const f32x4 (&acc)[2][2][4][2], const GUnit& u, int wr, int wc, int fr, int fq, const LAS unsigned* et) const {
        const int row0 = u.i0 * 256 + wr * 64 + fr, col0 = u.i1 * 256 + wc * 64 + 16 * fq;
#pragma unroll
        for (int ai = 0; ai < 2; ++ai)
#pragma unroll
            for (int m = 0; m < 4; ++m) { bf16* rowp = Vt + (size_t)(row0 + ai * 128 + m * 16) * MT + col0;
#pragma unroll
                for (int h = 0; h < 2; ++h) { const f32x4 v0 = acc[ai][0][m][h], v1 = acc[ai][1][m][h]; v4u w; w.x = cvt_pk_bf16(v0[0], v0[1]); w.y = cvt_pk_bf16(v0[2], v0[3]); w.z = cvt_pk_bf16(v1[0], v1[1]); w.w = cvt_pk_bf16(v1[2], v1[3]);
                    *(GAS v4u*)(rowp + h * 8) = w; } }
    } };
struct SchedRes { const char* A; const char* B; int G, c, mode;
    __device__ __forceinline__ bool next(int i, GUnit& u) const { const int L = i * G + c; if (L >= 512) return false; const int pm = L / 8, pn = L % 8;
        if (mode == 0) { u.A = A + (size_t)pm * 256 * D; u.B = B + (size_t)pn * 256 * D; }
        else { const int g = pn / 2, p2 = pn % 2; u.A = A + (size_t)pm * 256 * D + (size_t)g * 512; u.B = B + ((size_t)g * 512 + p2 * 256) * 512; }
        u.gtab = nullptr; u.e0 = nullptr; u.e1 = nullptr; u.i0 = pm; u.i1 = pn; u.i2 = 0; u.i3 = 0; return true; } };
template <bool BASE_BF16> struct EpiRes { static constexpr bool ETAB = false; static constexpr bool P16 = true; static constexpr bool PERM = true; const void* base; bf16* out; const float* gate0; const float* gate1; const float* cs; float* ssq;
    __device__ __forceinline__ void operator()(const f32x4 (&acc)[2][2][4][2], const GUnit& u, int wr, int wc, int fr, int fq, const LAS unsigned* et) const {
        const int pm = u.i0, pn = u.i1; const float* gate = (pm < 32) ? gate0 : gate1;
        const int col0 = pn * 256 + wc * 64 + 16 * fq;
        f32x4 gv[2][2];
#pragma unroll
        for (int bj = 0; bj < 2; ++bj)
#pragma unroll
            for (int n = 0; n < 2; ++n) { gv[bj][n] = *(const GAS f32x4*)(gate + col0 + bj * 8 + n * 4); if (cs) gv[bj][n] = gv[bj][n] * *(const GAS f32x4*)(cs + col0 + bj * 8 + n * 4); }
        float sq[2][4];
#pragma unroll
        for (int ai = 0; ai < 2; ++ai) {
            f32x4 b[4][2][2];
#pragma unroll
            for (int m = 0; m < 4; ++m) { const size_t off = (size_t)(pm * 256 + ai * 128 + wr * 64 + m * 16 + fr) * D + col0;
#pragma unroll
                for (int bj = 0; bj < 2; ++bj) {
                    if constexpr (BASE_BF16) { const v4u r = *(const GAS v4u*)((const bf16*)base + off + bj * 8); b[m][bj][0] = __builtin_bit_cast(f32x4, r); }
                    else { b[m][bj][0] = *(const GAS f32x4*)((const float*)base + off + bj * 8); b[m][bj][1] = *(const GAS f32x4*)((const float*)base + off + bj * 8 + 4); } } }
#pragma unroll
            for (int m = 0; m < 4; ++m) { const size_t off = (size_t)(pm * 256 + ai * 128 + wr * 64 + m * 16 + fr) * D + col0; float s = 0.f;
#pragma unroll
                for (int bj = 0; bj < 2; ++bj) { f32x4 b0, b1;
                    if constexpr (BASE_BF16) { const v4u r = __builtin_bit_cast(v4u, b[m][bj][0]); b0 = (f32x4){bflo(r.x), bfhi(r.x), bflo(r.y), bfhi(r.y)}; b1 = (f32x4){bflo(r.z), bfhi(r.z), bflo(r.w), bfhi(r.w)}; }
                    else { b0 = b[m][bj][0]; b1 = b[m][bj][1]; }
                    const f32x4 o0 = b0 + gv[bj][0] * acc[ai][bj][m][0], o1 = b1 + gv[bj][1] * acc[ai][bj][m][1];
                    v4u w; w.x = cvt_pk_bf16(o0.x, o0.y); w.y = cvt_pk_bf16(o0.z, o0.w); w.z = cvt_pk_bf16(o1.x, o1.y); w.w = cvt_pk_bf16(o1.z, o1.w); *(GAS v4u*)(out + off + bj * 8) = w;
                    s += ((o0.x * o0.x + o0.y * o0.y) + (o0.z * o0.z + o0.w * o0.w)) + ((o1.x * o1.x + o1.y * o1.y) + (o1.z * o1.z + o1.w * o1.w)); }
                s += __shfl_xor(s, 16); s += __shfl_xor(s, 32); sq[ai][m] = s; } }
        if (fq == 0) {
#pragma unroll
            for (int ai = 0; ai < 2; ++ai)
#pragma unroll
                for (int m = 0; m < 4; ++m) ssq[(size_t)(pm * 256 + ai * 128 + wr * 64 + m * 16 + fr) * 32 + pn * 4 + wc] = sq[ai][m]; }
    } };
__device__ __forceinline__ int moe_expert_of(const LAS int* toff, int ti, int lane) {
    asm volatile("" : "+v"(lane));
    const int v = toff[lane + 1]; const unsigned long long bal = __ballot(v <= ti); return (int)__popcll(bal); }
struct SchedMoe1 { const char* A; const char* W1; const unsigned* tok; const LAS int* toff; int G, c, lane;
    __device__ __forceinline__ bool next(int i, GUnit& u) const { const int L = i * G + c, ti = L / 4, pn = L % 4; if (ti >= __builtin_amdgcn_readfirstlane(toff[65])) return false;
        const int e = __builtin_amdgcn_readfirstlane(moe_expert_of(toff, ti, lane)), tl = ti - __builtin_amdgcn_readfirstlane(toff[e]);
        u.A = A; u.B = W1 + ((size_t)e * 1024 + pn * 256) * D; u.gtab = tok + (size_t)e * ECAP + tl * 256; u.e0 = nullptr; u.e1 = nullptr; u.i0 = ti; u.i1 = pn; u.i2 = e; u.i3 = tl; return true; } };
struct EpiMoe1 { static constexpr bool ETAB = false; static constexpr bool P16 = false; static constexpr bool PERM = true; unsigned char* HID;
    __device__ __forceinline__ void operator()(const f32x4 (&acc)[2][2][4][2], const GUnit& u, int wr, int wc, int fr, int fq, const LAS unsigned* et) const {
        const int row0 = u.i0 * 256 + wr * 64 + fr, col0 = u.i1 * 128 + wc * 32 + 8 * fq;
#pragma unroll
        for (int ai = 0; ai < 2; ++ai)
#pragma unroll
            for (int m = 0; m < 4; ++m) { float h[8];
#pragma unroll
                for (int n = 0; n < 2; ++n)
#pragma unroll
                    for (int j = 0; j < 4; j += 2) {
                        const f32x2 G = {acc[ai][0][m][n][j], acc[ai][0][m][n][j + 1]}, U = {acc[ai][1][m][n][j], acc[ai][1][m][n][j + 1]};
                        f32x2 e = {__builtin_amdgcn_exp2f(-G[0]), __builtin_amdgcn_exp2f(-G[1])}; e += f32x2{1.0f, 1.0f};
                        const f32x2 r = {__builtin_amdgcn_rcpf(e[0]), __builtin_amdgcn_rcpf(e[1])}; const f32x2 hv = (G * U) * r; h[n * 4 + j] = hv[0]; h[n * 4 + j + 1] = hv[1]; }
                v2u w; w.x = pk4_fp8(h[0], h[1], h[2], h[3]); w.y = pk4_fp8(h[4], h[5], h[6], h[7]);
                *(GAS v2u*)(HID + (size_t)(row0 + ai * 128 + m * 16) * FF + col0) = w; }
    } };
struct SchedMoe2 { const char* A; const char* W2; const unsigned* dst; const float* gw; const LAS int* toff; int G, c, lane;
    __device__ __forceinline__ bool next(int i, GUnit& u) const { const int TT = __builtin_amdgcn_readfirstlane(toff[64]); const int R = (TT * 8 + G - 1) / G; if (i >= R) return false;
        const int rr = (i < R - 1) ? (R - 2 - i) : (R - 1); const int L = rr * G + c, ti = L / 8, pn = L % 8; if (ti >= TT) return false;
        const int e = __builtin_amdgcn_readfirstlane(moe_expert_of(toff, ti, lane)), tl = ti - __builtin_amdgcn_readfirstlane(toff[e]);
        u.A = A + (size_t)ti * 256 * FF; u.B = W2 + ((size_t)e * D + pn * 256) * FF; u.gtab = nullptr; u.e0 = dst + (size_t)e * ECAP + tl * 256; u.e1 = (const unsigned*)(gw + (size_t)e * ECAP + tl * 256); u.i0 = ti; u.i1 = pn; u.i2 = e; u.i3 = tl; return true; } };
struct EpiMoe2 { static constexpr bool ETAB = true; static constexpr bool P16 = true; static constexpr bool PERM = true; unsigned char* Y;
    __device__ __forceinline__ void operator()(const f32x4 (&acc)[2][2][4][2], const GUnit& u, int wr, int wc, int fr, int fq, const LAS unsigned* et) const {
        const int pn = u.i1; int r0 = wr * 64 + fr; asm volatile("" : "+v"(r0)); const int col0 = pn * 256 + wc * 64 + 16 * fq;
#pragma unroll
        for (int ai = 0; ai < 2; ++ai)
#pragma unroll
            for (int m = 0; m < 4; ++m) { const int r = r0 + ai * 128 + m * 16; const unsigned dv = et[r]; const float g = __uint_as_float(et[256 + r]);
                const unsigned off = dv + (unsigned)(pn * 2048 + wc * 64 + 16 * fq); v4u w;
                { const f32x4 v0 = acc[ai][0][m][0] * g, v1 = acc[ai][0][m][1] * g; w.x = pk4_fp8(v0[0], v0[1], v0[2], v0[3]); w.y = pk4_fp8(v1[0], v1[1], v1[2], v1[3]); }
                { const f32x4 v0 = acc[ai][1][m][0] * g, v1 = acc[ai][1][m][1] * g; w.z = pk4_fp8(v0[0], v0[1], v0[2], v0[3]); w.w = pk4_fp8(v1[0], v1[1], v1[2], v1[3]); }
                *(GAS v4u*)(Y + off) = w; }
    } };

__device__ __forceinline__ v4u qk_fix8(const v4u raw, const f32x4 g0, const f32x4 g1, const f32x4 c0, const f32x4 c1, const f32x4 s0, const f32x4 s1, int half, float scale) {
    f32x4 x0 = {bflo(raw.x), bfhi(raw.x), bflo(raw.y), bfhi(raw.y)}, x1 = {bflo(raw.z), bfhi(raw.z), bflo(raw.w), bfhi(raw.w)};
    float ss = ((x0.x * x0.x + x0.y * x0.y) + (x0.z * x0.z + x0.w * x0.w)) + ((x1.x * x1.x + x1.y * x1.y) + (x1.z * x1.z + x1.w * x1.w));
#pragma unroll
    for (int o = 1; o < 16; o <<= 1) ss += __shfl_xor(ss, o);
    const float r = 1.0f / sqrtf(ss * (1.0f / HD) + EPS);
    const f32x4 y0 = x0 * r * g0, y1 = x1 * r * g1;
    f32x4 p0, p1;
    p0.x = __shfl_xor(y0.x, 4); p0.y = __shfl_xor(y0.y, 4); p0.z = __shfl_xor(y0.z, 4); p0.w = __shfl_xor(y0.w, 4);
    p1.x = __shfl_xor(y1.x, 4); p1.y = __shfl_xor(y1.y, 4); p1.z = __shfl_xor(y1.z, 4); p1.w = __shfl_xor(y1.w, 4);
    const f32x4 o0 = (half ? (y0 * c0 + p0 * s0) : (y0 * c0 - p0 * s0)) * scale, o1 = (half ? (y1 * c1 + p1 * s1) : (y1 * c1 - p1 * s1)) * scale;
    v4u w; w.x = cvt_pk_bf16(o0.x, o0.y); w.y = cvt_pk_bf16(o0.z, o0.w); w.z = cvt_pk_bf16(o1.x, o1.y); w.w = cvt_pk_bf16(o1.z, o1.w); return w;
}
__device__ __forceinline__ void p3_qk_finalize(Frame& F) {
    const int gw = F.vcu * NWAVES + F.wave, NGW = F.G * NWAVES;
    const int c = F.lane & 15, hq = F.lane >> 4, axis = c >> 3, half = (c >> 2) & 1, f0 = 8 * (c & 3);
    const float* ropec = (const float*)(F.ws + WS_ROPE); const float* ropes = ropec + 4096;
    const f32x4 gq0 = *(const GAS f32x4*)(F.in[I_GQ] + 8 * c), gq1 = *(const GAS f32x4*)(F.in[I_GQ] + 8 * c + 4), gk0 = *(const GAS f32x4*)(F.in[I_GK] + 8 * c), gk1 = *(const GAS f32x4*)(F.in[I_GK] + 8 * c + 4);
    bf16* Q = (bf16*)(F.ws + WS_ACTB); bf16* Kb = (bf16*)(F.ws + WS_KB);
    for (int row = gw; row < MT; row += NGW) {
        const bool lat = row < M; const int s = row & (S - 1); const int pos = axis ? (s & 63) : (s >> 6);
        f32x4 c0 = {1.f, 1.f, 1.f, 1.f}, c1 = c0, s0 = {0.f, 0.f, 0.f, 0.f}, s1 = s0;
        bf16* kp = Kb + (size_t)row * 512 + hq * HD + 8 * c;
        const v4u kr = *(const GAS v4u*)kp;
        if (lat) {
            c0 = *(const GAS f32x4*)(ropec + pos * 32 + f0); c1 = *(const GAS f32x4*)(ropec + pos * 32 + f0 + 4); s0 = *(const GAS f32x4*)(ropes + pos * 32 + f0); s1 = *(const GAS f32x4*)(ropes + pos * 32 + f0 + 4);
            bf16* qp = Q + (size_t)row * D + hq * HD + 8 * c;
            v4u qr[4];
#pragma unroll
            for (int it = 0; it < 4; ++it) qr[it] = *(const GAS v4u*)(qp + it * 512);
#pragma unroll
            for (int it = 0; it < 4; ++it) qr[it] = qk_fix8(qr[it], gq0, gq1, c0, c1, s0, s1, half, QSCALE);
#pragma unroll
            for (int it = 0; it < 4; ++it) *(GAS v4u*)(qp + it * 512) = qr[it];
        }
        *(GAS v4u*)kp = qk_fix8(kr, gk0, gk1, c0, c1, s0, s1, half, 1.0f);
    }
}

#define ATT_PROBE_FAKE -1
#define ATT_THR 8.0f
#define ATT_PROBE_FAKE2 -1
#define ATT_PROBE_SPLIT ((wid & 1) == 0)
#define ATT_PROBE_QK 0
#define ATT_PROBE_PV 0
__device__ __forceinline__ void p4_attention(Frame& F) {
    const bf16* Q = (const bf16*)(F.ws + WS_ACTB); const bf16* Kb = (const bf16*)(F.ws + WS_KB); const bf16* Vt = (const bf16*)(F.ws + WS_VT); unsigned char* O = F.ws + WS_ACTC;
    LAS unsigned char* lds = F.lds;
    const int wid = F.wave;
    for (int u = F.vcu; u < 1024; u += F.G) {
        int tq = F.tid; asm volatile("" : "+v"(tq));
        const int r32 = tq & 31, hi = (tq >> 5) & 1;
        const unsigned voffK = (unsigned)(((tq >> 4) * 512 + (((tq & 15) ^ ((tq >> 4) & 15)) * 8)) * 2), voffV = (unsigned)(((tq >> 3) * MT + (((tq & 7) ^ ((tq >> 4) & 7)) * 8)) * 2);
        const int b = u >> 9, rem = u & 511, n = rem >> 3, kvh = (rem >> 1) & 3, hp = rem & 1;
        const int head = kvh * 4 + hp * 2 + ((wid & 3) >> 1);
        const int qloc0 = n * 128 + ((wid & 1) + 2 * (wid >> 2)) * 32;
        const size_t qrow = (size_t)b * S + qloc0 + r32;
        bf16x8 qf[8];
#pragma unroll
        for (int ds = 0; ds < 8; ++ds) qf[ds] = *(const GAS bf16x8*)(Q + qrow * D + head * HD + 16 * ds + 8 * hi);
        const int kstart = (n == 0) ? 0 : n * 128 - 128, kend = (n == 63) ? S : n * 128 + 256, nloc = (kend - kstart) >> 6, NT = nloc + 4;
        float mrun = F.in[I_SINK][head] * 1.4426950408889634f, lrun = (hi == 0) ? 1.0f : 0.0f;
        f32x16 o[4];
#pragma unroll
        for (int db = 0; db < 4; ++db)
#pragma unroll
            for (int r = 0; r < 16; ++r) o[db][r] = 0.f;
#define ATT_DMA(t) do { const int _t = (t); const int _kr0 = (_t < nloc) ? (b * S + kstart + 64 * _t) : (M + b * CTX + 64 * (_t - nloc)); const int _sl = (_t & 3) * 32768; \
            _Pragma("unroll") for (int _i = 0; _i < 2; ++_i) { \
                { const char* _gb = (const char*)(Kb + (size_t)(_kr0 + 32 * _i) * 512 + kvh * HD); asm volatile("" : "+s"(_gb)); __builtin_amdgcn_global_load_lds((const unsigned*)(_gb + voffK), (LAS unsigned*)(lds + _sl + (_i * 512 + wid * 64) * 16), 16, 0, 0); } \
                { const char* _gb = (const char*)(Vt + (size_t)(kvh * HD + 64 * _i) * MT + _kr0); asm volatile("" : "+s"(_gb)); __builtin_amdgcn_global_load_lds((const unsigned*)(_gb + voffV), (LAS unsigned*)(lds + _sl + 16384 + (_i * 512 + wid * 64) * 16), 16, 0, 0); } } } while (0)
#define ATT_NEED(t) (((t) >= nloc) || ((kstart + 64 * (t) + 63 >= qloc0 - 128) && (kstart + 64 * (t) <= qloc0 + 31 + 128)))
#define ATT_KREAD(t) do { int _kbt = lbK + ((t) & 3) * 32768; asm volatile("" : "+v"(_kbt)); \
            _Pragma("unroll") for (int kb = 0; kb < 2; ++kb) _Pragma("unroll") for (int ds = 0; ds < 8; ++ds) kf[kb * 8 + ds] = *(const LAS bf16x8*)(lds + ((_kbt ^ (ds << 5)) + kb * 8192)); } while (0)
        const int lbK = r32 * 256 + (((r32 & 15) ^ hi) << 4);
        const int lbV = r32 * 128 + ((((r32 >> 1) & 7) ^ hi) << 4);
        auto pass = [&](auto FLc) __attribute__((always_inline)) {
        constexpr int FL = decltype(FLc)::value;
        constexpr bool real_ = (FL & 128) != 0;
        asm volatile("s_waitcnt vmcnt(0)" ::: "memory"); __builtin_amdgcn_s_barrier();
        if (real_) { ATT_DMA(0); ATT_DMA(1); ATT_DMA(2); }
        asm volatile("s_waitcnt vmcnt(8)" ::: "memory"); __builtin_amdgcn_s_barrier(); asm volatile("" ::: "memory");
        bf16x8 kf[16];
        if constexpr (FL & 16) { ATT_KREAD(0); } else { _Pragma("unroll") for (int i = 0; i < 16; ++i) asm volatile("" : "=v"(kf[i])); }
#pragma unroll 1
        for (int t = 0; t < NT; ++t) {
            if (t + 2 < NT) asm volatile("s_waitcnt vmcnt(4)" ::: "memory"); else asm volatile("s_waitcnt vmcnt(0)" ::: "memory");
            if constexpr (FL & 64) __builtin_amdgcn_s_barrier();
            asm volatile("" ::: "memory");
            if (real_ && t + 3 < NT) ATT_DMA(t + 3);
            if (ATT_NEED(t)) {
            f32x16 p[2];
            if constexpr (FL & 1) {
#pragma unroll
                for (int kb = 0; kb < 2; ++kb) {
#pragma unroll
                    for (int r = 0; r < 16; ++r) p[kb][r] = 0.f;
                }
#pragma unroll
                for (int ds = 0; ds < 8; ++ds)
#pragma unroll
                    for (int kb = 0; kb < 2; ++kb) p[kb] = __builtin_amdgcn_mfma_f32_32x32x16_bf16(kf[kb * 8 + ds], qf[ds], p[kb], 0, 0, 0);
            } else {
#pragma unroll
                for (int i = 0; i < 16; ++i) asm volatile("" :: "v"(kf[i]));
#pragma unroll
                for (int kb = 0; kb < 2; ++kb) asm volatile("" : "=v"(p[kb]));
            }
            __builtin_amdgcn_sched_barrier(0);
            bf16x8 vf[4][4];
            if constexpr (FL & 2) {   int vbt = lbV + (t & 3) * 32768 + 16384; asm volatile("" : "+v"(vbt));
#pragma unroll
                for (int db = 0; db < 4; ++db)
#pragma unroll
                    for (int g = 0; g < 4; ++g) vf[db][g] = *(const LAS bf16x8*)(lds + ((vbt ^ (g << 5)) + db * 4096));
            } else {
#pragma unroll
                for (int db = 0; db < 4; ++db)
#pragma unroll
                    for (int g = 0; g < 4; ++g) asm volatile("" : "=v"(vf[db][g]));
            }
            __builtin_amdgcn_sched_barrier(0);
            if constexpr (FL & 32) {
                const int kloc0 = kstart + 64 * t;
                if (t < nloc && !((kloc0 >= qloc0 + 31 - 128) && (kloc0 + 63 <= qloc0 + 128))) {
                    const int q = qloc0 + r32;
#pragma unroll
                    for (int kb = 0; kb < 2; ++kb)
#pragma unroll
                        for (int r = 0; r < 16; ++r) { const int key = kloc0 + 32 * kb + (r & 3) + 8 * (r >> 2) + 4 * hi; const int dlt = key - q; if (dlt > 128 || dlt < -128) p[kb][r] = -INFINITY; }
                }
            }
            bf16x8 pb[2][2];
            if constexpr (FL & 4) {
                float mq[4];
#pragma unroll
                for (int i = 0; i < 4; ++i) { const int kb = i >> 1, r0 = 8 * (i & 1);
                    float m = fmaxf(fmaxf(p[kb][r0], p[kb][r0 + 1]), p[kb][r0 + 2]); m = fmaxf(fmaxf(m, p[kb][r0 + 3]), p[kb][r0 + 4]); m = fmaxf(fmaxf(m, p[kb][r0 + 5]), p[kb][r0 + 6]); mq[i] = fmaxf(m, p[kb][r0 + 7]); }
                float mx = fmaxf(fmaxf(fmaxf(mq[0], mq[1]), mq[2]), mq[3]);
                float mb = mx; asm volatile("s_nop 1\n\tv_permlane32_swap_b32 %0, %1" : "+v"(mx), "+v"(mb));
                mx = fmaxf(mx, mb);
                const bool grow = mx > mrun + ATT_THR;
                if (__builtin_amdgcn_ballot_w64(grow) != 0ull) {
                    const float mnew = grow ? mx : mrun, alpha = __builtin_amdgcn_exp2f(mrun - mnew);
                    mrun = mnew; lrun *= alpha;
#pragma unroll
                    for (int db = 0; db < 4; ++db)
#pragma unroll
                        for (int r = 0; r < 16; r += 2) { f32x2 d = {o[db][r], o[db][r + 1]}; d *= f32x2{alpha, alpha}; o[db][r] = d[0]; o[db][r + 1] = d[1]; }
                }
                const f32x2 mn2 = {mrun, mrun};
                f32x2 ls2[4] = {{0.f, 0.f}, {0.f, 0.f}, {0.f, 0.f}, {0.f, 0.f}};
#pragma unroll
                for (int kb = 0; kb < 2; ++kb)
#pragma unroll
                    for (int r = 0; r < 16; r += 2) { f32x2 d = {p[kb][r], p[kb][r + 1]}; d -= mn2; d[0] = __builtin_amdgcn_exp2f(d[0]); d[1] = __builtin_amdgcn_exp2f(d[1]);
                        p[kb][r] = d[0]; p[kb][r + 1] = d[1]; ls2[(r >> 1) & 3] += d; }
                const f32x2 lsum = (ls2[0] + ls2[1]) + (ls2[2] + ls2[3]);
                const float ls = lsum[0] + lsum[1];
                lrun += ls;
#pragma unroll
                for (int kb = 0; kb < 2; ++kb)
#pragma unroll
                    for (int s2 = 0; s2 < 2; ++s2) { v4u w; w.x = cvt_pk_bf16_n(p[kb][8 * s2 + 0], p[kb][8 * s2 + 1]); w.y = cvt_pk_bf16_n(p[kb][8 * s2 + 2], p[kb][8 * s2 + 3]);
                        w.z = cvt_pk_bf16_n(p[kb][8 * s2 + 4], p[kb][8 * s2 + 5]); w.w = cvt_pk_bf16_n(p[kb][8 * s2 + 6], p[kb][8 * s2 + 7]); pb[kb][s2] = __builtin_bit_cast(bf16x8, w); }
            } else {
#pragma unroll
                for (int kb = 0; kb < 2; ++kb) asm volatile("" :: "v"(p[kb]));
#pragma unroll
                for (int kb = 0; kb < 2; ++kb)
#pragma unroll
                    for (int s2 = 0; s2 < 2; ++s2) asm volatile("" : "=v"(pb[kb][s2]));
            }
            if constexpr (FL & 8) {
#pragma unroll
                for (int kb = 0; kb < 2; ++kb)
#pragma unroll
                    for (int s2 = 0; s2 < 2; ++s2)
#pragma unroll
                        for (int db = 0; db < 4; ++db) o[db] = __builtin_amdgcn_mfma_f32_32x32x16_bf16(vf[db][2 * kb + s2], pb[kb][s2], o[db], 0, 0, 0);
            } else {
#pragma unroll
                for (int db = 0; db < 4; ++db)
#pragma unroll
                    for (int g = 0; g < 4; ++g) asm volatile("" :: "v"(vf[db][g]));
#pragma unroll
                for (int kb = 0; kb < 2; ++kb)
#pragma unroll
                    for (int s2 = 0; s2 < 2; ++s2) asm volatile("" :: "v"(pb[kb][s2]));
            }
            }
            __builtin_amdgcn_sched_barrier(0);
            if constexpr (FL & 16) { ATT_KREAD(t + 1); }
            else { _Pragma("unroll") for (int i = 0; i < 16; ++i) asm volatile("" : "=v"(kf[i])); }
        }
        };
#if ATT_PROBE_FAKE >= 0
        if (ATT_PROBE_SPLIT) pass(std::integral_constant<int, ATT_PROBE_FAKE>{}); else pass(std::integral_constant<int, ATT_PROBE_FAKE2>{});
#pragma unroll
        for (int db = 0; db < 4; ++db)
#pragma unroll
            for (int r = 0; r < 16; ++r) { asm volatile("" :: "v"(o[db][r])); o[db][r] = 0.f; }
        asm volatile("" :: "v"(lrun)); mrun = F.in[I_SINK][head] * 1.4426950408889634f; lrun = (hi == 0) ? 1.0f : 0.0f;
#endif
        pass(std::integral_constant<int, 255>{});
#undef ATT_KREAD
#undef ATT_DMA
#undef ATT_NEED
        float lb_ = lrun; asm volatile("s_nop 1\n\tv_permlane32_swap_b32 %0, %1" : "+v"(lrun), "+v"(lb_));
        const float ltot = lrun + lb_, inv = O_SCALE / ltot;
        int tq2 = F.tid; asm volatile("" : "+v"(tq2));
        unsigned char* orow = O + ((size_t)b * S + qloc0 + (tq2 & 31)) * D + head * HD + 16 * ((tq2 >> 5) & 1);
#pragma unroll
        for (int db = 0; db < 4; ++db) { unsigned wq[4];
#pragma unroll
            for (int g = 0; g < 4; ++g) wq[g] = pk4_fp8(o[db][4 * g] * inv, o[db][4 * g + 1] * inv, o[db][4 * g + 2] * inv, o[db][4 * g + 3] * inv);
            asm volatile("s_nop 1\n\tv_permlane32_swap_b32 %0, %1" : "+v"(wq[0]), "+v"(wq[2]));
            asm volatile("s_nop 1\n\tv_permlane32_swap_b32 %0, %1" : "+v"(wq[1]), "+v"(wq[3]));
            *(GAS v4u*)(orow + 32 * db) = (v4u){wq[0], wq[2], wq[1], wq[3]}; }
    }
}

typedef int v4i_k __attribute__((ext_vector_type(4)));
__device__ __forceinline__ float rdlane(float v, int l) { return __uint_as_float(__builtin_amdgcn_readlane(__float_as_uint(v), l)); }
#define ROUTE_PROBE_REP 1
__device__ __forceinline__ void moe_route(Frame& F, const int l) {
    const bf16* X1 = (const bf16*)(F.ws + WS_X1); const float* SSQ = (const float*)(F.ws + WS_SSQ); unsigned char* H2 = F.ws + WS_ACTA;
    const bf16* WRh = (const bf16*)(F.ws + WS_WR) + (size_t)l * 2 * NE * D; const bf16* WRl = WRh + NE * D;
    unsigned* tokl = (unsigned*)(F.ws + WS_TOK + l * LIST_L); unsigned* dstl = (unsigned*)(F.ws + WS_DST + l * LIST_L); float* gwl = (float*)(F.ws + WS_GW + l * LIST_L);
    unsigned* cntg = (unsigned*)(F.ws + WS_CTL) + CW_CNT + l * 64 * 64;
    LAS unsigned char* lds = F.lds;
    constexpr int AH = 0, AL = 32768, LOG = 65536, PEND = 98304, LCNT = 102400, LBASE = 102656;
    const int tid = F.tid, lane = F.lane, w = F.wave;
    for (int tb = F.vcu; tb < M / 64; tb += F.G) {
        const int row0 = tb * 64, b = row0 / S;
        if (tid < 64) ((LAS unsigned*)(lds + LCNT))[tid] = 0u;
        float rstd[8];
#pragma unroll
        for (int j = 0; j < 8; ++j) { const int row = row0 + 8 * w + j; const float v = (lane < 32) ? SSQ[(size_t)row * 32 + lane] : 0.f; rstd[j] = 1.0f / sqrtf(wave_sum(v) * (1.0f / D) + EPS); }
        const float* g2 = F.in[I_G2] + l * D; const float* sh2 = modp(F, l, b, 3); const float* sc2 = modp(F, l, b, 4);
        const int nt = w & 3, kh = w >> 2, r16 = lane & 15, kq = lane >> 4;
        f32x4 acc[4];
#pragma unroll 1
        for (int rep_ = 0; rep_ < ROUTE_PROBE_REP; ++rep_) {
        if (rep_) { _Pragma("unroll") for (int mt = 0; mt < 4; ++mt) asm volatile("" :: "v"(acc[mt])); }
#pragma unroll
        for (int mt = 0; mt < 4; ++mt) acc[mt] = (f32x4){0.f, 0.f, 0.f, 0.f};
        v2u xc[8], xn[8];
#pragma unroll
        for (int j = 0; j < 8; ++j) { xc[j] = *(const GAS v2u*)(X1 + (size_t)(row0 + 8 * w + j) * D + 4 * lane); xn[j] = *(const GAS v2u*)(X1 + (size_t)(row0 + 8 * w + j) * D + 4 * lane + 256); }
        const unsigned lo16 = (unsigned)lane * 16u;
#define ROUTE_MODLD(kcn) do { const char* _a = (const char*)g2 + (kcn) * 1024; const char* _b = (const char*)sc2 + (kcn) * 1024; const char* _c = (const char*)sh2 + (kcn) * 1024; asm volatile("" : "+s"(_a), "+s"(_b), "+s"(_c)); \
            g2n = *(const GAS f32x4*)(_a + lo16); sc2n = *(const GAS f32x4*)(_b + lo16); sh2n = *(const GAS f32x4*)(_c + lo16); } while (0)
        f32x4 g2n, sc2n, sh2n; ROUTE_MODLD(0);
#pragma unroll 1
        for (int kc = 0; kc < 8; ++kc) {
            const int k0 = kc * 256 + 4 * lane;
            const f32x4 av = g2n * (sc2n + 1.0f), bv = sh2n;
            if (kc < 7) ROUTE_MODLD(kc + 1);
            v2u xnn[8];
            if (kc < 6) {
#pragma unroll
                for (int j = 0; j < 8; ++j) xnn[j] = *(const GAS v2u*)(X1 + (size_t)(row0 + 8 * w + j) * D + k0 + 512);
            }
            bf16x8 wbh[4], wbl[4];
#pragma unroll
            for (int ks4 = 0; ks4 < 4; ++ks4) { const size_t wo = (size_t)(16 * nt + r16) * D + kc * 256 + 32 * (kh * 4 + ks4) + 8 * kq; wbh[ks4] = *(const GAS bf16x8*)(WRh + wo); wbl[ks4] = *(const GAS bf16x8*)(WRl + wo); }
#pragma unroll
            for (int j = 0; j < 8; ++j) { const int rl = 8 * w + j, row = row0 + rl;
                const f32x4 xf = {bflo(xc[j].x), bfhi(xc[j].x), bflo(xc[j].y), bfhi(xc[j].y)}; const f32x4 h = xf * rstd[j] * av + bv;
                v2u hh; hh.x = cvt_pk_bf16(h.x, h.y); hh.y = cvt_pk_bf16(h.z, h.w);
                *(GAS unsigned*)(H2 + (size_t)row * D + k0) = pk4_fp8(h.x * H2_SCALE, h.y * H2_SCALE, h.z * H2_SCALE, h.w * H2_SCALE);
                const f32x4 lo = {h.x - bflo(hh.x), h.y - bfhi(hh.x), h.z - bflo(hh.y), h.w - bfhi(hh.y)};
                v2u ll; ll.x = cvt_pk_bf16(lo.x, lo.y); ll.y = cvt_pk_bf16(lo.z, lo.w);
                const int off = rl * 512 + ((((lane >> 1) ^ (rl & 15))) << 4) + 8 * (lane & 1);
                *(LAS v2u*)(lds + AH + off) = hh; *(LAS v2u*)(lds + AL + off) = ll; }
#pragma unroll
            for (int j = 0; j < 8; ++j) { xc[j] = xn[j]; if (kc < 6) xn[j] = xnn[j]; }
            asm volatile("s_waitcnt lgkmcnt(0)" ::: "memory"); __builtin_amdgcn_s_barrier(); asm volatile("" ::: "memory");
#pragma unroll
            for (int ks4 = 0; ks4 < 4; ++ks4) { const int ks = kh * 4 + ks4;
                const bf16x8 bh = wbh[ks4], bl = wbl[ks4];
#pragma unroll
                for (int mt = 0; mt < 4; ++mt) { const int row = 16 * mt + r16; const int off = row * 512 + (((4 * ks + kq) ^ (row & 15)) << 4);
                    const bf16x8 ah = *(const LAS bf16x8*)(lds + AH + off), al = *(const LAS bf16x8*)(lds + AL + off);
                    acc[mt] = __builtin_amdgcn_mfma_f32_16x16x32_bf16(ah, bh, acc[mt], 0, 0, 0);
                    acc[mt] = __builtin_amdgcn_mfma_f32_16x16x32_bf16(ah, bl, acc[mt], 0, 0, 0);
                    acc[mt] = __builtin_amdgcn_mfma_f32_16x16x32_bf16(al, bh, acc[mt], 0, 0, 0); } }
            asm volatile("s_waitcnt lgkmcnt(0)" ::: "memory"); __builtin_amdgcn_s_barrier(); asm volatile("" ::: "memory");
        }
        }
        int tid_o = F.tid; asm volatile("" : "+v"(tid_o));
        { const int tid = tid_o, lane = tid_o & 63, r16 = lane & 15, kq = lane >> 4;
        LAS float* logp = (LAS float*)(lds + LOG);
#pragma unroll
        for (int mt = 0; mt < 4; ++mt)
#pragma unroll
            for (int r = 0; r < 4; ++r) logp[kh * 4096 + (16 * mt + 4 * kq + r) * 64 + 16 * nt + r16] = acc[mt][r];
        __syncthreads();
        const float br = F.in[I_BR][l * NE + lane];
        LAS int* kkey = (LAS int*)(lds + 110592) + w * 128; LAS float* ksc = (LAS float*)(kkey + 64);
        for (int j2 = 0; j2 < 8; j2 += 2) {
#pragma unroll
            for (int r = 0; r < 2; ++r) { const int rl = 8 * w + j2 + r;
                const float logit = logp[rl * 64 + lane] + logp[4096 + rl * 64 + lane];
                const float s = __builtin_amdgcn_rcpf(1.0f + __builtin_amdgcn_exp2f(-1.4426950408889634f * logit)), sb = s + br;
                const float m1 = grp8_max(sb);
                const unsigned long long eq = __ballot(sb == m1); const int g = lane >> 3; const unsigned gm = (unsigned)(eq >> (8 * g)) & 0xffu; const int first = __ffs(gm) - 1;
                const float m2 = grp8_max(((lane & 7) == first) ? -INFINITY : sb);
                const float gs = m1 + m2;
                int grank = 0;
#pragma unroll
                for (int g2i = 0; g2i < 8; ++g2i) { const float v = rdlane(gs, 8 * g2i); grank += (v > gs || (v == gs && g2i < g)) ? 1 : 0; }
                int kb = __float_as_int(sb); kb ^= (kb >> 31) & 0x7fffffff;
                if (grank < 4) { const int c = r * 32 + grank * 8 + (lane & 7); kkey[c] = (kb & ~63) | (63 - lane); ksc[c] = s; }
            }
            asm volatile("s_waitcnt lgkmcnt(0)" ::: "memory");
            const int hr = lane >> 5; const int key = kkey[lane]; const float ms = ksc[lane];
            int rank = 0;
#pragma unroll
            for (int q4 = 0; q4 < 8; ++q4) { const v4i_k kk = *(const LAS v4i_k*)(kkey + hr * 32 + 4 * q4); rank += (kk.x > key ? 1 : 0) + (kk.y > key ? 1 : 0) + (kk.z > key ? 1 : 0) + (kk.w > key ? 1 : 0); }
            asm volatile("s_waitcnt lgkmcnt(0)" ::: "memory");
            const bool sel = rank < TOPK;
            float ts = sel ? ms : 0.f; ts += DPPF(ts, 0xB1); ts += DPPF(ts, 0x4E); ts += DPPF(ts, 0x141); ts += DPPF(ts, 0x140);
            const float tot = hr ? (rdlane(ts, 32) + rdlane(ts, 48)) : (rdlane(ts, 0) + rdlane(ts, 16)), gate = ms * __builtin_amdgcn_rcpf(tot) * 2.5f;
            if (sel) { const int e = 63 - (key & 63), rl = 8 * w + j2 + hr;
                const unsigned lpos = __hip_atomic_fetch_add((LAS unsigned*)(lds + LCNT) + e, 1u, __ATOMIC_RELAXED, __HIP_MEMORY_SCOPE_WORKGROUP);
                *(LAS v2u*)(lds + PEND + (rl * 8 + rank) * 8) = (v2u){(unsigned)e | (lpos << 8), __float_as_uint(gate)}; }
        }
        __syncthreads();
        if (tid < 64) { const unsigned c = ((LAS unsigned*)(lds + LCNT))[tid]; ((LAS unsigned*)(lds + LBASE))[tid] = c ? __hip_atomic_fetch_add(cntg + tid * 64, c, RLX_AGENT) : 0u; }
        __syncthreads();
        { const int rl = tid >> 3, rank = tid & 7; const v2u pe = *(const LAS v2u*)(lds + PEND + (rl * 8 + rank) * 8); const unsigned e = pe.x & 0xffu, lpos = pe.x >> 8;
            const unsigned pos = ((LAS unsigned*)(lds + LBASE))[e] + lpos; const unsigned token = (unsigned)(row0 + rl); const size_t o = (size_t)e * ECAP + pos;
            tokl[o] = token; dstl[o] = token * 16384u + (unsigned)rank * 256u; gwl[o] = __uint_as_float(pe.y) * Y_SCALE; }
        __syncthreads();
        }
    }
}
__device__ __forceinline__ void moe_build_toff(Frame& F, const int l) {
    LAS int* toff = (LAS int*)(F.lds + TOFF_OFF);
    if (F.wave == 0) { const unsigned* cntg = (const unsigned*)(F.ws + WS_CTL) + CW_CNT + l * 64 * 64;
        const int c = (int)__hip_atomic_load(cntg + F.lane * 64, RLX_AGENT); const int ntl = (c + 255) >> 8; int inc = ntl;
#pragma unroll
        for (int o = 1; o < 64; o <<= 1) { const int v = __shfl_up(inc, o); if (F.lane >= o) inc += v; }
        toff[F.lane] = inc - ntl; if (F.lane == 63) { toff[64] = inc; toff[65] = inc + 64; } }
    __syncthreads();
}
__device__ __forceinline__ void moe_gemm1(Frame& F, const int l, const int G, const int c) {
    moe_build_toff(F, l);
    SchedMoe1 Sd{(const char*)(F.ws + WS_ACTA), (const char*)(F.ws + WS_W1) + (size_t)l * NE1 * 1024 * D, (const unsigned*)(F.ws + WS_TOK + l * LIST_L), (const LAS int*)(F.lds + TOFF_OFF), G, c, F.lane};
    EpiMoe1 E{F.ws + WS_HID};
    pg8::gemm_phase<EpiMoe1, SchedMoe1, true, true, SC_W1, SC_H2>(F.lds, (LAS unsigned*)(F.lds + GTL_OFF), D / 2, D / 2, D / 2, Sd, E);
}
__device__ __forceinline__ void moe_gemm2(Frame& F, const int l, const int G, const int c) {
    SchedMoe2 Sd{(const char*)(F.ws + WS_HID), (const char*)(F.ws + WS_W2) + (size_t)l * NE1 * D * FF, (const unsigned*)(F.ws + WS_DST + l * LIST_L), (const float*)(F.ws + WS_GW + l * LIST_L), (const LAS int*)(F.lds + TOFF_OFF), G, c, F.lane};
    EpiMoe2 E{F.ws + WS_Y};
    pg8::gemm_phase<EpiMoe2, SchedMoe2, false, true, SC_W2, SC_HID>(F.lds, (LAS unsigned*)(F.lds + GTL_OFF), FF / 2, FF / 2, FF / 2, Sd, E);
}
struct SchedComb { const char* A; const char* W2s; const LAS int* toff; int G, c;
    __device__ __forceinline__ bool next(int i, GUnit& u) const { const int L = i * G + c; if (L >= 512) return false; const int rt = L / 8, pn = L % 8;
        u.A = A + (size_t)(__builtin_amdgcn_readfirstlane(toff[64]) + rt) * 256 * FF; u.B = W2s + (size_t)pn * 256 * FF; u.gtab = nullptr; u.e0 = nullptr; u.e1 = nullptr; u.i0 = rt; u.i1 = pn; u.i2 = 0; u.i3 = 0; return true; } };
template <bool LAST> struct EpiComb { static constexpr bool ETAB = false; static constexpr int NST = 0; static constexpr bool P16 = true; static constexpr bool PERM = true; const bf16* X1; const unsigned char* Y; const float* gate0; const float* gate1; bf16* X2; float* outf; float* ssq;
    __device__ __forceinline__ void operator()(const f32x4 (&acc)[2][2][4][2], const GUnit& u, int wr, int wc, int fr, int fq, const LAS unsigned* et) const {
        const int pm = u.i0, pn = u.i1; const float* gate = (pm < 32) ? gate0 : gate1;
        const int col0 = pn * 256 + wc * 64 + 16 * fq;
        f32x4 gv[2][2];
#pragma unroll
        for (int bj = 0; bj < 2; ++bj)
#pragma unroll
            for (int n = 0; n < 2; ++n) gv[bj][n] = *(const GAS f32x4*)(gate + col0 + bj * 8 + n * 4);
        float sq[2][4];
        v2u pa[2][2][4][2];
#pragma unroll
        for (int ai = 0; ai < 2; ++ai)
#pragma unroll
            for (int bj = 0; bj < 2; ++bj)
#pragma unroll
                for (int m = 0; m < 4; ++m)
#pragma unroll
                    for (int n = 0; n < 2; ++n) { const f32x4 v = acc[ai][bj][m][n]; pa[ai][bj][m][n] = (v2u){cvt_pk_bf16_n(v.x, v.y), cvt_pk_bf16_n(v.z, v.w)}; }
        auto rows = [&](auto R0c, auto Nc) __attribute__((always_inline)) { constexpr int R0 = decltype(R0c)::value, N = decltype(Nc)::value;
            v4u yr[N][8], xr[N][2];
#pragma unroll
            for (int i = 0; i < N; ++i) { const int ai = (R0 + i) >> 2, m = (R0 + i) & 3; const int row = pm * 256 + ai * 128 + wr * 64 + m * 16 + fr; const size_t off = (size_t)row * D + col0;
#pragma unroll
                for (int k = 0; k < 8; ++k) yr[i][k] = *(const GAS v4u*)(Y + (((size_t)row * 8 + pn) * 8 + k) * 256 + (wc * 64 + 16 * fq));
                xr[i][0] = *(const GAS v4u*)(X1 + off); xr[i][1] = *(const GAS v4u*)(X1 + off + 8); }
#pragma unroll
            for (int i = 0; i < N; ++i) { const int ai = (R0 + i) >> 2, m = (R0 + i) & 3; const int row = pm * 256 + ai * 128 + wr * 64 + m * 16 + fr; const size_t off = (size_t)row * D + col0;
                f32x4 ys[2][2] = {{{0.f, 0.f, 0.f, 0.f}, {0.f, 0.f, 0.f, 0.f}}, {{0.f, 0.f, 0.f, 0.f}, {0.f, 0.f, 0.f, 0.f}}};
#pragma unroll
                for (int k = 0; k < 8; ++k) { const unsigned yw[4] = {yr[i][k].x, yr[i][k].y, yr[i][k].z, yr[i][k].w};
#pragma unroll
                    for (int q = 0; q < 4; ++q) { const f32x2 a = __builtin_amdgcn_cvt_pk_f32_fp8((int)yw[q], false), b2 = __builtin_amdgcn_cvt_pk_f32_fp8((int)yw[q], true); ys[q >> 1][q & 1] += (f32x4){a.x, a.y, b2.x, b2.y}; } }
                float sacc = 0.f;
#pragma unroll
                for (int bj = 0; bj < 2; ++bj) { const v4u r = xr[i][bj];
                    const f32x4 b0 = {bflo(r.x), bfhi(r.x), bflo(r.y), bfhi(r.y)}, b1 = {bflo(r.z), bfhi(r.z), bflo(r.w), bfhi(r.w)};
                    const v2u p0 = pa[ai][bj][m][0], p1 = pa[ai][bj][m][1]; const f32x4 a0 = {bflo(p0.x), bfhi(p0.x), bflo(p0.y), bfhi(p0.y)}, a1 = {bflo(p1.x), bfhi(p1.x), bflo(p1.y), bfhi(p1.y)};
                    const f32x4 o0 = b0 + gv[bj][0] * (a0 + ys[bj][0] * (1.0f / Y_SCALE)), o1 = b1 + gv[bj][1] * (a1 + ys[bj][1] * (1.0f / Y_SCALE));
                    if constexpr (LAST) { *(GAS f32x4*)(outf + off + bj * 8) = o0; *(GAS f32x4*)(outf + off + bj * 8 + 4) = o1; }
                    else { v4u w; w.x = cvt_pk_bf16(o0.x, o0.y); w.y = cvt_pk_bf16(o0.z, o0.w); w.z = cvt_pk_bf16(o1.x, o1.y); w.w = cvt_pk_bf16(o1.z, o1.w); *(GAS v4u*)(X2 + off + bj * 8) = w;
                        sacc += ((o0.x * o0.x + o0.y * o0.y) + (o0.z * o0.z + o0.w * o0.w)) + ((o1.x * o1.x + o1.y * o1.y) + (o1.z * o1.z + o1.w * o1.w)); } }
                if constexpr (!LAST) { sacc += __shfl_xor(sacc, 16); sacc += __shfl_xor(sacc, 32); sq[ai][m] = sacc; } }
            };
        rows(std::integral_constant<int, 0>{}, std::integral_constant<int, 3>{}); rows(std::integral_constant<int, 3>{}, std::integral_constant<int, 3>{}); rows(std::integral_constant<int, 6>{}, std::integral_constant<int, 2>{});
        if constexpr (!LAST) { if (fq == 0) {
#pragma unroll
            for (int ai = 0; ai < 2; ++ai)
#pragma unroll
                for (int m = 0; m < 4; ++m) ssq[(size_t)(pm * 256 + ai * 128 + wr * 64 + m * 16 + fr) * 32 + pn * 4 + wc] = sq[ai][m]; } }
    } };
template <bool LAST>
__device__ __forceinline__ void moe_combine_gemm(Frame& F, const int l, float* out_f32) {
    SchedComb Sd{(const char*)(F.ws + WS_HID), (const char*)(F.ws + WS_W2) + ((size_t)l * NE1 + NE) * D * FF, (const LAS int*)(F.lds + TOFF_OFF), F.G, F.vcu};
    EpiComb<LAST> E{(const bf16*)(F.ws + WS_X1), F.ws + WS_Y, modp(F, l, 0, 5), modp(F, l, 1, 5), (bf16*)(F.ws + WS_X2), out_f32, (float*)(F.ws + WS_SSQ)};
    pg8::gemm_phase<EpiComb<LAST>, SchedComb, false, true, SC_W2, SC_HID>(F.lds, (LAS unsigned*)(F.lds + GTL_OFF), FF / 2, FF / 2, FF / 2, Sd, E);
}
template <bool LAST>
__device__ __forceinline__ void moe_combine(Frame& F, const int l, float* out_f32) {
    const int gw = F.vcu * NWAVES + F.wave, NGW = F.G * NWAVES;
    const bf16* X1 = (const bf16*)(F.ws + WS_X1); const unsigned char* Y = F.ws + WS_Y; bf16* X2 = (bf16*)(F.ws + WS_X2);
    for (int rb = gw; rb < M / 8; rb += NGW) {
        const int row0 = rb * 8, b = row0 / S;
        const float* ga2 = modp(F, l, b, 5);
        for (int j = 0; j < 8; ++j) { const int row = row0 + j; f32x4 v[8];
#pragma unroll
            for (int jj = 0; jj < 8; ++jj) { const int col = 4 * F.lane + 256 * jj; f32x4 ys = {0.f, 0.f, 0.f, 0.f};
#pragma unroll
                for (int k = 0; k < 9; ++k) { const int y = *(const GAS int*)(Y + ((size_t)row * 9 + k) * D + col); const f32x2 a = __builtin_amdgcn_cvt_pk_f32_fp8(y, false), bq = __builtin_amdgcn_cvt_pk_f32_fp8(y, true); ys += (f32x4){a.x, a.y, bq.x, bq.y}; }
                const v2u xr = *(const GAS v2u*)(X1 + (size_t)row * D + col);
                v[jj] = (f32x4){bflo(xr.x), bfhi(xr.x), bflo(xr.y), bfhi(xr.y)} + *(const GAS f32x4*)(ga2 + col) * (ys * (1.0f / Y_SCALE));
                if (LAST) *(GAS f32x4*)(out_f32 + (size_t)row * D + col) = v[jj];
                else { v2u w; w.x = cvt_pk_bf16(v[jj].x, v[jj].y); w.y = cvt_pk_bf16(v[jj].z, v[jj].w); *(GAS v2u*)(X2 + (size_t)row * D + col) = w; } }
            if (!LAST) {
                float ss = 0.f;
#pragma unroll
                for (int jj = 0; jj < 8; ++jj) ss += (v[jj].x * v[jj].x + v[jj].y * v[jj].y) + (v[jj].z * v[jj].z + v[jj].w * v[jj].w);
                const float rstd = 1.0f / sqrtf(wave_sum(ss) * (1.0f / D) + EPS);
                if (F.lane == 0) ((float*)(F.ws + WS_RSTD2))[row] = rstd; } }
    }
}
__device__ __forceinline__ void bf8_unpack(const v4u r, f32x4& a, f32x4& b) { a = (f32x4){bflo(r.x), bfhi(r.x), bflo(r.y), bfhi(r.y)}; b = (f32x4){bflo(r.z), bfhi(r.z), bflo(r.w), bfhi(r.w)}; }
__device__ __forceinline__ void pool_diff(Frame& F) {
    const bf16* X2 = (const bf16*)(F.ws + WS_X2); const float* SSQ = (const float*)(F.ws + WS_SSQ); unsigned char* DP = F.ws + WS_ACTB;
    LAS float* rsl = (LAS float*)F.lds;
    const int cg = F.tid & 255, col = 8 * cg, g = cg >> 6, wdw = 2 << g, back = wdw >> 1, fwd = wdw - back, tsel = F.tid >> 8;
    for (int tb = F.vcu; tb < M / 64; tb += F.G) {
        const int t00 = tb * 64 + tsel * 32, bb = t00 / S, tl0 = t00 - bb * S;
        const bf16* base = X2 + (size_t)bb * S * D + col;
        {   const int tlt = tb * 64 - bb * S;
            __syncthreads();
            if (F.tid < 96) { const int tt = tlt - 16 + F.tid; float r = 0.f;
                if (tt >= 0 && tt < S) { const float* sp = SSQ + ((size_t)bb * S + tt) * 32; f32x4 a4 = {0.f, 0.f, 0.f, 0.f};
#pragma unroll
                    for (int q = 0; q < 8; ++q) a4 += *(const GAS f32x4*)(sp + 4 * q);
                    r = 1.0f / sqrtf(((a4.x + a4.y) + (a4.z + a4.w)) * (1.0f / D) + EPS); }
                rsl[F.tid] = r; }
            __syncthreads(); }
        const LAS float* rsb = rsl - (tb * 64 - bb * S - 16);
        f32x4 ma0, ma1, mb0, mb1;
        { const float* g1 = F.in[I_G1] + D + col; const float* sh = modp(F, 1, bb, 0) + col; const float* sc = modp(F, 1, bb, 1) + col;
          ma0 = *(const GAS f32x4*)(g1) * (*(const GAS f32x4*)(sc) + 1.0f); ma1 = *(const GAS f32x4*)(g1 + 4) * (*(const GAS f32x4*)(sc + 4) + 1.0f); mb0 = *(const GAS f32x4*)(sh); mb1 = *(const GAS f32x4*)(sh + 4); }
#define PD_NORM(r, rs, a, b) do { bf8_unpack((r), (a), (b)); (a) = (a) * (rs) * ma0 + mb0; (b) = (b) * (rs) * ma1 + mb1; } while (0)
        f32x4 sa = {0.f, 0.f, 0.f, 0.f}, sb = sa;
        { int lo = tl0 - 1 - back; lo = lo < 0 ? 0 : lo; int hi = tl0 - 1 + fwd; hi = hi > S ? S : hi;
          for (int tt = lo; tt < hi; ++tt) { f32x4 a, b; PD_NORM(*(const GAS v4u*)(base + (size_t)tt * D), rsb[tt], a, b); sa += a; sb += b; } }
#pragma unroll 1
        for (int j0 = 0; j0 < 32; j0 += 4) {
            v4u rin[4], rout[4], rc[4]; float sin_[4], sout_[4], sc_[4];
#pragma unroll
            for (int j = 0; j < 4; ++j) { const int t = tl0 + j0 + j; const int tin = t + fwd - 1, tout = t - back - 1;
                rin[j] = (tin < S) ? *(const GAS v4u*)(base + (size_t)tin * D) : (v4u){0u, 0u, 0u, 0u}; sin_[j] = (tin < S) ? rsb[tin] : 0.f;
                rout[j] = (tout >= 0) ? *(const GAS v4u*)(base + (size_t)tout * D) : (v4u){0u, 0u, 0u, 0u}; sout_[j] = (tout >= 0) ? rsb[tout] : 0.f;
                rc[j] = *(const GAS v4u*)(base + (size_t)t * D); sc_[j] = rsb[t]; }
#pragma unroll
            for (int j = 0; j < 4; ++j) { const int t = tl0 + j0 + j; const int tin = t + fwd - 1, tout = t - back - 1; f32x4 a, b;
                if (tin < S) { PD_NORM(rin[j], sin_[j], a, b); sa += a; sb += b; }
                if (tout >= 0) { PD_NORM(rout[j], sout_[j], a, b); sa -= a; sb -= b; }
                int lo = t - back; lo = lo < 0 ? 0 : lo; int hi = t + fwd; hi = hi > S ? S : hi; const float inv = 1.0f / (float)(hi - lo);
                PD_NORM(rc[j], sc_[j], a, b); const f32x4 o0 = (sa * inv - a) * DP_SCALE, o1 = (sb * inv - b) * DP_SCALE;
                v2u w; w.x = pk4_fp8(o0.x, o0.y, o0.z, o0.w); w.y = pk4_fp8(o1.x, o1.y, o1.z, o1.w);
                *(GAS v2u*)(DP + ((size_t)bb * S + t) * D + col) = w; }
        }
#undef PD_NORM
    }
}

__device__ __forceinline__ void p0_ctx_units(Frame& F) {
    const int per = F.G / 8; const bool g8 = (F.G % 8) == 0 && per > 0;
    const bool cons = g8 ? ((F.vcu % per) == per - 1) : (F.vcu < 8);
    if (!cons) return;
    const int q = g8 ? F.vcu / per : F.vcu;
    unsigned* ctl = (unsigned*)(F.ws + WS_CTL);
    if (F.tid == 0) {
        for (unsigned sp = 0; (__hip_atomic_load(ctl + CW_PRO, RLX_AGENT) < (unsigned)F.G || __hip_atomic_load(ctl + CW_QKV, RLX_AGENT) < 192u) && sp < (1u << 20); ++sp) __builtin_amdgcn_s_sleep(16);
        __builtin_amdgcn_fence(__ATOMIC_ACQUIRE, "agent"); asm volatile("s_waitcnt vmcnt(0)" ::: "memory"); }
    __syncthreads();
    unsigned char* HN = F.ws + WS_ACTA;
    {   const int ct = (q & 3) >> 1;
        ModVec mv; load_modvec(mv, F.in[I_G1], modp(F, 0, 2, 0), modp(F, 0, 2, 1), F.lane);
        for (int r = F.wave; r < 256; r += NWAVES) { const int row = ct * 256 + r; f32x4 v[8];
#pragma unroll
            for (int jj = 0; jj < 8; ++jj) v[jj] = *(const GAS f32x4*)(F.in[I_CTX] + (size_t)row * D + 4 * F.lane + 256 * jj);
            norm_mod_store_fp8(v, mv, HN + (size_t)(M + row) * D, F.lane, H2_SCALE); } }
    asm volatile("s_waitcnt vmcnt(0)" ::: "memory"); __syncthreads();
    if (q < 4) { SchedQK Sd{(const char*)(F.ws + WS_ACTA), (const char*)(F.ws + WS_WQKV), 1 << 20, 640 + q, 644};
        EpiQK E{(bf16*)(F.ws + WS_ACTB), (bf16*)(F.ws + WS_KB), F.in[I_GQ], F.in[I_GK], (const float*)(F.ws + WS_ROPE), (LAS float*)(F.lds + ETL_OFF)};
        pg8::gemm_phase<EpiQK, SchedQK, false, true, SC_W1, SC_H2>(F.lds, (LAS unsigned*)(F.lds + GTL_OFF), D / 2, D / 2, D / 2, Sd, E); }
    else { SchedVT Sd{(const char*)(F.ws + WS_WQKV) + (size_t)2560 * D, (const char*)(F.ws + WS_ACTA), 1 << 20, 128 + (q - 4), 132}; EpiVT E{(bf16*)(F.ws + WS_VT)};
        pg8::gemm_phase<EpiVT, SchedVT, false, true, SC_H2, SC_W1>(F.lds, (LAS unsigned*)(F.lds + GTL_OFF), D / 2, D / 2, D / 2, Sd, E); }
    __syncthreads();
}

constexpr int N_PHASES = 16;
__global__ void __launch_bounds__(NTHR, 2) fwd_kernel(Args args) {
    extern __shared__ __attribute__((aligned(16))) unsigned char lds[];
    Frame F;
    F.lds = (LAS unsigned char*)lds; F.tid = threadIdx.x; F.lane = F.tid & 63; F.wave = __builtin_amdgcn_readfirstlane(F.tid >> 6);
    F.G = gridDim.x; { const int bx = blockIdx.x; F.vcu = (F.G % 8 == 0) ? (bx % 8) * (F.G / 8) + bx / 8 : bx; }
    F.ws = args.ws; F.in = args.in;
    volatile LAS unsigned* MISC = (volatile LAS unsigned*)(F.lds + MISC_OFF);
    if (F.tid < 32) MISC[F.tid] = 0u;
    __syncthreads();
    unsigned* ctl = (unsigned*)(F.ws + WS_CTL);
    XcdBarrier bar; bar.bar = ctl + CW_BAR; bar.x = 0; bar.st = nullptr;
    const int lo = args.ph_lo, hi = args.ph_hi;
    if (hi - lo > 1) bar = xcd_barrier_post(ctl + CW_BAR, MISC + 8);
#ifndef PHASE_MASK
#define PHASE_MASK 0xFFFF
#endif
#define IN(k) (((PHASE_MASK >> (k)) & 1) && lo <= (k) && (k) < hi)
#ifndef REPEAT_MASK
#define REPEAT_MASK 0
#endif
#ifdef PROBE_A0
    unsigned long long tstamp = __builtin_amdgcn_s_memrealtime(); unsigned ta = 0u, tb = 0u;
#define SEAM(k) do { if (IN(k) && IN((k) + 1)) xcd_barrier(bar); { const unsigned long long tn = __builtin_amdgcn_s_memrealtime(); const unsigned dt = (unsigned)(tn - tstamp); tstamp = tn; \
        if ((k) >= PROBE_A0 && (k) < PROBE_A1) ta += dt; if ((k) >= PROBE_B0 && (k) < PROBE_B1) tb += dt; } } while (0)
#else
#define SEAM(k) do { if (IN(k) && IN((k) + 1)) xcd_barrier(bar); } while (0)
#endif
    if (IN(0)) { p0_prologue(F); p0_ctx_units(F); convert_all_dynamic(F, (unsigned*)(F.ws + WS_CTL) + CW_CVT); }
    if (IN(0) && IN(1)) {
        if (F.tid == 0) { unsigned* ctl = (unsigned*)(F.ws + WS_CTL);
            for (unsigned sp = 0; __hip_atomic_load(ctl + CW_PRO, RLX_AGENT) < (unsigned)F.G && sp < (1u << 20); ++sp) __builtin_amdgcn_s_sleep(16);
            __builtin_amdgcn_fence(__ATOMIC_ACQUIRE, "agent"); asm volatile("s_waitcnt vmcnt(0)" ::: "memory"); }
        __syncthreads();
    }
    if (IN(1)) p1_norm1(F);
    SEAM(1);
    if (IN(2)) {
        const Role R = cu_role(F, NCX_QKV);
        if (R.cvt) convert_experts(F, 0, CVT_L0_P0, CVT_PER_LAYER, R.rank, R.n);
        else {
        { SchedQK Sd{(const char*)(F.ws + WS_ACTA), (const char*)(F.ws + WS_WQKV), R.n, R.rank, 640}; EpiQK E{(bf16*)(F.ws + WS_ACTB), (bf16*)(F.ws + WS_KB), F.in[I_GQ], F.in[I_GK], (const float*)(F.ws + WS_ROPE), (LAS float*)(F.lds + ETL_OFF)};
          pg8::gemm_phase<EpiQK, SchedQK, false, true, SC_W1, SC_H2>(F.lds, (LAS unsigned*)(F.lds + GTL_OFF), D / 2, D / 2, D / 2, Sd, E); }
        { SchedVT Sd{(const char*)(F.ws + WS_WQKV) + (size_t)2560 * D, (const char*)(F.ws + WS_ACTA), R.n, R.n - 1 - R.rank, 128}; EpiVT E{(bf16*)(F.ws + WS_VT)};
          pg8::gemm_phase<EpiVT, SchedVT, false, true, SC_H2, SC_W1>(F.lds, (LAS unsigned*)(F.lds + GTL_OFF), D / 2, D / 2, D / 2, Sd, E); }
        }
    }
    SEAM(2);
    if (IN(4)) p4_attention(F);
#if (REPEAT_MASK >> 4) & 1
    if (IN(4)) p4_attention(F);
#endif
    SEAM(4);
    if (IN(5)) { SchedRes Sd{(const char*)(F.ws + WS_ACTC), (const char*)(F.ws + WS_WO), F.G, F.vcu, 0};
        EpiRes<false> E{F.in[I_X], (bf16*)(F.ws + WS_X1), modp(F, 0, 0, 2), modp(F, 0, 1, 2), nullptr, (float*)(F.ws + WS_SSQ)};
        pg8::gemm_phase<EpiRes<false>, SchedRes, false, true, SC_W1, SC_O>(F.lds, (LAS unsigned*)(F.lds + GTL_OFF), D / 2, D / 2, D / 2, Sd, E); }
#if (REPEAT_MASK >> 5) & 1
    if (IN(5)) { SchedRes Sd{(const char*)(F.ws + WS_ACTC), (const char*)(F.ws + WS_WO), F.G, F.vcu, 0};
        EpiRes<false> E{F.in[I_X], (bf16*)(F.ws + WS_X1), modp(F, 0, 0, 2), modp(F, 0, 1, 2), nullptr, (float*)(F.ws + WS_SSQ)};
        pg8::gemm_phase<EpiRes<false>, SchedRes, false, true, SC_W1, SC_O>(F.lds, (LAS unsigned*)(F.lds + GTL_OFF), D / 2, D / 2, D / 2, Sd, E); }
#endif
    SEAM(5);
    if (IN(6)) moe_route(F, 0);
#if (REPEAT_MASK >> 6) & 1
    if (IN(6)) moe_route(F, 0);
#endif
    SEAM(6);
    if (IN(7)) { const Role R = cu_role(F, NCX_MOE); if (R.cvt) convert_experts(F, 1, 0, CVT_L1_P7, R.rank, R.n); else moe_gemm1(F, 0, R.n, R.rank); }
#if (REPEAT_MASK >> 7) & 1
    if (IN(7)) { const Role R = cu_role(F, NCX_MOE); if (R.cvt) convert_experts(F, 1, 0, CVT_L1_P7, R.rank, R.n); else moe_gemm1(F, 0, R.n, R.rank); }
#endif
    SEAM(7);
    if (IN(8)) { const Role R = cu_role(F, NCX_MOE); if (R.cvt) convert_experts(F, 1, CVT_L1_P7, CVT_PER_LAYER, R.rank, R.n); else moe_gemm2(F, 0, R.n, R.rank); }
#if (REPEAT_MASK >> 8) & 1
    if (IN(8)) { const Role R = cu_role(F, NCX_MOE); if (R.cvt) convert_experts(F, 1, CVT_L1_P7, CVT_PER_LAYER, R.rank, R.n); else moe_gemm2(F, 0, R.n, R.rank); }
#endif
    SEAM(8);
    if (IN(9)) moe_combine_gemm<false>(F, 0, args.out);
#if (REPEAT_MASK >> 9) & 1
    if (IN(9)) moe_combine_gemm<false>(F, 0, args.out);
#endif
    SEAM(9);
    if (IN(10)) pool_diff(F);
#if (REPEAT_MASK >> 10) & 1
    if (IN(10)) pool_diff(F);
#endif
    SEAM(10);
    if (IN(11)) { SchedRes Sd{(const char*)(F.ws + WS_ACTB), (const char*)(F.ws + WS_WPOOL), F.G, F.vcu, 1};
        EpiRes<true> E{F.ws + WS_X2, (bf16*)(F.ws + WS_X1), modp(F, 1, 0, 2), modp(F, 1, 1, 2), F.in[I_PSCALE], (float*)(F.ws + WS_SSQ)};
        pg8::gemm_phase<EpiRes<true>, SchedRes, false, true, SC_PW, SC_DP>(F.lds, (LAS unsigned*)(F.lds + GTL_OFF), FF / 2, D / 2, FF / 2, Sd, E); }
#if (REPEAT_MASK >> 11) & 1
    if (IN(11)) { SchedRes Sd{(const char*)(F.ws + WS_ACTB), (const char*)(F.ws + WS_WPOOL), F.G, F.vcu, 1};
        EpiRes<true> E{F.ws + WS_X2, (bf16*)(F.ws + WS_X1), modp(F, 1, 0, 2), modp(F, 1, 1, 2), F.in[I_PSCALE], (float*)(F.ws + WS_SSQ)};
        pg8::gemm_phase<EpiRes<true>, SchedRes, false, true, SC_PW, SC_DP>(F.lds, (LAS unsigned*)(F.lds + GTL_OFF), FF / 2, D / 2, FF / 2, Sd, E); }
#endif
    SEAM(11);
    if (IN(12)) moe_route(F, 1);
#if (REPEAT_MASK >> 12) & 1
    if (IN(12)) moe_route(F, 1);
#endif
    SEAM(12);
    if (IN(13)) moe_gemm1(F, 1, F.G, F.vcu);
#if (REPEAT_MASK >> 13) & 1
    if (IN(13)) moe_gemm1(F, 1, F.G, F.vcu);
#endif
    SEAM(13);
    if (IN(14)) moe_gemm2(F, 1, F.G, F.vcu);
#if (REPEAT_MASK >> 14) & 1
    if (IN(14)) moe_gemm2(F, 1, F.G, F.vcu);
#endif
    SEAM(14);
    if (IN(15)) moe_combine_gemm<true>(F, 1, args.out);
#if (REPEAT_MASK >> 15) & 1
    if (IN(15)) moe_combine_gemm<true>(F, 1, args.out);
#endif
#ifdef PROBE_A0
    xcd_barrier(bar);
    { const unsigned long long tn = __builtin_amdgcn_s_memrealtime(); const unsigned dt = (unsigned)(tn - tstamp); if (15 >= PROBE_A0 && 15 < PROBE_A1) ta += dt; if (15 >= PROBE_B0 && 15 < PROBE_B1) tb += dt; }
    if (blockIdx.x == 0 && F.tid == 0) { __hip_atomic_store(ctl + 8, ta, RLX_AGENT); __hip_atomic_store(ctl + 9, tb, RLX_AGENT); }
    xcd_barrier(bar);
    { const float eps = (float)__hip_atomic_load(ctl + 8, RLX_AGENT) * (0.01f / 1000.0f), dlt = (float)__hip_atomic_load(ctl + 9, RLX_AGENT) * (0.01f * 10.0f);
      for (size_t i = (size_t)blockIdx.x * NTHR + F.tid; i < (size_t)M * D; i += (size_t)F.G * NTHR) { float v = args.out[i] * (1.0f + eps); if (i == 0) v += dlt; args.out[i] = v; } }
#endif
#undef IN
#undef SEAM
}

extern "C" void kernel_launch(void* const* d_in, const int* in_sizes, int n_in, void* d_out, int out_size, void* d_ws, size_t ws_size, hipStream_t stream) {
    static int grid = 0;
    if (grid == 0) {
        if (n_in != 23 || out_size != M * D || ws_size < WS_END) { fprintf(stderr, "kernel_launch: bad shapes n_in %d out %d ws %zu\n", n_in, out_size, ws_size); grid = -1; return; }
        int dev = 0, cus = 0, per_cu = 0;
        if (hipGetDevice(&dev) != hipSuccess || hipDeviceGetAttribute(&cus, hipDeviceAttributeMultiprocessorCount, dev) != hipSuccess) { grid = -1; return; }
        if (hipFuncSetAttribute((const void*)fwd_kernel, hipFuncAttributeMaxDynamicSharedMemorySize, LDS_BYTES) != hipSuccess) { fprintf(stderr, "kernel_launch: hipFuncSetAttribute failed\n"); grid = -1; return; }
        if (hipOccupancyMaxActiveBlocksPerMultiprocessor(&per_cu, (const void*)fwd_kernel, NTHR, LDS_BYTES) != hipSuccess || per_cu < 1) fprintf(stderr, "kernel_launch: occupancy query says %d\n", per_cu);
        (void)hipGetLastError();
        grid = cus;
    }
    if (grid < 0) return;
    (void)hipMemsetAsync((char*)d_ws + WS_CTL, 0, CTL_ZERO_BYTES, stream);
    Args a{};
    for (int i = 0; i < 23; ++i) a.in[i] = (const float*)d_in[i];
    a.out = (float*)d_out; a.ws = (unsigned char*)d_ws;
#if MK_N_LAUNCHES == 1
    a.ph_lo = 0; a.ph_hi = N_PHASES;
    hipLaunchKernelGGL(fwd_kernel, dim3(grid), dim3(NTHR), LDS_BYTES, stream, a);
#else
    for (int p = 0; p < N_PHASES; ++p) { a.ph_lo = p; a.ph_hi = p + 1; hipLaunchKernelGGL(fwd_kernel, dim3(grid), dim3(NTHR), LDS_BYTES, stream, a); }
#endif
}
```
